# Optimizing an MI355X kernel written in HIP

```python
import math
import jax, jax.numpy as jnp
from jax import lax
import numpy as np

D_MODEL = 1024
BATCH = 32
SEQ = 2048
DEPTH = 2
DEC_BATCH = 16
DEC_SEQ = 32
PAST_LEN = 4096

CHUNK = 64
Q_BLOCK = 128
HEAD_DIM = 64
SB_WIDTH = D_MODEL // 2
SB_HEADS = SB_WIDTH // HEAD_DIM
SSM_WIDTH = D_MODEL // 4
SSM_GROUP = 16
SSM_GROUPS = SSM_WIDTH // SSM_GROUP
SSM_STATE = 64
RWKV_WIDTH = D_MODEL // 4
RWKV_HEADS = RWKV_WIDTH // HEAD_DIM
RWKV_LORA = 32
RWKV_SHIFT = 3 * RWKV_WIDTH + 2 * RWKV_LORA
MIX_WIDTH = SB_WIDTH + SSM_WIDTH + RWKV_WIDTH
IN_SPLITS = (SB_WIDTH, 2 * SB_WIDTH, 3 * SB_WIDTH, 4 * SB_WIDTH,
             4 * SB_WIDTH + SSM_WIDTH, 4 * SB_WIDTH + 2 * SSM_WIDTH,
             4 * SB_WIDTH + 2 * SSM_WIDTH + RWKV_SHIFT)
D_IN = IN_SPLITS[-1] + RWKV_WIDTH
RMS_EPS = 1e-6
GN_EPS = 64e-5
DECAY_SCALE = math.exp(-0.5)

kernel_name = 'hybrid_stickbreak_s5_rwkv7_stream_step'


def rms_norm(x, w):
    xf = x.astype(jnp.float32)
    return xf * lax.rsqrt(jnp.mean(xf * xf, axis=-1, keepdims=True) + RMS_EPS) * w.astype(jnp.float32)


def sb_block(qb, k, v, q_start):
    tq, tk = qb.shape[1], k.shape[1]
    z = jnp.einsum('bqhd,bkhd->bhqk', qb, k).astype(jnp.float32) * (HEAD_DIM ** -0.5)
    qpos = q_start + jnp.arange(tq)
    kpos = jnp.arange(tk)
    mask = kpos[None, :] < qpos[:, None]
    log_keep = jnp.where(mask, jax.nn.log_sigmoid(-z), 0.0)
    later = lax.cumsum(log_keep, axis=3, reverse=True) - log_keep
    a = jnp.where(mask, jnp.exp(jax.nn.log_sigmoid(z) + later), 0.0)
    return jnp.einsum('bhqk,bkhd->bqhd', a.astype(v.dtype), v)


def stick_breaking(q, k_all, v_all, q_start):
    lq = q.shape[1]
    outs = []
    for s in range(0, lq, Q_BLOCK):
        e = min(s + Q_BLOCK, lq)
        kend = q_start + e
        outs.append(sb_block(q[:, s:e], k_all[:, :kend], v_all[:, :kend], q_start + s))
    return jnp.concatenate(outs, axis=1)


def _complex_affine_combine(e1, e2):
    a1r, a1i, b1r, b1i = e1
    a2r, a2i, b2r, b2i = e2
    return (a1r * a2r - a1i * a2i, a1r * a2i + a1i * a2r,
            a2r * b1r - a2i * b1i + b2r, a2r * b1i + a2i * b1r + b2i)


def s5_branch(u, h0_re, h0_im, lam_re, lam_im, log_dt, b_re, b_im, c_re, c_im, d, w_glu, b_glu):
    f32 = jnp.float32
    bsz, l, _ = u.shape
    dt = jnp.exp(log_dt.astype(f32))[:, None]
    lr = jnp.minimum(lam_re.astype(f32), -1e-4)
    li = lam_im.astype(f32)
    er = jnp.exp(lr * dt)
    ar, ai = er * jnp.cos(li * dt), er * jnp.sin(li * dt)
    den = lr * lr + li * li
    fr = ((ar - 1.0) * lr + ai * li) / den
    fi = (ai * lr - (ar - 1.0) * li) / den
    br, bi = b_re.astype(f32), b_im.astype(f32)
    bbr = fr[..., None] * br - fi[..., None] * bi
    bbi = fr[..., None] * bi + fi[..., None] * br
    ug = u.astype(f32).reshape(bsz, l, SSM_GROUPS, SSM_GROUP)
    bu_r = jnp.einsum('blgc,gpc->blgp', ug, bbr)
    bu_i = jnp.einsum('blgc,gpc->blgp', ug, bbi)
    a_r = jnp.broadcast_to(ar, bu_r.shape)
    a_i = jnp.broadcast_to(ai, bu_r.shape)
    _, _, hr, hi = lax.associative_scan(_complex_affine_combine, (a_r, a_i, bu_r, bu_i), axis=1)
    if h0_re is not None:
        t = jnp.arange(1, l + 1, dtype=f32)[:, None, None]
        et = jnp.exp(lr * dt * t)
        p_r, p_i = et * jnp.cos(li * dt * t), et * jnp.sin(li * dt * t)
        h0r = h0_re.astype(f32)[:, None]
        h0i = h0_im.astype(f32)[:, None]
        hr = hr + p_r * h0r - p_i * h0i
        hi = hi + p_r * h0i + p_i * h0r
    y = (jnp.einsum('blgp,gcp->blgc', hr, c_re.astype(f32))
         - jnp.einsum('blgp,gcp->blgc', hi, c_im.astype(f32))
         + d.astype(f32) * ug)
    y = jax.nn.gelu(y.reshape(bsz, l, SSM_WIDTH))
    z = y @ w_glu.astype(f32) + b_glu.astype(f32)
    val, gate = jnp.split(z, 2, axis=-1)
    return val * jax.nn.sigmoid(gate), hr[:, -1], hi[:, -1]


def wkv7_scan(s0, r, decay, kt, v, kh, bh):
    def step(s, inp):
        r_t, w_t, k_t, v_t, kh_t, b_t = inp
        sa = jnp.einsum('bhvk,bhk->bhv', s, kh_t)
        s = s * w_t[:, :, None, :] - sa[..., None] * b_t[:, :, None, :] + v_t[..., None] * k_t[:, :, None, :]
        return s, jnp.einsum('bhvk,bhk->bhv', s, r_t)
    xs = tuple(jnp.moveaxis(t, 1, 0) for t in (r, decay, kt, v, kh, bh))
    s_final, ys = lax.scan(step, s0, xs)
    return jnp.moveaxis(ys, 0, 1), s_final


def rwkv7_branch(c_proj, prev_row, s0, mu, w0, w2, a0, a2, k_k, k_a, u_bonus, ln_w, ln_b):
    f32 = jnp.float32
    bsz, l, _ = c_proj.shape
    cp = c_proj.astype(f32)
    prev = jnp.zeros((bsz, 1, RWKV_SHIFT), f32) if prev_row is None else prev_row.astype(f32)[:, None]
    shifted = jnp.concatenate([prev, cp[:, :-1]], axis=1)
    xc = cp + mu.astype(f32) * (shifted - cp)
    r, k, v, w_lo, a_lo = jnp.split(
        xc, (RWKV_WIDTH, 2 * RWKV_WIDTH, 3 * RWKV_WIDTH, 3 * RWKV_WIDTH + RWKV_LORA), axis=-1)
    decay = jnp.exp(-DECAY_SCALE * jax.nn.sigmoid(w0.astype(f32) + jnp.tanh(w_lo) @ w2.astype(f32)))
    a = jax.nn.sigmoid(a0.astype(f32) + a_lo @ a2.astype(f32))
    hs = lambda t: t.reshape(bsz, l, RWKV_HEADS, HEAD_DIM)
    kk = hs(k * k_k.astype(f32))
    kh = kk * lax.rsqrt(jnp.sum(kk * kk, axis=-1, keepdims=True) + 1e-12)
    kt = hs(k * (1.0 + (a - 1.0) * k_a.astype(f32)))
    r, v, decay, a = hs(r), hs(v), hs(decay), hs(a)
    if s0 is None:
        s0 = jnp.zeros((bsz, RWKV_HEADS, HEAD_DIM, HEAD_DIM), f32)
    ys, s_final = wkv7_scan(s0.astype(f32), r, decay, kt, v, kh, a * kh)
    mean = jnp.mean(ys, axis=-1, keepdims=True)
    var = jnp.mean((ys - mean) ** 2, axis=-1, keepdims=True)
    y = ((ys - mean) * lax.rsqrt(var + GN_EPS)).reshape(bsz, l, RWKV_WIDTH) * ln_w.astype(f32) + ln_b.astype(f32)
    bonus = jnp.sum(r * kt * u_bonus.astype(f32), axis=-1, keepdims=True) * v
    y = y + bonus.reshape(bsz, l, RWKV_WIDTH)
    return y, s_final, cp[:, -1]


def mixer_layer(x, p, past):
    f32 = jnp.float32
    bsz, l, _ = x.shape
    h = rms_norm(x, p['norm_w']).astype(x.dtype)
    proj = h @ p['w_in']
    q, k, v, g_a, u, g_b, c_proj, g_c = jnp.split(proj, IN_SPLITS, axis=-1)
    heads = lambda t: t.reshape(bsz, l, SB_HEADS, HEAD_DIM)
    q = rms_norm(heads(q), p['q_norm_w']).astype(x.dtype)
    k = rms_norm(heads(k), p['k_norm_w']).astype(x.dtype)
    v = heads(v)
    if past is None:
        k_all, v_all, q_start = k, v, 0
        h0_re, h0_im, s0, prev_row = None, None, None, None
    else:
        k_all = jnp.concatenate([past['k'].astype(k.dtype), k], axis=1)
        v_all = jnp.concatenate([past['v'].astype(v.dtype), v], axis=1)
        q_start = past['k'].shape[1]
        h0_re, h0_im, s0, prev_row = past['ssm_re'], past['ssm_im'], past['wkv'], past['shift']
    y_a = stick_breaking(q, k_all, v_all, q_start).reshape(bsz, l, SB_WIDTH).astype(f32)
    y_a = y_a * jax.nn.silu(g_a.astype(f32))
    y_b, ssm_re, ssm_im = s5_branch(u, h0_re, h0_im, p['ssm_lambda_re'], p['ssm_lambda_im'], p['ssm_log_dt'],
                                    p['ssm_b_re'], p['ssm_b_im'], p['ssm_c_re'], p['ssm_c_im'], p['ssm_d'],
                                    p['ssm_w_glu'], p['ssm_b_glu'])
    y_b = y_b * jax.nn.silu(g_b.astype(f32))
    y_c, wkv, shift = rwkv7_branch(c_proj, prev_row, s0, p['rwkv_mu'], p['rwkv_w0'], p['rwkv_w2'],
                                   p['rwkv_a0'], p['rwkv_a2'], p['rwkv_k_k'], p['rwkv_k_a'], p['rwkv_u'],
                                   p['rwkv_ln_w'], p['rwkv_ln_b'])
    y_c = y_c * jax.nn.silu(g_c.astype(f32))
    mix = jnp.concatenate([y_a, y_b, y_c], axis=-1).astype(x.dtype)
    x_new = x + mix @ p['w_out']
    return x_new, (k, v, ssm_re, ssm_im, wkv, shift)


def setup_inputs(seed: int = 0) -> dict:
    key = jax.random.key(seed)
    keys = list(jax.random.split(key, 40))
    f32 = jnp.float32

    def nrm(shape, scale):
        return scale * jax.random.normal(keys.pop(), shape, f32)

    def unif(shape, lo, hi):
        return jax.random.uniform(keys.pop(), shape, f32, lo, hi)

    lam_im0 = math.pi * jnp.arange(SSM_STATE, dtype=f32)
    return {
        'x_prompt': nrm((BATCH, SEQ, D_MODEL), 1.0),
        'x_sample': nrm((DEC_BATCH, DEC_SEQ, D_MODEL), 1.0),
        'cache_k': nrm((DEPTH, DEC_BATCH, PAST_LEN, SB_HEADS, HEAD_DIM), 1.0),
        'cache_v': nrm((DEPTH, DEC_BATCH, PAST_LEN, SB_HEADS, HEAD_DIM), 1.0),
        'state_ssm_re': nrm((DEPTH, DEC_BATCH, SSM_GROUPS, SSM_STATE), 0.3),
        'state_ssm_im': nrm((DEPTH, DEC_BATCH, SSM_GROUPS, SSM_STATE), 0.3),
        'state_wkv': nrm((DEPTH, DEC_BATCH, RWKV_HEADS, HEAD_DIM, HEAD_DIM), 0.3),
        'state_shift': nrm((DEPTH, DEC_BATCH, RWKV_SHIFT), 1.0),
        'norm_w': 1.0 + nrm((DEPTH, D_MODEL), 0.01),
        'w_in': nrm((DEPTH, D_MODEL, D_IN), D_MODEL ** -0.5),
        'q_norm_w': 1.0 + nrm((DEPTH, HEAD_DIM), 0.01),
        'k_norm_w': 1.0 + nrm((DEPTH, HEAD_DIM), 0.01),
        'ssm_lambda_re': -0.5 + nrm((DEPTH, SSM_GROUPS, SSM_STATE), 0.01),
        'ssm_lambda_im': lam_im0 + nrm((DEPTH, SSM_GROUPS, SSM_STATE), 0.01),
        'ssm_log_dt': unif((DEPTH, SSM_GROUPS), math.log(1e-3), math.log(1e-1)),
        'ssm_b_re': nrm((DEPTH, SSM_GROUPS, SSM_STATE, SSM_GROUP), (2 * SSM_GROUP) ** -0.5),
        'ssm_b_im': nrm((DEPTH, SSM_GROUPS, SSM_STATE, SSM_GROUP), (2 * SSM_GROUP) ** -0.5),
        'ssm_c_re': nrm((DEPTH, SSM_GROUPS, SSM_GROUP, SSM_STATE), SSM_STATE ** -0.5),
        'ssm_c_im': nrm((DEPTH, SSM_GROUPS, SSM_GROUP, SSM_STATE), SSM_STATE ** -0.5),
        'ssm_d': nrm((DEPTH, SSM_GROUPS, SSM_GROUP), 1.0),
        'ssm_w_glu': nrm((DEPTH, SSM_WIDTH, 2 * SSM_WIDTH), SSM_WIDTH ** -0.5),
        'ssm_b_glu': nrm((DEPTH, 2 * SSM_WIDTH), 0.01),
        'rwkv_mu': unif((DEPTH, RWKV_SHIFT), 0.0, 1.0),
        'rwkv_w0': nrm((DEPTH, RWKV_WIDTH), 0.5),
        'rwkv_w2': nrm((DEPTH, RWKV_LORA, RWKV_WIDTH), RWKV_LORA ** -0.5),
        'rwkv_a0': nrm((DEPTH, RWKV_WIDTH), 0.1),
        'rwkv_a2': nrm((DEPTH, RWKV_LORA, RWKV_WIDTH), RWKV_LORA ** -0.5),
        'rwkv_k_k': 0.85 + nrm((DEPTH, RWKV_WIDTH), 0.01),
        'rwkv_k_a': 1.0 + nrm((DEPTH, RWKV_WIDTH), 0.01),
        'rwkv_u': nrm((DEPTH, RWKV_HEADS, HEAD_DIM), 0.1),
        'rwkv_ln_w': 1.0 + nrm((DEPTH, RWKV_WIDTH), 0.01),
        'rwkv_ln_b': nrm((DEPTH, RWKV_WIDTH), 0.01),
        'w_out': nrm((DEPTH, MIX_WIDTH, D_MODEL), MIX_WIDTH ** -0.5),
    }


def _stack(states, j):
    return jnp.stack([s[j] for s in states], axis=0)


def reference(x_prompt, x_sample, cache_k, cache_v, state_ssm_re, state_ssm_im, state_wkv, state_shift,
              norm_w, w_in, q_norm_w, k_norm_w, ssm_lambda_re, ssm_lambda_im, ssm_log_dt,
              ssm_b_re, ssm_b_im, ssm_c_re, ssm_c_im, ssm_d, ssm_w_glu, ssm_b_glu,
              rwkv_mu, rwkv_w0, rwkv_w2, rwkv_a0, rwkv_a2, rwkv_k_k, rwkv_k_a, rwkv_u,
              rwkv_ln_w, rwkv_ln_b, w_out):
    xp, xs = x_prompt, x_sample
    p_states, s_states = [], []
    for i in range(DEPTH):
        p = {
            'norm_w': norm_w[i], 'w_in': w_in[i], 'q_norm_w': q_norm_w[i], 'k_norm_w': k_norm_w[i],
            'ssm_lambda_re': ssm_lambda_re[i], 'ssm_lambda_im': ssm_lambda_im[i], 'ssm_log_dt': ssm_log_dt[i],
            'ssm_b_re': ssm_b_re[i], 'ssm_b_im': ssm_b_im[i], 'ssm_c_re': ssm_c_re[i], 'ssm_c_im': ssm_c_im[i],
            'ssm_d': ssm_d[i], 'ssm_w_glu': ssm_w_glu[i], 'ssm_b_glu': ssm_b_glu[i],
            'rwkv_mu': rwkv_mu[i], 'rwkv_w0': rwkv_w0[i], 'rwkv_w2': rwkv_w2[i], 'rwkv_a0': rwkv_a0[i],
            'rwkv_a2': rwkv_a2[i], 'rwkv_k_k': rwkv_k_k[i], 'rwkv_k_a': rwkv_k_a[i], 'rwkv_u': rwkv_u[i],
            'rwkv_ln_w': rwkv_ln_w[i], 'rwkv_ln_b': rwkv_ln_b[i], 'w_out': w_out[i],
        }
        xp, st_p = mixer_layer(xp, p, None)
        past = {'k': cache_k[i], 'v': cache_v[i], 'ssm_re': state_ssm_re[i], 'ssm_im': state_ssm_im[i],
                'wkv': state_wkv[i], 'shift': state_shift[i]}
        xs, st_s = mixer_layer(xs, p, past)
        p_states.append(st_p)
        s_states.append(st_s)
    new_k_prompt, new_v_prompt = _stack(p_states, 0), _stack(p_states, 1)
    ssm_re_prompt, ssm_im_prompt = _stack(p_states, 2), _stack(p_states, 3)
    wkv_prompt, shift_prompt = _stack(p_states, 4), _stack(p_states, 5)
    new_k_sample, new_v_sample = _stack(s_states, 0), _stack(s_states, 1)
    ssm_re_sample, ssm_im_sample = _stack(s_states, 2), _stack(s_states, 3)
    wkv_sample, shift_sample = _stack(s_states, 4), _stack(s_states, 5)
    return (xp, xs, new_k_prompt, new_v_prompt, ssm_re_prompt, ssm_im_prompt, wkv_prompt, shift_prompt,
            new_k_sample, new_v_sample, ssm_re_sample, ssm_im_sample, wkv_sample, shift_sample)
```

```cpp
#include <hip/hip_runtime.h>
#include <hip/hip_cooperative_groups.h>
#include <cstdio>
namespace cg = cooperative_groups;

#ifndef MULTI_LAUNCH
#define MULTI_LAUNCH 0
#endif

#define DI __device__ __forceinline__
typedef unsigned short bf16_t;
typedef short bf16x8 __attribute__((ext_vector_type(8)));
typedef float f32x16 __attribute__((ext_vector_type(16)));
typedef unsigned u32x4 __attribute__((ext_vector_type(4)));
typedef unsigned u32x2 __attribute__((ext_vector_type(2)));
#define MFMA(a, b, c) __builtin_amdgcn_mfma_f32_32x32x16_bf16((a), (b), (c), 0, 0, 0)

constexpr int NT = 512;
constexpr int NTOK_P = 65536, NTOK = 66048, D_IN = 3648;
constexpr int OFF_Q = 0, OFF_K = 512, OFF_V = 1024, OFF_GA = 1536, OFF_U = 2048, OFF_GB = 2304, OFF_C = 2560, OFF_GC = 3392;
constexpr size_t O_Y = 0, O_KP = 67633152, O_VP = 134742016, O_SREP = 201850880, O_SIMP = 201916416, O_WKVP = 201981952,
                 O_SHP = 203030528, O_KS = 203083776, O_VS = 203608064, O_SRES = 204132352, O_SIMS = 204165120,
                 O_WKVS = 204197888, O_SHS = 204722176, O_END = 204748800;
constexpr int SMEM_BYTES = 110592;
constexpr int LDS_ROW = 144;
constexpr int STAGE = (256 + 128) * LDS_ROW;

struct Params {
  const float *x_prompt, *x_sample, *cache_k, *cache_v, *st_re, *st_im, *st_wkv, *st_shift;
  const float *norm_w, *w_in, *q_norm_w, *k_norm_w, *lam_re, *lam_im, *log_dt, *b_re, *b_im, *c_re, *c_im, *ssm_d, *w_glu, *b_glu;
  const float *mu, *w0, *w2, *a0, *a2, *k_k, *k_a, *u_bonus, *ln_w, *ln_b, *w_out;
  float* out;
  bf16_t *WinT, *WoutT, *WgluT, *hbf, *P, *mix, *yb;
  unsigned* counters;
};

DI int opq_v(int x) { asm volatile("" : "+v"(x)); return x; }
DI int opq_s(int x) { asm volatile("" : "+s"(x)); return x; }
#define TID opq_v((int)threadIdx.x)
#define BID opq_s((int)blockIdx.x)
#define GDIM opq_s((int)gridDim.x)
DI unsigned f2bf(float x) { unsigned u = __float_as_uint(x); u += 0x7fffu + ((u >> 16) & 1u); return u >> 16; }
DI unsigned pk2(float a, float b) { return f2bf(a) | (f2bf(b) << 16); }
DI float bf2f(unsigned v) { return __uint_as_float(v << 16); }
DI float bflo(unsigned w) { return __uint_as_float(w << 16); }
DI float bfhi(unsigned w) { return __uint_as_float(w & 0xffff0000u); }
DI float sigmoidf_(float x) { return 1.f / (1.f + __expf(-x)); }
DI float siluf_(float x) { return x / (1.f + __expf(-x)); }
DI float wave_sum(float v) {
#pragma unroll
  for (int m = 32; m >= 1; m >>= 1) v += __shfl_xor(v, m);
  return v;
}
DI const float* xrow(const Params& p, int layer, int row) {
  if (layer == 0) return row < NTOK_P ? p.x_prompt + (size_t)row * 1024 : p.x_sample + (size_t)(row - NTOK_P) * 1024;
  return p.out + (size_t)row * 1024;
}

DI void transpose_tile(const float* __restrict__ src, int K, int N, bf16_t* __restrict__ dst, int k0, int n0, float* tile) {
  const int tid = TID;
#pragma unroll
  for (int i = 0; i < 8; ++i) { int idx = tid + NT * i; int kk = idx >> 6, nn = idx & 63; tile[kk * 65 + nn] = src[(size_t)(k0 + kk) * N + n0 + nn]; }
  __syncthreads();
#pragma unroll
  for (int i = 0; i < 8; ++i) { int idx = tid + NT * i; int nn = idx >> 6, kk = idx & 63; dst[(size_t)(n0 + nn) * K + k0 + kk] = (bf16_t)f2bf(tile[kk * 65 + nn]); }
  __syncthreads();
}
DI void phase_weights(const Params& p, char* smem) {
  float* tile = (float*)smem;
  const int bid = BID, gdim = GDIM;
  for (int t = bid; t < 2400; t += gdim) {
    int layer = t / 1200, j = t % 1200;
    if (j < 912) { int kt = j / 57, nt = j % 57; transpose_tile(p.w_in + (size_t)layer * 1024 * 3648, 1024, 3648, p.WinT + (size_t)layer * 3648 * 1024, kt * 64, nt * 64, tile); }
    else if (j < 1168) { j -= 912; int kt = j / 16, nt = j % 16; transpose_tile(p.w_out + (size_t)layer * 1024 * 1024, 1024, 1024, p.WoutT + (size_t)layer * 1024 * 1024, kt * 64, nt * 64, tile); }
    else { j -= 1168; int kt = j / 8, nt = j % 8; transpose_tile(p.w_glu + (size_t)layer * 256 * 512, 256, 512, p.WgluT + (size_t)layer * 512 * 256, kt * 64, nt * 64, tile); }
  }
  { const int tid = TID; if (bid == 0 && tid < 64) p.counters[tid] = 0; }
}

DI void phase_norm(const Params& p, int layer) {
  const int tid = TID, lane = tid & 63, w = tid >> 6;
  const int bid = BID, gdim = GDIM;
  const float* nw = p.norm_w + layer * 1024;
  for (int row = bid * 8 + w; row < NTOK; row += gdim * 8) {
    const float* x = xrow(p, layer, row);
    float4 v[4]; float ss = 0.f;
#pragma unroll
    for (int i = 0; i < 4; ++i) { v[i] = *(const float4*)(x + i * 256 + lane * 4); ss += v[i].x * v[i].x + v[i].y * v[i].y + v[i].z * v[i].z + v[i].w * v[i].w; }
    ss = wave_sum(ss);
    const float sc = rsqrtf(ss * (1.f / 1024.f) + 1e-6f);
#pragma unroll
    for (int i = 0; i < 4; ++i) {
      float4 wv = *(const float4*)(nw + i * 256 + lane * 4);
      u32x2 o; o.x = pk2(v[i].x * sc * wv.x, v[i].y * sc * wv.y); o.y = pk2(v[i].z * sc * wv.z, v[i].w * sc * wv.w);
      *(u32x2*)(p.hbf + (size_t)row * 1024 + i * 256 + lane * 4) = o;
    }
  }
}

template <int MODE>
DI void gemm_phase(const Params& p, int layer, char* smem) {
  constexpr int K = (MODE == 1) ? 256 : 1024;
  constexpr int NTN = (MODE == 0) ? 29 : (MODE == 1 ? 4 : 8);
  constexpr int KT = K / 64;
  const bf16_t* __restrict__ A = MODE == 0 ? p.hbf : (MODE == 1 ? p.yb : p.mix);
  const bf16_t* __restrict__ Bt = MODE == 0 ? p.WinT + (size_t)layer * 3648 * 1024 : (MODE == 1 ? p.WgluT + (size_t)layer * 512 * 256 : p.WoutT + (size_t)layer * 1024 * 1024);
  const int tid = TID, lane = tid & 63, wv = tid >> 6, r = lane & 31, h = lane >> 5;
  const int wm = wv >> 1, wn = wv & 1;
  const int bid = BID, gdim = GDIM;
  const int xcd = bid & 7, jb = bid >> 3, nbx = (gdim - xcd + 7) >> 3;

  for (int idx = jb;; idx += nbx) {
    const int tmi = idx / NTN, tn = idx % NTN, tm = xcd + 8 * tmi;
    if (tm >= 258) break;
    const int m0 = tm * 256, n0 = tn * 128;
    const int lrow = tid >> 3, kc = tid & 7;
    const bf16_t* ap[4]; const bf16_t* bp[2];
#pragma unroll
    for (int i = 0; i < 4; ++i) ap[i] = A + (size_t)(m0 + lrow + 64 * i) * K + kc * 8;
#pragma unroll
    for (int i = 0; i < 2; ++i) {
      int row = lrow + 64 * i, brow;
      if (MODE == 0) { brow = n0 + row; brow = brow < 3648 ? brow : 3647; }
      else if (MODE == 2) brow = n0 + row;
      else { int wn_ = row >> 6, nt_ = (row >> 5) & 1, c_ = row & 31; brow = nt_ * 256 + tn * 64 + wn_ * 32 + c_; }
      bp[i] = Bt + (size_t)brow * K + kc * 8;
    }
    u32x4 ra[4], rb[2];
#pragma unroll
    for (int i = 0; i < 4; ++i) ra[i] = *(const u32x4*)(ap[i]);
#pragma unroll
    for (int i = 0; i < 2; ++i) rb[i] = *(const u32x4*)(bp[i]);
    {
      char* As = smem; char* Bs = smem + 256 * LDS_ROW;
#pragma unroll
      for (int i = 0; i < 4; ++i) *(u32x4*)(As + (lrow + 64 * i) * LDS_ROW + kc * 16) = ra[i];
#pragma unroll
      for (int i = 0; i < 2; ++i) *(u32x4*)(Bs + (lrow + 64 * i) * LDS_ROW + kc * 16) = rb[i];
    }
    __syncthreads();
    f32x16 acc[2][2];
#pragma unroll
    for (int a = 0; a < 2; ++a)
#pragma unroll
      for (int b = 0; b < 2; ++b)
#pragma unroll
        for (int i = 0; i < 16; ++i) acc[a][b][i] = 0.f;

    for (int kt = 0; kt < KT; ++kt) {
      const bool more = (kt + 1 < KT);
      if (more) {
#pragma unroll
        for (int i = 0; i < 4; ++i) ra[i] = *(const u32x4*)(ap[i] + (kt + 1) * 64);
#pragma unroll
        for (int i = 0; i < 2; ++i) rb[i] = *(const u32x4*)(bp[i] + (kt + 1) * 64);
      }
      const char* As = smem + (kt & 1) * STAGE; const char* Bs = As + 256 * LDS_ROW;
#pragma unroll
      for (int s = 0; s < 4; ++s) {
        bf16x8 af[2], bfr[2];
#pragma unroll
        for (int mt = 0; mt < 2; ++mt) af[mt] = *(const bf16x8*)(As + (wm * 64 + mt * 32 + r) * LDS_ROW + s * 32 + h * 16);
#pragma unroll
        for (int nt = 0; nt < 2; ++nt) bfr[nt] = *(const bf16x8*)(Bs + (wn * 64 + nt * 32 + r) * LDS_ROW + s * 32 + h * 16);
#pragma unroll
        for (int mt = 0; mt < 2; ++mt)
#pragma unroll
          for (int nt = 0; nt < 2; ++nt) acc[mt][nt] = MFMA(bfr[nt], af[mt], acc[mt][nt]);
      }
      if (more) {
        char* As2 = smem + ((kt + 1) & 1) * STAGE; char* Bs2 = As2 + 256 * LDS_ROW;
#pragma unroll
        for (int i = 0; i < 4; ++i) *(u32x4*)(As2 + (lrow + 64 * i) * LDS_ROW + kc * 16) = ra[i];
#pragma unroll
        for (int i = 0; i < 2; ++i) *(u32x4*)(Bs2 + (lrow + 64 * i) * LDS_ROW + kc * 16) = rb[i];
      }
      __syncthreads();
    }

    if (MODE == 0) {
      const int nb = n0 + wn * 64;
      if (nb < 3648) {
        float scale[2] = {1.f, 1.f};
        if (nb < 1024) {
#pragma unroll
          for (int mt = 0; mt < 2; ++mt) {
            float ss = 0.f;
#pragma unroll
            for (int nt = 0; nt < 2; ++nt)
#pragma unroll
              for (int i = 0; i < 16; ++i) ss += acc[mt][nt][i] * acc[mt][nt][i];
            ss += __shfl_xor(ss, 32);
            scale[mt] = rsqrtf(ss * (1.f / 64.f) + 1e-6f);
          }
        }
        const float* nw = (nb < 512 ? p.q_norm_w : p.k_norm_w) + layer * 64;
#pragma unroll
        for (int mt = 0; mt < 2; ++mt) {
          const int m = m0 + wm * 64 + mt * 32 + r;
          const bool is_p = m < NTOK_P;
#pragma unroll
          for (int nt = 0; nt < 2; ++nt)
#pragma unroll
            for (int g = 0; g < 4; ++g) {
              const int ncol = nb + nt * 32 + 8 * g + 4 * h;
              float v0 = acc[mt][nt][4 * g], v1 = acc[mt][nt][4 * g + 1], v2 = acc[mt][nt][4 * g + 2], v3 = acc[mt][nt][4 * g + 3];
              if (nb < 1024) {
                float4 w4 = *(const float4*)(nw + (ncol - nb));
                v0 *= scale[mt] * w4.x; v1 *= scale[mt] * w4.y; v2 *= scale[mt] * w4.z; v3 *= scale[mt] * w4.w;
              }
              u32x2 o; o.x = pk2(v0, v1); o.y = pk2(v2, v3);
              *(u32x2*)(p.P + (size_t)m * D_IN + ncol) = o;
              if (nb >= 512 && nb < 1536) {
                float* dst;
                if (nb < 1024) dst = p.out + (is_p ? O_KP + ((size_t)layer * 65536 + m) * 512 : O_KS + ((size_t)layer * 512 + (m - NTOK_P)) * 512) + (ncol - 512);
                else dst = p.out + (is_p ? O_VP + ((size_t)layer * 65536 + m) * 512 : O_VS + ((size_t)layer * 512 + (m - NTOK_P)) * 512) + (ncol - 1024);
                *(float4*)dst = make_float4(v0, v1, v2, v3);
              }
              if (nb >= OFF_C && nb < OFF_GC) {
                const bool last = is_p ? ((m & 2047) == 2047) : (((m - NTOK_P) & 31) == 31);
                if (last) {
                  float* dst = p.out + (is_p ? O_SHP + ((size_t)layer * 32 + (m >> 11)) * 832 : O_SHS + ((size_t)layer * 16 + ((m - NTOK_P) >> 5)) * 832) + (ncol - OFF_C);
                  *(float4*)dst = make_float4(v0, v1, v2, v3);
                }
              }
            }
        }
      }
    } else if (MODE == 1) {
      const float* bg = p.b_glu + layer * 512;
#pragma unroll
      for (int mt = 0; mt < 2; ++mt) {
        const int m = m0 + wm * 64 + mt * 32 + r;
#pragma unroll
        for (int g = 0; g < 4; ++g) {
          const int col = tn * 64 + wn * 32 + 8 * g + 4 * h;
          float4 bv = *(const float4*)(bg + col), bgt = *(const float4*)(bg + 256 + col);
          u32x2 gb = *(const u32x2*)(p.P + (size_t)m * D_IN + OFF_GB + col);
          float o0 = (acc[mt][0][4 * g] + bv.x) * sigmoidf_(acc[mt][1][4 * g] + bgt.x) * siluf_(bflo(gb.x));
          float o1 = (acc[mt][0][4 * g + 1] + bv.y) * sigmoidf_(acc[mt][1][4 * g + 1] + bgt.y) * siluf_(bfhi(gb.x));
          float o2 = (acc[mt][0][4 * g + 2] + bv.z) * sigmoidf_(acc[mt][1][4 * g + 2] + bgt.z) * siluf_(bflo(gb.y));
          float o3 = (acc[mt][0][4 * g + 3] + bv.w) * sigmoidf_(acc[mt][1][4 * g + 3] + bgt.w) * siluf_(bfhi(gb.y));
          u32x2 o; o.x = pk2(o0, o1); o.y = pk2(o2, o3);
          *(u32x2*)(p.mix + (size_t)m * 1024 + 512 + col) = o;
        }
      }
    } else {
#pragma unroll
      for (int mt = 0; mt < 2; ++mt) {
        const int m = m0 + wm * 64 + mt * 32 + r;
        const float* xr = xrow(p, layer, m);
        float* orow = p.out + (size_t)m * 1024;
#pragma unroll
        for (int nt = 0; nt < 2; ++nt)
#pragma unroll
          for (int g = 0; g < 4; ++g) {
            const int ncol = n0 + wn * 64 + nt * 32 + 8 * g + 4 * h;
            float4 xv = *(const float4*)(xr + ncol);
            xv.x += acc[mt][nt][4 * g]; xv.y += acc[mt][nt][4 * g + 1]; xv.z += acc[mt][nt][4 * g + 2]; xv.w += acc[mt][nt][4 * g + 3];
            *(float4*)(orow + ncol) = xv;
          }
      }
    }
  }
}

constexpr int VS = 66;
DI void attn_item(const Params& p, int layer, int wi, bf16_t* vl) {
  const int lane = TID & 63, r = lane & 31, h = lane >> 5;
  const bool sample = wi >= 16384;
  int b, hd, qt, tok0, qabs0;
  if (!sample) { b = wi >> 9; hd = (wi >> 6) & 7; qt = wi & 63; tok0 = b * 2048; qabs0 = qt * 32; }
  else { int j = wi - 16384; b = j >> 3; hd = j & 7; qt = 0; tok0 = NTOK_P + b * 32; qabs0 = 4096; }
  const int tq0 = tok0 + qt * 32;
  bf16x8 qf[4];
  {
    const bf16_t* qp = p.P + (size_t)(tq0 + r) * D_IN + OFF_Q + hd * 64 + h * 8;
#pragma unroll
    for (int ks = 0; ks < 4; ++ks) qf[ks] = *(const bf16x8*)(qp + ks * 16);
  }
  f32x16 o[2];
#pragma unroll
  for (int d = 0; d < 2; ++d)
#pragma unroll
    for (int i = 0; i < 16; ++i) o[d][i] = 0.f;
  float run = 0.f;
  const int nblk = qabs0 / 32 + 1;
  const int pir = 16 * ((r >> 2) & 1) + 4 * (r >> 3) + (r & 3);
  const float* ck = p.cache_k + ((size_t)(layer * 16 + b) * 4096) * 512 + hd * 64;
  const float* cv = p.cache_v + ((size_t)(layer * 16 + b) * 4096) * 512 + hd * 64;

  for (int kb = nblk - 1; kb >= 0; --kb) {
    const int kp0 = kb * 32;
    const bool fromP = (!sample) || (kb == 128);
    bf16x8 kf[4];
    if (fromP) {
      const int tk = sample ? (tok0 + (kp0 + pir - 4096)) : (tok0 + kp0 + pir);
      const bf16_t* kp = p.P + (size_t)tk * D_IN + OFF_K + hd * 64 + h * 8;
#pragma unroll
      for (int ks = 0; ks < 4; ++ks) kf[ks] = *(const bf16x8*)(kp + ks * 16);
#pragma unroll
      for (int i = 0; i < 4; ++i) {
        const int key = i * 8 + (lane >> 3), dc = lane & 7;
        const int tv = sample ? (tok0 + (kp0 + key - 4096)) : (tok0 + kp0 + key);
        u32x4 v = *(const u32x4*)(p.P + (size_t)tv * D_IN + OFF_V + hd * 64 + dc * 8);
        unsigned* dst = (unsigned*)(vl + key * VS + dc * 8);
        dst[0] = v.x; dst[1] = v.y; dst[2] = v.z; dst[3] = v.w;
      }
    } else {
      const float* kp = ck + (size_t)(kp0 + pir) * 512 + h * 8;
#pragma unroll
      for (int ks = 0; ks < 4; ++ks) {
        float4 a = *(const float4*)(kp + ks * 16), c = *(const float4*)(kp + ks * 16 + 4);
        u32x4 t; t.x = pk2(a.x, a.y); t.y = pk2(a.z, a.w); t.z = pk2(c.x, c.y); t.w = pk2(c.z, c.w);
        kf[ks] = __builtin_bit_cast(bf16x8, t);
      }
#pragma unroll
      for (int i = 0; i < 4; ++i) {
        const int key = i * 8 + (lane >> 3), dc = lane & 7;
        const float* vp = cv + (size_t)(kp0 + key) * 512 + dc * 8;
        float4 a = *(const float4*)vp, c = *(const float4*)(vp + 4);
        unsigned* dst = (unsigned*)(vl + key * VS + dc * 8);
        dst[0] = pk2(a.x, a.y); dst[1] = pk2(a.z, a.w); dst[2] = pk2(c.x, c.y); dst[3] = pk2(c.z, c.w);
      }
    }
    f32x16 st;
#pragma unroll
    for (int i = 0; i < 16; ++i) st[i] = 0.f;
#pragma unroll
    for (int ks = 0; ks < 4; ++ks) st = MFMA(kf[ks], qf[ks], st);
    const bool diag = (kb == nblk - 1);
    float z[16], lk[16], lat[16];
#pragma unroll
    for (int i = 0; i < 16; ++i) {
      z[i] = st[i] * 0.125f;
      const bool msk = (!diag) || (16 * h + i < r);
      const float e = __expf(-fabsf(z[i]));
      const float sp = fmaxf(z[i], 0.f) + __logf(1.f + e);
      lk[i] = msk ? -sp : 0.f;
    }
    float suf = 0.f;
#pragma unroll
    for (int i = 15; i >= 0; --i) { lat[i] = suf; suf += lk[i]; }
    const float other = __shfl_xor(suf, 32);
    const float base = run + (h == 0 ? other : 0.f);
    float a[16];
#pragma unroll
    for (int i = 0; i < 16; ++i) {
      const bool msk = (!diag) || (16 * h + i < r);
      a[i] = msk ? __expf(z[i] + lk[i] + base + lat[i]) : 0.f;
    }
    run += suf + other;
    __builtin_amdgcn_wave_barrier();
#pragma unroll
    for (int s2 = 0; s2 < 2; ++s2) {
      u32x4 t; t.x = pk2(a[8 * s2], a[8 * s2 + 1]); t.y = pk2(a[8 * s2 + 2], a[8 * s2 + 3]); t.z = pk2(a[8 * s2 + 4], a[8 * s2 + 5]); t.w = pk2(a[8 * s2 + 6], a[8 * s2 + 7]);
      const bf16x8 pf = __builtin_bit_cast(bf16x8, t);
#pragma unroll
      for (int dt = 0; dt < 2; ++dt) {
        const bf16_t* vp = vl + (16 * h + 8 * s2) * VS + 32 * dt + r;
        bf16x8 vf;
#pragma unroll
        for (int j = 0; j < 8; ++j) vf[j] = (short)vp[j * VS];
        o[dt] = MFMA(vf, pf, o[dt]);
      }
    }
    __builtin_amdgcn_wave_barrier();
    if (__all(run < -104.f)) break;
  }
  const int tok = tq0 + r;
#pragma unroll
  for (int dt = 0; dt < 2; ++dt)
#pragma unroll
    for (int g = 0; g < 4; ++g) {
      const int d0 = 32 * dt + 8 * g + 4 * h;
      u32x2 ga = *(const u32x2*)(p.P + (size_t)tok * D_IN + OFF_GA + hd * 64 + d0);
      u32x2 ov;
      ov.x = pk2(o[dt][4 * g] * siluf_(bflo(ga.x)), o[dt][4 * g + 1] * siluf_(bfhi(ga.x)));
      ov.y = pk2(o[dt][4 * g + 2] * siluf_(bflo(ga.y)), o[dt][4 * g + 3] * siluf_(bfhi(ga.y)));
      *(u32x2*)(p.mix + (size_t)tok * 1024 + hd * 64 + d0) = ov;
    }
}

DI void s5_item(const Params& p, int layer, int item) {
  const int lane = TID & 63;
  const int seq = item >> 4, g = item & 15;
  const bool sample = seq >= 32;
  const int b = sample ? seq - 32 : seq, L = sample ? 32 : 2048, tok0 = sample ? NTOK_P + b * 32 : b * 2048;
  const int lg = layer * 16 + g;
  const float dt = expf(p.log_dt[lg]);
  const float lr = fminf(p.lam_re[lg * 64 + lane], -1e-4f), li = p.lam_im[lg * 64 + lane];
  const float er = expf(lr * dt);
  const float ar = er * cosf(li * dt), ai = er * sinf(li * dt);
  const float den = lr * lr + li * li;
  const float fr = ((ar - 1.f) * lr + ai * li) / den, fi = (ai * lr - (ar - 1.f) * li) / den;
  float bbr[16], bbi[16], cre[16], cim[16];
  {
    const float* brp = p.b_re + ((size_t)lg * 64 + lane) * 16;
    const float* bip = p.b_im + ((size_t)lg * 64 + lane) * 16;
#pragma unroll
    for (int c = 0; c < 16; ++c) { float br = brp[c], bi = bip[c]; bbr[c] = fr * br - fi * bi; bbi[c] = fr * bi + fi * br; }
#pragma unroll
    for (int c = 0; c < 16; ++c) { cre[c] = p.c_re[((size_t)lg * 16 + c) * 64 + lane]; cim[c] = p.c_im[((size_t)lg * 16 + c) * 64 + lane]; }
  }
  const int cl = ((lane >> 3) & 1) + 2 * ((lane >> 2) & 1) + 4 * ((lane >> 1) & 1) + 8 * (lane & 1);
  const float dl = p.ssm_d[lg * 16 + cl];
  float hr = 0.f, hi = 0.f;
  if (sample) { hr = p.st_re[((size_t)(layer * 16 + b) * 16 + g) * 64 + lane]; hi = p.st_im[((size_t)(layer * 16 + b) * 16 + g) * 64 + lane]; }
  for (int t = 0; t < L; ++t) {
    const bf16_t* up = p.P + (size_t)(tok0 + t) * D_IN + OFF_U + g * 16;
    const u32x4 u0 = *(const u32x4*)up, u1 = *(const u32x4*)(up + 8);
    float u[16];
    u[0] = bflo(u0.x); u[1] = bfhi(u0.x); u[2] = bflo(u0.y); u[3] = bfhi(u0.y); u[4] = bflo(u0.z); u[5] = bfhi(u0.z); u[6] = bflo(u0.w); u[7] = bfhi(u0.w);
    u[8] = bflo(u1.x); u[9] = bfhi(u1.x); u[10] = bflo(u1.y); u[11] = bfhi(u1.y); u[12] = bflo(u1.z); u[13] = bfhi(u1.z); u[14] = bflo(u1.w); u[15] = bfhi(u1.w);
    float bur = 0.f, bui = 0.f;
#pragma unroll
    for (int c = 0; c < 16; ++c) { bur += bbr[c] * u[c]; bui += bbi[c] * u[c]; }
    const float nhr = ar * hr - ai * hi + bur, nhi = ar * hi + ai * hr + bui;
    hr = nhr; hi = nhi;
    float y[16];
#pragma unroll
    for (int c = 0; c < 16; ++c) y[c] = hr * cre[c] - hi * cim[c];
    float v8[8], v4[4], v2[2], v1;
    { const bool up_ = lane & 1;
#pragma unroll
      for (int j = 0; j < 8; ++j) { float mine = up_ ? y[j + 8] : y[j], send = up_ ? y[j] : y[j + 8]; v8[j] = mine + __shfl_xor(send, 1); } }
    { const bool up_ = lane & 2;
#pragma unroll
      for (int j = 0; j < 4; ++j) { float mine = up_ ? v8[j + 4] : v8[j], send = up_ ? v8[j] : v8[j + 4]; v4[j] = mine + __shfl_xor(send, 2); } }
    { const bool up_ = lane & 4;
#pragma unroll
      for (int j = 0; j < 2; ++j) { float mine = up_ ? v4[j + 2] : v4[j], send = up_ ? v4[j] : v4[j + 2]; v2[j] = mine + __shfl_xor(send, 4); } }
    { const bool up_ = lane & 8; float mine = up_ ? v2[1] : v2[0], send = up_ ? v2[0] : v2[1]; v1 = mine + __shfl_xor(send, 8); }
    v1 += __shfl_xor(v1, 16);
    v1 += __shfl_xor(v1, 32);
    const float yv = v1 + dl * bf2f(up[cl]);
    const float gl = 0.5f * yv * (1.f + tanhf(0.7978845608f * (yv + 0.044715f * yv * yv * yv)));
    if (lane < 16) p.yb[(size_t)(tok0 + t) * 256 + g * 16 + cl] = (bf16_t)f2bf(gl);
  }
  float* ore = p.out + (sample ? O_SRES : O_SREP) + ((size_t)(layer * (sample ? 16 : 32) + b) * 16 + g) * 64 + lane;
  float* oim = p.out + (sample ? O_SIMS : O_SIMP) + ((size_t)(layer * (sample ? 16 : 32) + b) * 16 + g) * 64 + lane;
  *ore = hr; *oim = hi;
}

DI void rwkv_item(const Params& p, int layer, int item, char* smem) {
  float* R = (float*)smem; float* W = R + 2048; float* KT = W + 2048; float* KH = KT + 2048; float* BB = KH + 2048;
  float* V = BB + 2048; float* Y = V + 2048; float* LORA = Y + 2048; float* BON = LORA + 2048;
  const int tid = TID, lane = tid & 63, wv = tid >> 6;
  const int seq = item >> 2, hd = item & 3;
  const bool sample = seq >= 32;
  const int b = sample ? seq - 32 : seq, L = sample ? 32 : 2048, tok0 = sample ? NTOK_P + b * 32 : b * 2048;
  const int cg_ = hd * 64 + lane;
  float w2c[32], a2c[32];
#pragma unroll
  for (int j = 0; j < 32; ++j) { w2c[j] = p.w2[(size_t)(layer * 32 + j) * 256 + cg_]; a2c[j] = p.a2[(size_t)(layer * 32 + j) * 256 + cg_]; }
  const float w0c = p.w0[layer * 256 + cg_], a0c = p.a0[layer * 256 + cg_], kkc = p.k_k[layer * 256 + cg_], kac = p.k_a[layer * 256 + cg_];
  const float ubc = p.u_bonus[layer * 256 + cg_], lnw = p.ln_w[layer * 256 + cg_], lnb = p.ln_b[layer * 256 + cg_];
  const float* mu = p.mu + layer * 832;
  const float mu_r = mu[cg_], mu_k = mu[256 + cg_], mu_v = mu[512 + cg_], mu_l = mu[768 + lane];
  const float* shp = p.st_shift + (size_t)(layer * 16 + b) * 832;
  const int row = tid >> 3, kq = tid & 7;
  float S[8];
  if (sample) {
    const float* sp = p.st_wkv + (((size_t)(layer * 16 + b) * 4 + hd) * 64 + row) * 64 + kq * 8;
#pragma unroll
    for (int j = 0; j < 8; ++j) S[j] = sp[j];
  } else {
#pragma unroll
    for (int j = 0; j < 8; ++j) S[j] = 0.f;
  }
  for (int c0 = 0; c0 < L; c0 += 32) {
    float xr[4], xk[4], xv[4];
#pragma unroll
    for (int i = 0; i < 4; ++i) {
      const int tl = wv + 8 * i;
      const bf16_t* cp = p.P + (size_t)(tok0 + c0 + tl) * D_IN + OFF_C;
      const bool first = (c0 + tl == 0);
      float pr, pk, pv, pl;
      if (first) {
        if (sample) { pr = shp[cg_]; pk = shp[256 + cg_]; pv = shp[512 + cg_]; pl = shp[768 + lane]; }
        else { pr = 0.f; pk = 0.f; pv = 0.f; pl = 0.f; }
      } else {
        const bf16_t* pp = cp - D_IN;
        pr = bf2f(pp[cg_]); pk = bf2f(pp[256 + cg_]); pv = bf2f(pp[512 + cg_]); pl = bf2f(pp[768 + lane]);
      }
      const float c_r = bf2f(cp[cg_]), c_k = bf2f(cp[256 + cg_]), c_v = bf2f(cp[512 + cg_]), c_l = bf2f(cp[768 + lane]);
      xr[i] = c_r + mu_r * (pr - c_r); xk[i] = c_k + mu_k * (pk - c_k); xv[i] = c_v + mu_v * (pv - c_v);
      const float xl = c_l + mu_l * (pl - c_l);
      LORA[tl * 64 + lane] = lane < 32 ? tanhf(xl) : xl;
    }
    __syncthreads();
#pragma unroll
    for (int i = 0; i < 4; ++i) {
      const int tl = wv + 8 * i;
      float dsum = w0c, asum = a0c;
#pragma unroll
      for (int j = 0; j < 32; ++j) { dsum += LORA[tl * 64 + j] * w2c[j]; asum += LORA[tl * 64 + 32 + j] * a2c[j]; }
      const float dec = __expf(-0.6065306597f * sigmoidf_(dsum));
      const float a = sigmoidf_(asum);
      const float kk = xk[i] * kkc;
      const float ss = wave_sum(kk * kk);
      const float kh = kk * rsqrtf(ss + 1e-12f);
      const float kt = xk[i] * (1.f + (a - 1.f) * kac);
      const float bon = wave_sum(xr[i] * kt * ubc);
      R[tl * 64 + lane] = xr[i]; W[tl * 64 + lane] = dec; KT[tl * 64 + lane] = kt; KH[tl * 64 + lane] = kh; BB[tl * 64 + lane] = a * kh; V[tl * 64 + lane] = xv[i];
      if (lane == 0) BON[tl] = bon;
    }
    __syncthreads();
    for (int tl = 0; tl < 32; ++tl) {
      const int o = tl * 64 + kq * 8;
      const float4 kh0 = *(const float4*)(KH + o), kh1 = *(const float4*)(KH + o + 4);
      const float4 w0_ = *(const float4*)(W + o), w1_ = *(const float4*)(W + o + 4);
      const float4 b0 = *(const float4*)(BB + o), b1 = *(const float4*)(BB + o + 4);
      const float4 k0 = *(const float4*)(KT + o), k1 = *(const float4*)(KT + o + 4);
      const float4 r0 = *(const float4*)(R + o), r1 = *(const float4*)(R + o + 4);
      const float vv = V[tl * 64 + row];
      const float khv[8] = {kh0.x, kh0.y, kh0.z, kh0.w, kh1.x, kh1.y, kh1.z, kh1.w};
      const float wvv[8] = {w0_.x, w0_.y, w0_.z, w0_.w, w1_.x, w1_.y, w1_.z, w1_.w};
      const float bv[8] = {b0.x, b0.y, b0.z, b0.w, b1.x, b1.y, b1.z, b1.w};
      const float kv[8] = {k0.x, k0.y, k0.z, k0.w, k1.x, k1.y, k1.z, k1.w};
      const float rv[8] = {r0.x, r0.y, r0.z, r0.w, r1.x, r1.y, r1.z, r1.w};
      float sa = 0.f;
#pragma unroll
      for (int j = 0; j < 8; ++j) sa += S[j] * khv[j];
      sa += __shfl_xor(sa, 1); sa += __shfl_xor(sa, 2); sa += __shfl_xor(sa, 4);
      float yv = 0.f;
#pragma unroll
      for (int j = 0; j < 8; ++j) { S[j] = S[j] * wvv[j] + (vv * kv[j] - sa * bv[j]); yv += S[j] * rv[j]; }
      yv += __shfl_xor(yv, 1); yv += __shfl_xor(yv, 2); yv += __shfl_xor(yv, 4);
      if (kq == 0) Y[tl * 64 + row] = yv;
    }
    __syncthreads();
#pragma unroll
    for (int i = 0; i < 4; ++i) {
      const int tl = wv + 8 * i;
      const int tok = tok0 + c0 + tl;
      const float y = Y[tl * 64 + lane];
      const float mean = wave_sum(y) * (1.f / 64.f);
      const float d = y - mean;
      const float var = wave_sum(d * d) * (1.f / 64.f);
      float yn = d * rsqrtf(var + 64e-5f) * lnw + lnb;
      yn += BON[tl] * V[tl * 64 + lane];
      const float gate = bf2f(p.P[(size_t)tok * D_IN + OFF_GC + cg_]);
      p.mix[(size_t)tok * 1024 + 768 + cg_] = (bf16_t)f2bf(yn * siluf_(gate));
    }
    __syncthreads();
  }
  float* so = p.out + (sample ? O_WKVS : O_WKVP) + (((size_t)(layer * (sample ? 16 : 32) + b) * 4 + hd) * 64 + row) * 64 + kq * 8;
  *(float4*)so = make_float4(S[0], S[1], S[2], S[3]);
  *(float4*)(so + 4) = make_float4(S[4], S[5], S[6], S[7]);
}

DI void phase_mixers(const Params& p, int layer, char* smem) {
  __shared__ int s_item;
  const int G = GDIM, bid = BID, half = G / 2;
  const int tid = TID, wv = tid >> 6;
  if (bid < half) {
    for (int item = bid; item < 128; item += half) rwkv_item(p, layer, item, smem);
  } else {
    const int j = bid - half, nb2 = G - half;
    for (int item = 128 + j; item < 192; item += nb2) rwkv_item(p, layer, item, smem);
    if (wv < 4) { for (int it = j * 4 + wv; it < 512; it += nb2 * 4) s5_item(p, layer, it); }
    else { for (int it = 512 + j * 4 + (wv - 4); it < 768; it += nb2 * 4) s5_item(p, layer, it); }
  }
  __syncthreads();
  unsigned* ctr = p.counters + layer;
  bf16_t* vl = (bf16_t*)smem + wv * (32 * VS);
  while (true) {
    if (tid == 0) s_item = (int)atomicAdd(ctr, 1u);
    __syncthreads();
    const int it = s_item;
    __syncthreads();
    if (it >= 2064) break;
    attn_item(p, layer, it * 8 + wv, vl);
  }
}

__global__ void __launch_bounds__(NT) mega(Params p) {
  __shared__ __attribute__((aligned(16))) char smem[SMEM_BYTES];
  cg::grid_group grid = cg::this_grid();
  phase_weights(p, smem);
  phase_norm(p, 0);
  grid.sync();
  for (int layer = 0; layer < 2; ++layer) {
    if (layer == 1) { phase_norm(p, 1); grid.sync(); }
    gemm_phase<0>(p, layer, smem);
    grid.sync();
    phase_mixers(p, layer, smem);
    grid.sync();
    gemm_phase<1>(p, layer, smem);
    grid.sync();
    gemm_phase<2>(p, layer, smem);
    if (layer == 0) grid.sync();
  }
}

#if MULTI_LAUNCH
template <int PH>
__global__ void __launch_bounds__(NT) phase_kernel(Params p, int layer) {
  __shared__ __attribute__((aligned(16))) char smem[SMEM_BYTES];
  if (PH == 0) { phase_weights(p, smem); }
  else if (PH == 1) phase_norm(p, layer);
  else if (PH == 2) gemm_phase<0>(p, layer, smem);
  else if (PH == 3) phase_mixers(p, layer, smem);
  else if (PH == 4) gemm_phase<1>(p, layer, smem);
  else gemm_phase<2>(p, layer, smem);
}
#endif

extern "C" void kernel_launch(void* const* d_in, const int* in_sizes, int n_in, void* d_out, int out_size, void* d_ws, size_t ws_size, hipStream_t stream) {
  Params p{};
  const float** f = (const float**)&p;
  for (int i = 0; i < 33; ++i) f[i] = (const float*)d_in[i];
  p.out = (float*)d_out;
  char* ws = (char*)d_ws;
  size_t off = 0;
  auto take = [&](size_t bytes) { char* q = ws + off; off += (bytes + 255) & ~(size_t)255; return q; };
  p.WinT = (bf16_t*)take((size_t)2 * 3648 * 1024 * 2);
  p.WoutT = (bf16_t*)take((size_t)2 * 1024 * 1024 * 2);
  p.WgluT = (bf16_t*)take((size_t)2 * 512 * 256 * 2);
  p.hbf = (bf16_t*)take((size_t)NTOK * 1024 * 2);
  p.P = (bf16_t*)take((size_t)NTOK * D_IN * 2);
  p.mix = (bf16_t*)take((size_t)NTOK * 1024 * 2);
  p.yb = (bf16_t*)take((size_t)NTOK * 256 * 2);
  p.counters = (unsigned*)take(256);
  if (off > ws_size || (size_t)out_size != O_END || n_in != 33) fprintf(stderr, "kernel_launch: unexpected sizes ws=%zu need=%zu out=%d n_in=%d\n", ws_size, off, out_size, n_in);
#if MULTI_LAUNCH
  const int G = 256;
  phase_kernel<0><<<G, NT, 0, stream>>>(p, 0);
  for (int layer = 0; layer < 2; ++layer) {
    phase_kernel<1><<<G, NT, 0, stream>>>(p, layer);
    phase_kernel<2><<<G, NT, 0, stream>>>(p, layer);
    phase_kernel<3><<<G, NT, 0, stream>>>(p, layer);
    phase_kernel<4><<<G, NT, 0, stream>>>(p, layer);
    phase_kernel<5><<<G, NT, 0, stream>>>(p, layer);
  }
#else
  static int grid_blocks = 0;
  if (!grid_blocks) {
    int dev = 0, cus = 0, per_cu = 0;
    hipGetDevice(&dev);
    hipDeviceGetAttribute(&cus, hipDeviceAttributeMultiprocessorCount, dev);
    hipOccupancyMaxActiveBlocksPerMultiprocessor(&per_cu, mega, NT, 0);
    if (per_cu < 1) per_cu = 1;
    grid_blocks = cus * per_cu;
  }
  void* args[] = {&p};
  hipError_t e = hipLaunchCooperativeKernel((void*)mega, dim3(grid_blocks), dim3(NT), args, 0, stream);
  if (e != hipSuccess) fprintf(stderr, "cooperative launch failed: %s (grid %d)\n", hipGetErrorString(e), grid_blocks);
#endif
}
```

```cpp
#include <hip/hip_runtime.h>
#include <hip/hip_cooperative_groups.h>
#include <cstdio>
namespace cg = cooperative_groups;

#ifndef MULTI_LAUNCH
#define MULTI_LAUNCH 0
#endif

#define DI __device__ __forceinline__
typedef unsigned short bf16_t;
typedef short bf16x8 __attribute__((ext_vector_type(8)));
typedef float f32x16 __attribute__((ext_vector_type(16)));
typedef unsigned u32x4 __attribute__((ext_vector_type(4)));
typedef unsigned u32x2 __attribute__((ext_vector_type(2)));
#define MFMA(a, b, c) __builtin_amdgcn_mfma_f32_32x32x16_bf16((a), (b), (c), 0, 0, 0)

constexpr int NT = 512;
constexpr int NTOK_P = 65536, NTOK = 66048, D_IN = 3648;
constexpr int OFF_Q = 0, OFF_K = 512, OFF_V = 1024, OFF_GA = 1536, OFF_U = 2048, OFF_GB = 2304, OFF_C = 2560, OFF_GC = 3392;
constexpr size_t O_Y = 0, O_KP = 67633152, O_VP = 134742016, O_SREP = 201850880, O_SIMP = 201916416, O_WKVP = 201981952,
                 O_SHP = 203030528, O_KS = 203083776, O_VS = 203608064, O_SRES = 204132352, O_SIMS = 204165120,
                 O_WKVS = 204197888, O_SHS = 204722176, O_END = 204748800;
constexpr int SMEM_BYTES = 4 * 26112 + 8 * 4224;
constexpr int LDS_ROW = 144;
constexpr int STAGE = (256 + 128) * LDS_ROW;

struct Params {
  const float *x_prompt, *x_sample, *cache_k, *cache_v, *st_re, *st_im, *st_wkv, *st_shift;
  const float *norm_w, *w_in, *q_norm_w, *k_norm_w, *lam_re, *lam_im, *log_dt, *b_re, *b_im, *c_re, *c_im, *ssm_d, *w_glu, *b_glu;
  const float *mu, *w0, *w2, *a0, *a2, *k_k, *k_a, *u_bonus, *ln_w, *ln_b, *w_out;
  float* out;
  bf16_t *WinT, *WoutT, *WgluT, *hbf, *P, *mix, *yb;
  unsigned* counters;
};

DI int opq_v(int x) { asm volatile("" : "+v"(x)); return x; }
DI int opq_s(int x) { asm volatile("" : "+s"(x)); return x; }
#define TID opq_v((int)threadIdx.x)
#define BID opq_s((int)blockIdx.x)
#define GDIM opq_s((int)gridDim.x)
DI unsigned f2bf(float x) { unsigned u = __float_as_uint(x); u += 0x7fffu + ((u >> 16) & 1u); return u >> 16; }
DI unsigned pk2(float a, float b) { return f2bf(a) | (f2bf(b) << 16); }
DI float bf2f(unsigned v) { return __uint_as_float(v << 16); }
DI float bflo(unsigned w) { return __uint_as_float(w << 16); }
DI float bfhi(unsigned w) { return __uint_as_float(w & 0xffff0000u); }
DI float sigmoidf_(float x) { return 1.f / (1.f + __expf(-x)); }
DI float siluf_(float x) { return x / (1.f + __expf(-x)); }
DI float wave_sum(float v) {
#pragma unroll
  for (int m = 32; m >= 1; m >>= 1) v += __shfl_xor(v, m);
  return v;
}
DI const float* xrow(const Params& p, int layer, int row) {
  if (layer == 0) return row < NTOK_P ? p.x_prompt + (size_t)row * 1024 : p.x_sample + (size_t)(row - NTOK_P) * 1024;
  return p.out + (size_t)row * 1024;
}

DI void transpose_tile(const float* __restrict__ src, int K, int N, bf16_t* __restrict__ dst, int k0, int n0, float* tile) {
  const int tid = TID;
#pragma unroll
  for (int i = 0; i < 8; ++i) { int idx = tid + NT * i; int kk = idx >> 6, nn = idx & 63; tile[kk * 65 + nn] = src[(size_t)(k0 + kk) * N + n0 + nn]; }
  __syncthreads();
#pragma unroll
  for (int i = 0; i < 8; ++i) { int idx = tid + NT * i; int nn = idx >> 6, kk = idx & 63; dst[(size_t)(n0 + nn) * K + k0 + kk] = (bf16_t)f2bf(tile[kk * 65 + nn]); }
  __syncthreads();
}
DI void phase_weights(const Params& p, char* smem) {
  float* tile = (float*)smem;
  const int bid = BID, gdim = GDIM;
  for (int t = bid; t < 2400; t += gdim) {
    int layer = t / 1200, j = t % 1200;
    if (j < 912) { int kt = j / 57, nt = j % 57; transpose_tile(p.w_in + (size_t)layer * 1024 * 3648, 1024, 3648, p.WinT + (size_t)layer * 3648 * 1024, kt * 64, nt * 64, tile); }
    else if (j < 1168) { j -= 912; int kt = j / 16, nt = j % 16; transpose_tile(p.w_out + (size_t)layer * 1024 * 1024, 1024, 1024, p.WoutT + (size_t)layer * 1024 * 1024, kt * 64, nt * 64, tile); }
    else { j -= 1168; int kt = j / 8, nt = j % 8; transpose_tile(p.w_glu + (size_t)layer * 256 * 512, 256, 512, p.WgluT + (size_t)layer * 512 * 256, kt * 64, nt * 64, tile); }
  }
  { const int tid = TID; if (bid == 0 && tid < 64) p.counters[tid] = 0; }
}

DI void phase_norm(const Params& p, int layer) {
  const int tid = TID, lane = tid & 63, w = tid >> 6;
  const int bid = BID, gdim = GDIM;
  const float* nw = p.norm_w + layer * 1024;
  for (int row = bid * 8 + w; row < NTOK; row += gdim * 8) {
    const float* x = xrow(p, layer, row);
    float4 v[4]; float ss = 0.f;
#pragma unroll
    for (int i = 0; i < 4; ++i) { v[i] = *(const float4*)(x + i * 256 + lane * 4); ss += v[i].x * v[i].x + v[i].y * v[i].y + v[i].z * v[i].z + v[i].w * v[i].w; }
    ss = wave_sum(ss);
    const float sc = rsqrtf(ss * (1.f / 1024.f) + 1e-6f);
#pragma unroll
    for (int i = 0; i < 4; ++i) {
      float4 wv = *(const float4*)(nw + i * 256 + lane * 4);
      u32x2 o; o.x = pk2(v[i].x * sc * wv.x, v[i].y * sc * wv.y); o.y = pk2(v[i].z * sc * wv.z, v[i].w * sc * wv.w);
      *(u32x2*)(p.hbf + (size_t)row * 1024 + i * 256 + lane * 4) = o;
    }
  }
}

template <int MODE>
DI void gemm_phase(const Params& p, int layer, char* smem) {
  constexpr int K = (MODE == 1) ? 256 : 1024;
  constexpr int NTN = (MODE == 0) ? 29 : (MODE == 1 ? 4 : 8);
  constexpr int KT = K / 64;
  const bf16_t* __restrict__ A = MODE == 0 ? p.hbf : (MODE == 1 ? p.yb : p.mix);
  const bf16_t* __restrict__ Bt = MODE == 0 ? p.WinT + (size_t)layer * 3648 * 1024 : (MODE == 1 ? p.WgluT + (size_t)layer * 512 * 256 : p.WoutT + (size_t)layer * 1024 * 1024);
  const int tid = TID, lane = tid & 63, wv = tid >> 6, r = lane & 31, h = lane >> 5;
  const int wm = wv >> 1, wn = wv & 1;
  const int bid = BID, gdim = GDIM;
  const int xcd = bid & 7, jb = bid >> 3, nbx = (gdim - xcd + 7) >> 3;

  for (int idx = jb;; idx += nbx) {
    const int tmi = idx / NTN, tn = idx % NTN, tm = xcd + 8 * tmi;
    if (tm >= 258) break;
    const int m0 = tm * 256, n0 = tn * 128;
    const int lrow = tid >> 3, kc = tid & 7;
    const bf16_t* ap[4]; const bf16_t* bp[2];
#pragma unroll
    for (int i = 0; i < 4; ++i) ap[i] = A + (size_t)(m0 + lrow + 64 * i) * K + kc * 8;
#pragma unroll
    for (int i = 0; i < 2; ++i) {
      int row = lrow + 64 * i, brow;
      if (MODE == 0) { brow = n0 + row; brow = brow < 3648 ? brow : 3647; }
      else if (MODE == 2) brow = n0 + row;
      else { int wn_ = row >> 6, nt_ = (row >> 5) & 1, c_ = row & 31; brow = nt_ * 256 + tn * 64 + wn_ * 32 + c_; }
      bp[i] = Bt + (size_t)brow * K + kc * 8;
    }
    u32x4 ra[4], rb[2];
#pragma unroll
    for (int i = 0; i < 4; ++i) ra[i] = *(const u32x4*)(ap[i]);
#pragma unroll
    for (int i = 0; i < 2; ++i) rb[i] = *(const u32x4*)(bp[i]);
    {
      char* As = smem; char* Bs = smem + 256 * LDS_ROW;
#pragma unroll
      for (int i = 0; i < 4; ++i) *(u32x4*)(As + (lrow + 64 * i) * LDS_ROW + kc * 16) = ra[i];
#pragma unroll
      for (int i = 0; i < 2; ++i) *(u32x4*)(Bs + (lrow + 64 * i) * LDS_ROW + kc * 16) = rb[i];
    }
    __syncthreads();
    f32x16 acc[2][2];
#pragma unroll
    for (int a = 0; a < 2; ++a)
#pragma unroll
      for (int b = 0; b < 2; ++b)
#pragma unroll
        for (int i = 0; i < 16; ++i) acc[a][b][i] = 0.f;

    for (int kt = 0; kt < KT; ++kt) {
      const bool more = (kt + 1 < KT);
      if (more) {
#pragma unroll
        for (int i = 0; i < 4; ++i) ra[i] = *(const u32x4*)(ap[i] + (kt + 1) * 64);
#pragma unroll
        for (int i = 0; i < 2; ++i) rb[i] = *(const u32x4*)(bp[i] + (kt + 1) * 64);
      }
      const char* As = smem + (kt & 1) * STAGE; const char* Bs = As + 256 * LDS_ROW;
#pragma unroll
      for (int s = 0; s < 4; ++s) {
        bf16x8 af[2], bfr[2];
#pragma unroll
        for (int mt = 0; mt < 2; ++mt) af[mt] = *(const bf16x8*)(As + (wm * 64 + mt * 32 + r) * LDS_ROW + s * 32 + h * 16);
#pragma unroll
        for (int nt = 0; nt < 2; ++nt) bfr[nt] = *(const bf16x8*)(Bs + (wn * 64 + nt * 32 + r) * LDS_ROW + s * 32 + h * 16);
#pragma unroll
        for (int mt = 0; mt < 2; ++mt)
#pragma unroll
          for (int nt = 0; nt < 2; ++nt) acc[mt][nt] = MFMA(bfr[nt], af[mt], acc[mt][nt]);
      }
      if (more) {
        char* As2 = smem + ((kt + 1) & 1) * STAGE; char* Bs2 = As2 + 256 * LDS_ROW;
#pragma unroll
        for (int i = 0; i < 4; ++i) *(u32x4*)(As2 + (lrow + 64 * i) * LDS_ROW + kc * 16) = ra[i];
#pragma unroll
        for (int i = 0; i < 2; ++i) *(u32x4*)(Bs2 + (lrow + 64 * i) * LDS_ROW + kc * 16) = rb[i];
      }
      __syncthreads();
    }

    if (MODE == 0) {
      const int nb = n0 + wn * 64;
      if (nb < 3648) {
        float scale[2] = {1.f, 1.f};
        if (nb < 1024) {
#pragma unroll
          for (int mt = 0; mt < 2; ++mt) {
            float ss = 0.f;
#pragma unroll
            for (int nt = 0; nt < 2; ++nt)
#pragma unroll
              for (int i = 0; i < 16; ++i) ss += acc[mt][nt][i] * acc[mt][nt][i];
            ss += __shfl_xor(ss, 32);
            scale[mt] = rsqrtf(ss * (1.f / 64.f) + 1e-6f);
          }
        }
        const float* nw = (nb < 512 ? p.q_norm_w : p.k_norm_w) + layer * 64;
#pragma unroll
        for (int mt = 0; mt < 2; ++mt) {
          const int m = m0 + wm * 64 + mt * 32 + r;
          const bool is_p = m < NTOK_P;
#pragma unroll
          for (int nt = 0; nt < 2; ++nt)
#pragma unroll
            for (int g = 0; g < 4; ++g) {
              const int ncol = nb + nt * 32 + 8 * g + 4 * h;
              float v0 = acc[mt][nt][4 * g], v1 = acc[mt][nt][4 * g + 1], v2 = acc[mt][nt][4 * g + 2], v3 = acc[mt][nt][4 * g + 3];
              if (nb < 1024) {
                float4 w4 = *(const float4*)(nw + (ncol - nb));
                v0 *= scale[mt] * w4.x; v1 *= scale[mt] * w4.y; v2 *= scale[mt] * w4.z; v3 *= scale[mt] * w4.w;
              }
              u32x2 o; o.x = pk2(v0, v1); o.y = pk2(v2, v3);
              *(u32x2*)(p.P + (size_t)m * D_IN + ncol) = o;
              if (nb >= 512 && nb < 1536) {
                float* dst;
                if (nb < 1024) dst = p.out + (is_p ? O_KP + ((size_t)layer * 65536 + m) * 512 : O_KS + ((size_t)layer * 512 + (m - NTOK_P)) * 512) + (ncol - 512);
                else dst = p.out + (is_p ? O_VP + ((size_t)layer * 65536 + m) * 512 : O_VS + ((size_t)layer * 512 + (m - NTOK_P)) * 512) + (ncol - 1024);
                *(float4*)dst = make_float4(v0, v1, v2, v3);
              }
              if (nb >= OFF_C && nb < OFF_GC) {
                const bool last = is_p ? ((m & 2047) == 2047) : (((m - NTOK_P) & 31) == 31);
                if (last) {
                  float* dst = p.out + (is_p ? O_SHP + ((size_t)layer * 32 + (m >> 11)) * 832 : O_SHS + ((size_t)layer * 16 + ((m - NTOK_P) >> 5)) * 832) + (ncol - OFF_C);
                  *(float4*)dst = make_float4(v0, v1, v2, v3);
                }
              }
            }
        }
      }
    } else if (MODE == 1) {
      const float* bg = p.b_glu + layer * 512;
#pragma unroll
      for (int mt = 0; mt < 2; ++mt) {
        const int m = m0 + wm * 64 + mt * 32 + r;
#pragma unroll
        for (int g = 0; g < 4; ++g) {
          const int col = tn * 64 + wn * 32 + 8 * g + 4 * h;
          float4 bv = *(const float4*)(bg + col), bgt = *(const float4*)(bg + 256 + col);
          u32x2 gb = *(const u32x2*)(p.P + (size_t)m * D_IN + OFF_GB + col);
          float o0 = (acc[mt][0][4 * g] + bv.x) * sigmoidf_(acc[mt][1][4 * g] + bgt.x) * siluf_(bflo(gb.x));
          float o1 = (acc[mt][0][4 * g + 1] + bv.y) * sigmoidf_(acc[mt][1][4 * g + 1] + bgt.y) * siluf_(bfhi(gb.x));
          float o2 = (acc[mt][0][4 * g + 2] + bv.z) * sigmoidf_(acc[mt][1][4 * g + 2] + bgt.z) * siluf_(bflo(gb.y));
          float o3 = (acc[mt][0][4 * g + 3] + bv.w) * sigmoidf_(acc[mt][1][4 * g + 3] + bgt.w) * siluf_(bfhi(gb.y));
          u32x2 o; o.x = pk2(o0, o1); o.y = pk2(o2, o3);
          *(u32x2*)(p.mix + (size_t)m * 1024 + 512 + col) = o;
        }
      }
    } else {
#pragma unroll
      for (int mt = 0; mt < 2; ++mt) {
        const int m = m0 + wm * 64 + mt * 32 + r;
        const float* xr = xrow(p, layer, m);
        float* orow = p.out + (size_t)m * 1024;
#pragma unroll
        for (int nt = 0; nt < 2; ++nt)
#pragma unroll
          for (int g = 0; g < 4; ++g) {
            const int ncol = n0 + wn * 64 + nt * 32 + 8 * g + 4 * h;
            float4 xv = *(const float4*)(xr + ncol);
            xv.x += acc[mt][nt][4 * g]; xv.y += acc[mt][nt][4 * g + 1]; xv.z += acc[mt][nt][4 * g + 2]; xv.w += acc[mt][nt][4 * g + 3];
            *(float4*)(orow + ncol) = xv;
          }
      }
    }
  }
}

constexpr int VS = 66;
DI void attn_item(const Params& p, int layer, int wi, bf16_t* vl) {
  const int lane = TID & 63, r = lane & 31, h = lane >> 5;
  const bool sample = wi >= 16384;
  int b, hd, qt, tok0, qabs0;
  if (!sample) { b = wi >> 9; hd = (wi >> 6) & 7; qt = wi & 63; tok0 = b * 2048; qabs0 = qt * 32; }
  else { int j = wi - 16384; b = j >> 3; hd = j & 7; qt = 0; tok0 = NTOK_P + b * 32; qabs0 = 4096; }
  const int tq0 = tok0 + qt * 32;
  bf16x8 qf[4];
  {
    const bf16_t* qp = p.P + (size_t)(tq0 + r) * D_IN + OFF_Q + hd * 64 + h * 8;
#pragma unroll
    for (int ks = 0; ks < 4; ++ks) qf[ks] = *(const bf16x8*)(qp + ks * 16);
  }
  f32x16 o[2];
#pragma unroll
  for (int d = 0; d < 2; ++d)
#pragma unroll
    for (int i = 0; i < 16; ++i) o[d][i] = 0.f;
  float run = 0.f;
  const int nblk = qabs0 / 32 + 1;
  const int pir = 16 * ((r >> 2) & 1) + 4 * (r >> 3) + (r & 3);
  const float* ck = p.cache_k + ((size_t)(layer * 16 + b) * 4096) * 512 + hd * 64;
  const float* cv = p.cache_v + ((size_t)(layer * 16 + b) * 4096) * 512 + hd * 64;

  for (int kb = nblk - 1; kb >= 0; --kb) {
    const int kp0 = kb * 32;
    const bool fromP = (!sample) || (kb == 128);
    bf16x8 kf[4];
    if (fromP) {
      const int tk = sample ? (tok0 + (kp0 + pir - 4096)) : (tok0 + kp0 + pir);
      const bf16_t* kp = p.P + (size_t)tk * D_IN + OFF_K + hd * 64 + h * 8;
#pragma unroll
      for (int ks = 0; ks < 4; ++ks) kf[ks] = *(const bf16x8*)(kp + ks * 16);
#pragma unroll
      for (int i = 0; i < 4; ++i) {
        const int key = i * 8 + (lane >> 3), dc = lane & 7;
        const int tv = sample ? (tok0 + (kp0 + key - 4096)) : (tok0 + kp0 + key);
        u32x4 v = *(const u32x4*)(p.P + (size_t)tv * D_IN + OFF_V + hd * 64 + dc * 8);
        unsigned* dst = (unsigned*)(vl + key * VS + dc * 8);
        dst[0] = v.x; dst[1] = v.y; dst[2] = v.z; dst[3] = v.w;
      }
    } else {
      const float* kp = ck + (size_t)(kp0 + pir) * 512 + h * 8;
#pragma unroll
      for (int ks = 0; ks < 4; ++ks) {
        float4 a = *(const float4*)(kp + ks * 16), c = *(const float4*)(kp + ks * 16 + 4);
        u32x4 t; t.x = pk2(a.x, a.y); t.y = pk2(a.z, a.w); t.z = pk2(c.x, c.y); t.w = pk2(c.z, c.w);
        kf[ks] = __builtin_bit_cast(bf16x8, t);
      }
#pragma unroll
      for (int i = 0; i < 4; ++i) {
        const int key = i * 8 + (lane >> 3), dc = lane & 7;
        const float* vp = cv + (size_t)(kp0 + key) * 512 + dc * 8;
        float4 a = *(const float4*)vp, c = *(const float4*)(vp + 4);
        unsigned* dst = (unsigned*)(vl + key * VS + dc * 8);
        dst[0] = pk2(a.x, a.y); dst[1] = pk2(a.z, a.w); dst[2] = pk2(c.x, c.y); dst[3] = pk2(c.z, c.w);
      }
    }
    f32x16 st;
#pragma unroll
    for (int i = 0; i < 16; ++i) st[i] = 0.f;
#pragma unroll
    for (int ks = 0; ks < 4; ++ks) st = MFMA(kf[ks], qf[ks], st);
    const bool diag = (kb == nblk - 1);
    float z[16], lk[16], lat[16];
#pragma unroll
    for (int i = 0; i < 16; ++i) {
      z[i] = st[i] * 0.125f;
      const bool msk = (!diag) || (16 * h + i < r);
      const float e = __expf(-fabsf(z[i]));
      const float sp = fmaxf(z[i], 0.f) + __logf(1.f + e);
      lk[i] = msk ? -sp : 0.f;
    }
    float suf = 0.f;
#pragma unroll
    for (int i = 15; i >= 0; --i) { lat[i] = suf; suf += lk[i]; }
    const float other = __shfl_xor(suf, 32);
    const float base = run + (h == 0 ? other : 0.f);
    float a[16];
#pragma unroll
    for (int i = 0; i < 16; ++i) {
      const bool msk = (!diag) || (16 * h + i < r);
      a[i] = msk ? __expf(z[i] + lk[i] + base + lat[i]) : 0.f;
    }
    run += suf + other;
    __builtin_amdgcn_wave_barrier();
#pragma unroll
    for (int s2 = 0; s2 < 2; ++s2) {
      u32x4 t; t.x = pk2(a[8 * s2], a[8 * s2 + 1]); t.y = pk2(a[8 * s2 + 2], a[8 * s2 + 3]); t.z = pk2(a[8 * s2 + 4], a[8 * s2 + 5]); t.w = pk2(a[8 * s2 + 6], a[8 * s2 + 7]);
      const bf16x8 pf = __builtin_bit_cast(bf16x8, t);
#pragma unroll
      for (int dt = 0; dt < 2; ++dt) {
        const bf16_t* vp = vl + (16 * h + 8 * s2) * VS + 32 * dt + r;
        bf16x8 vf;
#pragma unroll
        for (int j = 0; j < 8; ++j) vf[j] = (short)vp[j * VS];
        o[dt] = MFMA(vf, pf, o[dt]);
      }
    }
    __builtin_amdgcn_wave_barrier();
    if (__all(run < -104.f)) break;
  }
  const int tok = tq0 + r;
#pragma unroll
  for (int dt = 0; dt < 2; ++dt)
#pragma unroll
    for (int g = 0; g < 4; ++g) {
      const int d0 = 32 * dt + 8 * g + 4 * h;
      u32x2 ga = *(const u32x2*)(p.P + (size_t)tok * D_IN + OFF_GA + hd * 64 + d0);
      u32x2 ov;
      ov.x = pk2(o[dt][4 * g] * siluf_(bflo(ga.x)), o[dt][4 * g + 1] * siluf_(bfhi(ga.x)));
      ov.y = pk2(o[dt][4 * g + 2] * siluf_(bflo(ga.y)), o[dt][4 * g + 3] * siluf_(bfhi(ga.y)));
      *(u32x2*)(p.mix + (size_t)tok * 1024 + hd * 64 + d0) = ov;
    }
}

constexpr int S5_LDS = 16384 + 8704 + 1024;
DI void s5_disc(const Params& p, int lg, int pi, float dt, float& ar, float& ai, float& fr, float& fi) {
  const float lr = fminf(p.lam_re[lg * 64 + pi], -1e-4f), li = p.lam_im[lg * 64 + pi];
  const float er = expf(lr * dt);
  ar = er * cosf(li * dt); ai = er * sinf(li * dt);
  const float den = lr * lr + li * li;
  fr = ((ar - 1.f) * lr + ai * li) / den; fi = (ai * lr - (ar - 1.f) * li) / den;
}
DI void s5_item(const Params& p, int layer, int item, char* lds) {
  float* BU = (float*)lds;
  char* Himg = lds + 16384;
  bf16_t* Ub = (bf16_t*)(lds + 16384 + 8704);
  const int lane = TID & 63, r = lane & 31, h = lane >> 5;
  const int seq = item >> 4, g = item & 15;
  const bool sample = seq >= 32;
  const int b = sample ? seq - 32 : seq, L = sample ? 32 : 2048, tok0 = sample ? NTOK_P + b * 32 : b * 2048;
  const int lg = layer * 16 + g;
  const float dt = expf(p.log_dt[lg]);
  float ar, ai, fr_, fi_;
  s5_disc(p, lg, lane, dt, ar, ai, fr_, fi_);
  bf16x8 bbf[4];
#pragma unroll
  for (int half = 0; half < 2; ++half) {
    const int pi = 32 * half + r;
    float a_r, a_i, f_r, f_i;
    s5_disc(p, lg, pi, dt, a_r, a_i, f_r, f_i);
    const float* brp = p.b_re + ((size_t)lg * 64 + pi) * 16 + 8 * h;
    const float* bip = p.b_im + ((size_t)lg * 64 + pi) * 16 + 8 * h;
    float re[8], im[8];
#pragma unroll
    for (int j = 0; j < 8; ++j) { const float br = brp[j], bi = bip[j]; re[j] = f_r * br - f_i * bi; im[j] = f_r * bi + f_i * br; }
    u32x4 t0, t1;
    t0.x = pk2(re[0], re[1]); t0.y = pk2(re[2], re[3]); t0.z = pk2(re[4], re[5]); t0.w = pk2(re[6], re[7]);
    t1.x = pk2(im[0], im[1]); t1.y = pk2(im[2], im[3]); t1.z = pk2(im[4], im[5]); t1.w = pk2(im[6], im[7]);
    bbf[half] = __builtin_bit_cast(bf16x8, t0);
    bbf[2 + half] = __builtin_bit_cast(bf16x8, t1);
  }
  bf16x8 cf[8];
#pragma unroll
  for (int s = 0; s < 8; ++s) {
    u32x4 t; t.x = 0; t.y = 0; t.z = 0; t.w = 0;
    if (r < 16) {
      const int k0 = 16 * s + 8 * h;
      const float* src = (s < 4 ? p.c_re : p.c_im) + ((size_t)lg * 16 + r) * 64 + (k0 & 63);
      const float sg = s < 4 ? 1.f : -1.f;
      const float4 c0 = *(const float4*)src, c1 = *(const float4*)(src + 4);
      t.x = pk2(sg * c0.x, sg * c0.y); t.y = pk2(sg * c0.z, sg * c0.w); t.z = pk2(sg * c1.x, sg * c1.y); t.w = pk2(sg * c1.z, sg * c1.w);
    }
    cf[s] = __builtin_bit_cast(bf16x8, t);
  }
  const float dl = p.ssm_d[lg * 16 + (r & 15)];
  float hr = 0.f, hi = 0.f;
  if (sample) { hr = p.st_re[((size_t)(layer * 16 + b) * 16 + g) * 64 + lane]; hi = p.st_im[((size_t)(layer * 16 + b) * 16 + g) * 64 + lane]; }
  f32x16 zero;
#pragma unroll
  for (int i = 0; i < 16; ++i) zero[i] = 0.f;
  const bf16_t* upb = p.P + (size_t)(tok0 + r) * D_IN + OFF_U + g * 16 + 8 * h;
  bf16x8 uf = *(const bf16x8*)upb;
  for (int t0 = 0; t0 < L; t0 += 32) {
    const bf16x8 ucur = uf;
    if (t0 + 32 < L) uf = *(const bf16x8*)(upb + (size_t)(t0 + 32) * D_IN);
    *(bf16x8*)(Ub + r * 16 + 8 * h) = ucur;
#pragma unroll
    for (int tile = 0; tile < 4; ++tile) {
      const f32x16 d = MFMA(ucur, bbf[tile], zero);
#pragma unroll
      for (int i = 0; i < 16; ++i) BU[((i & 3) + 8 * (i >> 2) + 4 * h) * 128 + 32 * tile + r] = d[i];
    }
    __builtin_amdgcn_wave_barrier();
#pragma unroll 8
    for (int t = 0; t < 32; ++t) {
      const float bur = BU[t * 128 + lane], bui = BU[t * 128 + 64 + lane];
      const float nhr = ar * hr - ai * hi + bur, nhi = ar * hi + ai * hr + bui;
      hr = nhr; hi = nhi;
      *(bf16_t*)(Himg + t * 272 + lane * 2) = (bf16_t)f2bf(hr);
      *(bf16_t*)(Himg + t * 272 + 128 + lane * 2) = (bf16_t)f2bf(hi);
    }
    __builtin_amdgcn_wave_barrier();
    f32x16 yacc = zero;
#pragma unroll
    for (int s = 0; s < 8; ++s) {
      const bf16x8 af = *(const bf16x8*)(Himg + r * 272 + s * 32 + h * 16);
      yacc = MFMA(af, cf[s], yacc);
    }
    if (r < 16) {
#pragma unroll
      for (int i = 0; i < 16; ++i) {
        const int t = (i & 3) + 8 * (i >> 2) + 4 * h;
        const float yv = yacc[i] + dl * bf2f(Ub[t * 16 + r]);
        const float gl = yv / (1.f + __expf(-1.5957691216f * (yv + 0.044715f * yv * yv * yv)));
        p.yb[(size_t)(tok0 + t0 + t) * 256 + g * 16 + r] = (bf16_t)f2bf(gl);
      }
    }
    __builtin_amdgcn_wave_barrier();
  }
  float* ore = p.out + (sample ? O_SRES : O_SREP) + ((size_t)(layer * (sample ? 16 : 32) + b) * 16 + g) * 64 + lane;
  float* oim = p.out + (sample ? O_SIMS : O_SIMP) + ((size_t)(layer * (sample ? 16 : 32) + b) * 16 + g) * 64 + lane;
  *ore = hr; *oim = hi;
}

DI void rwkv_item(const Params& p, int layer, int item, char* smem) {
  float* R = (float*)smem; float* W = R + 2048; float* KT = W + 2048; float* KH = KT + 2048; float* BB = KH + 2048;
  float* V = BB + 2048; float* Y = V + 2048; float* LORA = Y + 2048; float* BON = LORA + 2048;
  const int tid = TID, lane = tid & 63, wv = tid >> 6;
  const int seq = item >> 2, hd = item & 3;
  const bool sample = seq >= 32;
  const int b = sample ? seq - 32 : seq, L = sample ? 32 : 2048, tok0 = sample ? NTOK_P + b * 32 : b * 2048;
  const int cg_ = hd * 64 + lane;
  float w2c[32], a2c[32];
#pragma unroll
  for (int j = 0; j < 32; ++j) { w2c[j] = p.w2[(size_t)(layer * 32 + j) * 256 + cg_]; a2c[j] = p.a2[(size_t)(layer * 32 + j) * 256 + cg_]; }
  const float w0c = p.w0[layer * 256 + cg_], a0c = p.a0[layer * 256 + cg_], kkc = p.k_k[layer * 256 + cg_], kac = p.k_a[layer * 256 + cg_];
  const float ubc = p.u_bonus[layer * 256 + cg_], lnw = p.ln_w[layer * 256 + cg_], lnb = p.ln_b[layer * 256 + cg_];
  const float* mu = p.mu + layer * 832;
  const float mu_r = mu[cg_], mu_k = mu[256 + cg_], mu_v = mu[512 + cg_], mu_l = mu[768 + lane];
  const float* shp = p.st_shift + (size_t)(layer * 16 + b) * 832;
  const int row = tid >> 3, kq = tid & 7;
  float S[8];
  if (sample) {
    const float* sp = p.st_wkv + (((size_t)(layer * 16 + b) * 4 + hd) * 64 + row) * 64 + kq * 8;
#pragma unroll
    for (int j = 0; j < 8; ++j) S[j] = sp[j];
  } else {
#pragma unroll
    for (int j = 0; j < 8; ++j) S[j] = 0.f;
  }
  for (int c0 = 0; c0 < L; c0 += 32) {
    float xr[4], xk[4], xv[4];
#pragma unroll
    for (int i = 0; i < 4; ++i) {
      const int tl = wv + 8 * i;
      const bf16_t* cp = p.P + (size_t)(tok0 + c0 + tl) * D_IN + OFF_C;
      const bool first = (c0 + tl == 0);
      float pr, pk, pv, pl;
      if (first) {
        if (sample) { pr = shp[cg_]; pk = shp[256 + cg_]; pv = shp[512 + cg_]; pl = shp[768 + lane]; }
        else { pr = 0.f; pk = 0.f; pv = 0.f; pl = 0.f; }
      } else {
        const bf16_t* pp = cp - D_IN;
        pr = bf2f(pp[cg_]); pk = bf2f(pp[256 + cg_]); pv = bf2f(pp[512 + cg_]); pl = bf2f(pp[768 + lane]);
      }
      const float c_r = bf2f(cp[cg_]), c_k = bf2f(cp[256 + cg_]), c_v = bf2f(cp[512 + cg_]), c_l = bf2f(cp[768 + lane]);
      xr[i] = c_r + mu_r * (pr - c_r); xk[i] = c_k + mu_k * (pk - c_k); xv[i] = c_v + mu_v * (pv - c_v);
      const float xl = c_l + mu_l * (pl - c_l);
      LORA[tl * 64 + lane] = lane < 32 ? tanhf(xl) : xl;
    }
    __syncthreads();
#pragma unroll
    for (int i = 0; i < 4; ++i) {
      const int tl = wv + 8 * i;
      float dsum = w0c, asum = a0c;
#pragma unroll
      for (int j = 0; j < 32; ++j) { dsum += LORA[tl * 64 + j] * w2c[j]; asum += LORA[tl * 64 + 32 + j] * a2c[j]; }
      const float dec = __expf(-0.6065306597f * sigmoidf_(dsum));
      const float a = sigmoidf_(asum);
      const float kk = xk[i] * kkc;
      const float ss = wave_sum(kk * kk);
      const float kh = kk * rsqrtf(ss + 1e-12f);
      const float kt = xk[i] * (1.f + (a - 1.f) * kac);
      const float bon = wave_sum(xr[i] * kt * ubc);
      R[tl * 64 + lane] = xr[i]; W[tl * 64 + lane] = dec; KT[tl * 64 + lane] = kt; KH[tl * 64 + lane] = kh; BB[tl * 64 + lane] = a * kh; V[tl * 64 + lane] = xv[i];
      if (lane == 0) BON[tl] = bon;
    }
    __syncthreads();
    for (int tl = 0; tl < 32; ++tl) {
      const int o = tl * 64 + kq * 8;
      const float4 kh0 = *(const float4*)(KH + o), kh1 = *(const float4*)(KH + o + 4);
      const float4 w0_ = *(const float4*)(W + o), w1_ = *(const float4*)(W + o + 4);
      const float4 b0 = *(const float4*)(BB + o), b1 = *(const float4*)(BB + o + 4);
      const float4 k0 = *(const float4*)(KT + o), k1 = *(const float4*)(KT + o + 4);
      const float4 r0 = *(const float4*)(R + o), r1 = *(const float4*)(R + o + 4);
      const float vv = V[tl * 64 + row];
      const float khv[8] = {kh0.x, kh0.y, kh0.z, kh0.w, kh1.x, kh1.y, kh1.z, kh1.w};
      const float wvv[8] = {w0_.x, w0_.y, w0_.z, w0_.w, w1_.x, w1_.y, w1_.z, w1_.w};
      const float bv[8] = {b0.x, b0.y, b0.z, b0.w, b1.x, b1.y, b1.z, b1.w};
      const float kv[8] = {k0.x, k0.y, k0.z, k0.w, k1.x, k1.y, k1.z, k1.w};
      const float rv[8] = {r0.x, r0.y, r0.z, r0.w, r1.x, r1.y, r1.z, r1.w};
      float sa = 0.f;
#pragma unroll
      for (int j = 0; j < 8; ++j) sa += S[j] * khv[j];
      sa += __shfl_xor(sa, 1); sa += __shfl_xor(sa, 2); sa += __shfl_xor(sa, 4);
      float yv = 0.f;
#pragma unroll
      for (int j = 0; j < 8; ++j) { S[j] = S[j] * wvv[j] + (vv * kv[j] - sa * bv[j]); yv += S[j] * rv[j]; }
      yv += __shfl_xor(yv, 1); yv += __shfl_xor(yv, 2); yv += __shfl_xor(yv, 4);
      if (kq == 0) Y[tl * 64 + row] = yv;
    }
    __syncthreads();
#pragma unroll
    for (int i = 0; i < 4; ++i) {
      const int tl = wv + 8 * i;
      const int tok = tok0 + c0 + tl;
      const float y = Y[tl * 64 + lane];
      const float mean = wave_sum(y) * (1.f / 64.f);
      const float d = y - mean;
      const float var = wave_sum(d * d) * (1.f / 64.f);
      float yn = d * rsqrtf(var + 64e-5f) * lnw + lnb;
      yn += BON[tl] * V[tl * 64 + lane];
      const float gate = bf2f(p.P[(size_t)tok * D_IN + OFF_GC + cg_]);
      p.mix[(size_t)tok * 1024 + 768 + cg_] = (bf16_t)f2bf(yn * siluf_(gate));
    }
    __syncthreads();
  }
  float* so = p.out + (sample ? O_WKVS : O_WKVP) + (((size_t)(layer * (sample ? 16 : 32) + b) * 4 + hd) * 64 + row) * 64 + kq * 8;
  *(float4*)so = make_float4(S[0], S[1], S[2], S[3]);
  *(float4*)(so + 4) = make_float4(S[4], S[5], S[6], S[7]);
}

constexpr int ATT_LDS0 = 4 * S5_LDS;
DI void phase_mixers(const Params& p, int layer, char* smem) {
  const int G = GDIM, bid = BID, half = G / 2;
  const int tid = TID, wv = tid >> 6, lane = tid & 63;
  if (bid < half) {
    for (int item = bid; item < 128; item += half) rwkv_item(p, layer, item, smem);
  } else {
    const int j = bid - half, nb2 = G - half;
    for (int item = 128 + j; item < 192; item += nb2) rwkv_item(p, layer, item, smem);
    if (wv < 4) { for (int it = j * 4 + wv; it < 768; it += nb2 * 4) s5_item(p, layer, it, smem + wv * S5_LDS); }
  }
  unsigned* ctr = p.counters + layer;
  bf16_t* vl = (bf16_t*)(smem + ATT_LDS0) + wv * (32 * VS);
  while (true) {
    int it = 0;
    if (lane == 0) it = (int)atomicAdd(ctr, 1u);
    it = __builtin_amdgcn_readfirstlane(it);
    if (it >= 16512) break;
    attn_item(p, layer, it, vl);
  }
}

__global__ void __launch_bounds__(NT) mega(Params p) {
  __shared__ __attribute__((aligned(16))) char smem[SMEM_BYTES];
  cg::grid_group grid = cg::this_grid();
  phase_weights(p, smem);
  phase_norm(p, 0);
  grid.sync();
  for (int layer = 0; layer < 2; ++layer) {
    if (layer == 1) { phase_norm(p, 1); grid.sync(); }
    gemm_phase<0>(p, layer, smem);
    grid.sync();
    phase_mixers(p, layer, smem);
    grid.sync();
    gemm_phase<1>(p, layer, smem);
    grid.sync();
    gemm_phase<2>(p, layer, smem);
    if (layer == 0) grid.sync();
  }
}

#if MULTI_LAUNCH
template <int PH>
__global__ void __launch_bounds__(NT) phase_kernel(Params p, int layer) {
  __shared__ __attribute__((aligned(16))) char smem[SMEM_BYTES];
  if (PH == 0) { phase_weights(p, smem); }
  else if (PH == 1) phase_norm(p, layer);
  else if (PH == 2) gemm_phase<0>(p, layer, smem);
  else if (PH == 3) phase_mixers(p, layer, smem);
  else if (PH == 4) gemm_phase<1>(p, layer, smem);
  else gemm_phase<2>(p, layer, smem);
}
#endif

extern "C" void kernel_launch(void* const* d_in, const int* in_sizes, int n_in, void* d_out, int out_size, void* d_ws, size_t ws_size, hipStream_t stream) {
  Params p{};
  const float** f = (const float**)&p;
  for (int i = 0; i < 33; ++i) f[i] = (const float*)d_in[i];
  p.out = (float*)d_out;
  char* ws = (char*)d_ws;
  size_t off = 0;
  auto take = [&](size_t bytes) { char* q = ws + off; off += (bytes + 255) & ~(size_t)255; return q; };
  p.WinT = (bf16_t*)take((size_t)2 * 3648 * 1024 * 2);
  p.WoutT = (bf16_t*)take((size_t)2 * 1024 * 1024 * 2);
  p.WgluT = (bf16_t*)take((size_t)2 * 512 * 256 * 2);
  p.hbf = (bf16_t*)take((size_t)NTOK * 1024 * 2);
  p.P = (bf16_t*)take((size_t)NTOK * D_IN * 2);
  p.mix = (bf16_t*)take((size_t)NTOK * 1024 * 2);
  p.yb = (bf16_t*)take((size_t)NTOK * 256 * 2);
  p.counters = (unsigned*)take(256);
  if (off > ws_size || (size_t)out_size != O_END || n_in != 33) fprintf(stderr, "kernel_launch: unexpected sizes ws=%zu need=%zu out=%d n_in=%d\n", ws_size, off, out_size, n_in);
#if MULTI_LAUNCH
  const int G = 256;
  phase_kernel<0><<<G, NT, 0, stream>>>(p, 0);
  for (int layer = 0; layer < 2; ++layer) {
    phase_kernel<1><<<G, NT, 0, stream>>>(p, layer);
    phase_kernel<2><<<G, NT, 0, stream>>>(p, layer);
    phase_kernel<3><<<G, NT, 0, stream>>>(p, layer);
    phase_kernel<4><<<G, NT, 0, stream>>>(p, layer);
    phase_kernel<5><<<G, NT, 0, stream>>>(p, layer);
  }
#else
  static int grid_blocks = 0;
  if (!grid_blocks) {
    int dev = 0, cus = 0, per_cu = 0;
    hipGetDevice(&dev);
    hipDeviceGetAttribute(&cus, hipDeviceAttributeMultiprocessorCount, dev);
    hipOccupancyMaxActiveBlocksPerMultiprocessor(&per_cu, mega, NT, 0);
    if (per_cu < 1) per_cu = 1;
    grid_blocks = cus * per_cu;
  }
  void* args[] = {&p};
  hipError_t e = hipLaunchCooperativeKernel((void*)mega, dim3(grid_blocks), dim3(NT), args, 0, stream);
  if (e != hipSuccess) fprintf(stderr, "cooperative launch failed: %s (grid %d)\n", hipGetErrorString(e), grid_blocks);
#endif
}
```

```cpp
#include <hip/hip_runtime.h>
#include <hip/hip_cooperative_groups.h>
#include <cstdio>
namespace cg = cooperative_groups;

#define PROBE_GEMM0 0
#define PROBE_MIX 0
#ifndef MULTI_LAUNCH
#define MULTI_LAUNCH 0
#endif

#define DI __device__ __forceinline__
typedef unsigned short bf16_t;
typedef short bf16x8 __attribute__((ext_vector_type(8)));
typedef float f32x16 __attribute__((ext_vector_type(16)));
typedef unsigned u32x4 __attribute__((ext_vector_type(4)));
typedef unsigned u32x2 __attribute__((ext_vector_type(2)));
#define MFMA(a, b, c) __builtin_amdgcn_mfma_f32_32x32x16_bf16((a), (b), (c), 0, 0, 0)

constexpr int NT = 512;
constexpr int NTOK_P = 65536, NTOK = 66048, D_IN = 3648;
constexpr int OFF_Q = 0, OFF_K = 512, OFF_V = 1024, OFF_GA = 1536, OFF_U = 2048, OFF_GB = 2304, OFF_C = 2560, OFF_GC = 3392;
constexpr size_t O_Y = 0, O_KP = 67633152, O_VP = 134742016, O_SREP = 201850880, O_SIMP = 201916416, O_WKVP = 201981952,
                 O_SHP = 203030528, O_KS = 203083776, O_VS = 203608064, O_SRES = 204132352, O_SIMS = 204165120,
                 O_WKVS = 204197888, O_SHS = 204722176, O_END = 204748800;
constexpr int SMEM_BYTES = 6 * 17920 + 8 * 4224;
constexpr int LDS_ROW = 144;
constexpr int STAGE = (256 + 128) * LDS_ROW;

struct Params {
  const float *x_prompt, *x_sample, *cache_k, *cache_v, *st_re, *st_im, *st_wkv, *st_shift;
  const float *norm_w, *w_in, *q_norm_w, *k_norm_w, *lam_re, *lam_im, *log_dt, *b_re, *b_im, *c_re, *c_im, *ssm_d, *w_glu, *b_glu;
  const float *mu, *w0, *w2, *a0, *a2, *k_k, *k_a, *u_bonus, *ln_w, *ln_b, *w_out;
  float* out;
  bf16_t *WinT, *WoutT, *WgluT, *hbf, *P, *mix, *yb;
  unsigned* counters;
};

DI int opq_v(int x) { asm volatile("" : "+v"(x)); return x; }
DI int opq_s(int x) { asm volatile("" : "+s"(x)); return x; }
#define TID opq_v((int)threadIdx.x)
#define BID opq_s((int)blockIdx.x)
#define GDIM opq_s((int)gridDim.x)
DI unsigned f2bf(float x) { unsigned u = __float_as_uint(x); u += 0x7fffu + ((u >> 16) & 1u); return u >> 16; }
DI unsigned pk2(float a, float b) { return f2bf(a) | (f2bf(b) << 16); }
DI float bf2f(unsigned v) { return __uint_as_float(v << 16); }
DI float bflo(unsigned w) { return __uint_as_float(w << 16); }
DI float bfhi(unsigned w) { return __uint_as_float(w & 0xffff0000u); }
DI float sigmoidf_(float x) { return 1.f / (1.f + __expf(-x)); }
DI float siluf_(float x) { return x / (1.f + __expf(-x)); }
typedef float f32x2 __attribute__((ext_vector_type(2)));
DI f32x2 fma2(f32x2 a, f32x2 b, f32x2 c) { return __builtin_elementwise_fma(a, b, c); }
template <int CTRL> DI float dpp_mov(float x) { return __int_as_float(__builtin_amdgcn_update_dpp(0, __float_as_int(x), CTRL, 0xF, 0xF, true)); }
DI float sum8(float x) { x += dpp_mov<0xB1>(x); x += dpp_mov<0x4E>(x); x += dpp_mov<0x141>(x); return x; }
DI float fast_tanh(float x) { return 1.f - 2.f / (1.f + __expf(2.f * x)); }
DI void lds_barrier() { asm volatile("s_waitcnt lgkmcnt(0)\n\ts_barrier" ::: "memory"); }
DI float wave_sum(float v) {
#pragma unroll
  for (int m = 32; m >= 1; m >>= 1) v += __shfl_xor(v, m);
  return v;
}
DI const float* xrow(const Params& p, int layer, int row) {
  if (layer == 0) return row < NTOK_P ? p.x_prompt + (size_t)row * 1024 : p.x_sample + (size_t)(row - NTOK_P) * 1024;
  return p.out + (size_t)row * 1024;
}

DI void transpose_tile(const float* __restrict__ src, int K, int N, bf16_t* __restrict__ dst, int k0, int n0, float* tile) {
  const int tid = TID;
#pragma unroll
  for (int i = 0; i < 8; ++i) { int idx = tid + NT * i; int kk = idx >> 6, nn = idx & 63; tile[kk * 65 + nn] = src[(size_t)(k0 + kk) * N + n0 + nn]; }
  __syncthreads();
#pragma unroll
  for (int i = 0; i < 8; ++i) { int idx = tid + NT * i; int nn = idx >> 6, kk = idx & 63; dst[(size_t)(n0 + nn) * K + k0 + kk] = (bf16_t)f2bf(tile[kk * 65 + nn]); }
  __syncthreads();
}
DI void phase_weights(const Params& p, char* smem) {
  float* tile = (float*)smem;
  const int bid = BID, gdim = GDIM;
  for (int t = bid; t < 2400; t += gdim) {
    int layer = t / 1200, j = t % 1200;
    if (j < 912) { int kt = j / 57, nt = j % 57; transpose_tile(p.w_in + (size_t)layer * 1024 * 3648, 1024, 3648, p.WinT + (size_t)layer * 3648 * 1024, kt * 64, nt * 64, tile); }
    else if (j < 1168) { j -= 912; int kt = j / 16, nt = j % 16; transpose_tile(p.w_out + (size_t)layer * 1024 * 1024, 1024, 1024, p.WoutT + (size_t)layer * 1024 * 1024, kt * 64, nt * 64, tile); }
    else { j -= 1168; int kt = j / 8, nt = j % 8; transpose_tile(p.w_glu + (size_t)layer * 256 * 512, 256, 512, p.WgluT + (size_t)layer * 512 * 256, kt * 64, nt * 64, tile); }
  }
  { const int tid = TID; if (bid == 0 && tid < 64) p.counters[tid] = 0; }
}

DI void phase_norm(const Params& p, int layer) {
  const int tid = TID, lane = tid & 63, w = tid >> 6;
  const int bid = BID, gdim = GDIM;
  const float* nw = p.norm_w + layer * 1024;
  for (int row = bid * 8 + w; row < NTOK; row += gdim * 8) {
    const float* x = xrow(p, layer, row);
    float4 v[4]; float ss = 0.f;
#pragma unroll
    for (int i = 0; i < 4; ++i) { v[i] = *(const float4*)(x + i * 256 + lane * 4); ss += v[i].x * v[i].x + v[i].y * v[i].y + v[i].z * v[i].z + v[i].w * v[i].w; }
    ss = wave_sum(ss);
    const float sc = rsqrtf(ss * (1.f / 1024.f) + 1e-6f);
#pragma unroll
    for (int i = 0; i < 4; ++i) {
      float4 wv = *(const float4*)(nw + i * 256 + lane * 4);
      u32x2 o; o.x = pk2(v[i].x * sc * wv.x, v[i].y * sc * wv.y); o.y = pk2(v[i].z * sc * wv.z, v[i].w * sc * wv.w);
      *(u32x2*)(p.hbf + (size_t)row * 1024 + i * 256 + lane * 4) = o;
    }
  }
}

template <int MODE>
DI void gemm_phase(const Params& p, int layer, char* smem) {
  constexpr int K = (MODE == 1) ? 256 : 1024;
  constexpr int NTN = (MODE == 0) ? 29 : (MODE == 1 ? 4 : 8);
  constexpr int KT = K / 64;
  const bf16_t* __restrict__ A = MODE == 0 ? p.hbf : (MODE == 1 ? p.yb : p.mix);
  const bf16_t* __restrict__ Bt = MODE == 0 ? p.WinT + (size_t)layer * 3648 * 1024 : (MODE == 1 ? p.WgluT + (size_t)layer * 512 * 256 : p.WoutT + (size_t)layer * 1024 * 1024);
  const int tid = TID, lane = tid & 63, wv = tid >> 6, r = lane & 31, h = lane >> 5;
  const int wm = wv >> 1, wn = wv & 1;
  const int bid = BID, gdim = GDIM;
  const int xcd = bid & 7, jb = bid >> 3, nbx = (gdim - xcd + 7) >> 3;

  const int total_x = ((258 - xcd + 7) >> 3) * NTN;
  const int nmine = jb < total_x ? (total_x - jb + nbx - 1) / nbx : 0;
  if (nmine == 0) return;
  const int lrow = tid >> 3, kc = tid & 7;
  auto set_ptrs = [&](int idx, const bf16_t* (&ap)[4], const bf16_t* (&bp)[2]) {
    const int tmi_ = idx / NTN, tn_ = idx % NTN, m0_ = (xcd + 8 * tmi_) * 256, n0_ = tn_ * 128;
#pragma unroll
    for (int i = 0; i < 4; ++i) ap[i] = A + (size_t)(m0_ + lrow + 64 * i) * K + kc * 8;
#pragma unroll
    for (int i = 0; i < 2; ++i) {
      int row = lrow + 64 * i, brow;
      if (MODE == 0) { brow = n0_ + row; brow = brow < 3648 ? brow : 3647; }
      else if (MODE == 2) brow = n0_ + row;
      else { int wn_ = row >> 6, nt_ = (row >> 5) & 1, c_ = row & 31; brow = nt_ * 256 + tn_ * 64 + wn_ * 32 + c_; }
      bp[i] = Bt + (size_t)brow * K + kc * 8;
    }
  };
  f32x16 acc[2][2];
  auto zero_acc = [&]() {
#pragma unroll
    for (int a = 0; a < 2; ++a)
#pragma unroll
      for (int b = 0; b < 2; ++b)
#pragma unroll
        for (int i = 0; i < 16; ++i) acc[a][b][i] = 0.f;
  };
  auto compute = [&](const char* buf, char* nbuf, const u32x4 (&pa)[4], const u32x4 (&pb)[2]) {
    const char* As = buf; const char* Bs = buf + 256 * LDS_ROW;
    char* An = nbuf; char* Bn = nbuf + 256 * LDS_ROW;
#pragma unroll
    for (int s = 0; s < 4; ++s) {
      bf16x8 af[2], bfr[2];
#pragma unroll
      for (int mt = 0; mt < 2; ++mt) af[mt] = *(const bf16x8*)(As + (wm * 64 + mt * 32 + r) * LDS_ROW + s * 32 + h * 16);
#pragma unroll
      for (int nt = 0; nt < 2; ++nt) bfr[nt] = *(const bf16x8*)(Bs + (wn * 64 + nt * 32 + r) * LDS_ROW + s * 32 + h * 16);
#pragma unroll
      for (int mt = 0; mt < 2; ++mt)
#pragma unroll
        for (int nt = 0; nt < 2; ++nt) acc[mt][nt] = MFMA(bfr[nt], af[mt], acc[mt][nt]);
      if (s < 2) {
        *(u32x4*)(An + (lrow + 64 * (2 * s)) * LDS_ROW + kc * 16) = pa[2 * s];
        *(u32x4*)(An + (lrow + 64 * (2 * s + 1)) * LDS_ROW + kc * 16) = pa[2 * s + 1];
      } else {
        *(u32x4*)(Bn + (lrow + 64 * (s - 2)) * LDS_ROW + kc * 16) = pb[s - 2];
      }
    }
  };
  u32x4 sa[4][4], sb[4][2];
  const bf16_t* cap[4]; const bf16_t* cbp[2]; const bf16_t* nap[4]; const bf16_t* nbp[2];
  set_ptrs(jb, cap, cbp);
#pragma unroll
  for (int j = 0; j < 4; ++j) {
#pragma unroll
    for (int i = 0; i < 4; ++i) sa[j][i] = *(const u32x4*)(cap[i] + j * 64);
#pragma unroll
    for (int i = 0; i < 2; ++i) sb[j][i] = *(const u32x4*)(cbp[i] + j * 64);
  }
  {
    char* As = smem; char* Bs = smem + 256 * LDS_ROW;
#pragma unroll
    for (int i = 0; i < 4; ++i) *(u32x4*)(As + (lrow + 64 * i) * LDS_ROW + kc * 16) = sa[0][i];
#pragma unroll
    for (int i = 0; i < 2; ++i) *(u32x4*)(Bs + (lrow + 64 * i) * LDS_ROW + kc * 16) = sb[0][i];
  }
  lds_barrier();
  zero_acc();
  int c_idx = jb;
  for (int ti = 0; ti < nmine; ++ti) {
    set_ptrs(ti + 1 < nmine ? c_idx + nbx : c_idx, nap, nbp);
    for (int q = 0; q < KT / 4; ++q) {
      const bool lastq = (q == KT / 4 - 1);
      const int koff = lastq ? 0 : (4 * (q + 1)) * 64;
      const bf16_t* lap[4]; const bf16_t* lbp[2];
#pragma unroll
      for (int i = 0; i < 4; ++i) lap[i] = (lastq ? nap[i] : cap[i]) + koff;
#pragma unroll
      for (int i = 0; i < 2; ++i) lbp[i] = (lastq ? nbp[i] : cbp[i]) + koff;
#pragma unroll
      for (int j = 0; j < 4; ++j) {
#pragma unroll
        for (int i = 0; i < 4; ++i) sa[j][i] = *(const u32x4*)(lap[i] + j * 64);
#pragma unroll
        for (int i = 0; i < 2; ++i) sb[j][i] = *(const u32x4*)(lbp[i] + j * 64);
        compute(smem + (j & 1) * STAGE, smem + ((j + 1) & 1) * STAGE, sa[(j + 1) & 3], sb[(j + 1) & 3]);
        lds_barrier();
      }
    }
#pragma unroll
    for (int i = 0; i < 4; ++i) cap[i] = nap[i];
#pragma unroll
    for (int i = 0; i < 2; ++i) cbp[i] = nbp[i];
    const int idx = c_idx; c_idx += nbx;
    const int tmi = idx / NTN, tn = idx % NTN, tm = xcd + 8 * tmi;
    const int m0 = tm * 256, n0 = tn * 128;
    if (MODE == 0) {
      const int nb = n0 + wn * 64;
      if (nb < 3648) {
        float scale[2] = {1.f, 1.f};
        if (nb < 1024) {
#pragma unroll
          for (int mt = 0; mt < 2; ++mt) {
            float ss = 0.f;
#pragma unroll
            for (int nt = 0; nt < 2; ++nt)
#pragma unroll
              for (int i = 0; i < 16; ++i) ss += acc[mt][nt][i] * acc[mt][nt][i];
            ss += __shfl_xor(ss, 32);
            scale[mt] = rsqrtf(ss * (1.f / 64.f) + 1e-6f);
          }
        }
        const float* nw = (nb < 512 ? p.q_norm_w : p.k_norm_w) + layer * 64;
#pragma unroll
        for (int mt = 0; mt < 2; ++mt) {
          const int m = m0 + wm * 64 + mt * 32 + r;
          const bool is_p = m < NTOK_P;
#pragma unroll
          for (int nt = 0; nt < 2; ++nt)
#pragma unroll
            for (int g = 0; g < 4; ++g) {
              const int ncol = nb + nt * 32 + 8 * g + 4 * h;
              float v0 = acc[mt][nt][4 * g], v1 = acc[mt][nt][4 * g + 1], v2 = acc[mt][nt][4 * g + 2], v3 = acc[mt][nt][4 * g + 3];
              if (nb < 1024) {
                float4 w4 = *(const float4*)(nw + (ncol - nb));
                v0 *= scale[mt] * w4.x; v1 *= scale[mt] * w4.y; v2 *= scale[mt] * w4.z; v3 *= scale[mt] * w4.w;
              }
              u32x2 o; o.x = pk2(v0, v1); o.y = pk2(v2, v3);
              *(u32x2*)(p.P + (size_t)m * D_IN + ncol) = o;
              if (nb >= 512 && nb < 1536) {
                float* dst;
                if (nb < 1024) dst = p.out + (is_p ? O_KP + ((size_t)layer * 65536 + m) * 512 : O_KS + ((size_t)layer * 512 + (m - NTOK_P)) * 512) + (ncol - 512);
                else dst = p.out + (is_p ? O_VP + ((size_t)layer * 65536 + m) * 512 : O_VS + ((size_t)layer * 512 + (m - NTOK_P)) * 512) + (ncol - 1024);
                *(float4*)dst = make_float4(v0, v1, v2, v3);
              }
              if (nb >= OFF_C && nb < OFF_GC) {
                const bool last = is_p ? ((m & 2047) == 2047) : (((m - NTOK_P) & 31) == 31);
                if (last) {
                  float* dst = p.out + (is_p ? O_SHP + ((size_t)layer * 32 + (m >> 11)) * 832 : O_SHS + ((size_t)layer * 16 + ((m - NTOK_P) >> 5)) * 832) + (ncol - OFF_C);
                  *(float4*)dst = make_float4(v0, v1, v2, v3);
                }
              }
            }
        }
      }
    } else if (MODE == 1) {
      const float* bg = p.b_glu + layer * 512;
#pragma unroll
      for (int mt = 0; mt < 2; ++mt) {
        const int m = m0 + wm * 64 + mt * 32 + r;
#pragma unroll
        for (int g = 0; g < 4; ++g) {
          const int col = tn * 64 + wn * 32 + 8 * g + 4 * h;
          float4 bv = *(const float4*)(bg + col), bgt = *(const float4*)(bg + 256 + col);
          u32x2 gb = *(const u32x2*)(p.P + (size_t)m * D_IN + OFF_GB + col);
          float o0 = (acc[mt][0][4 * g] + bv.x) * sigmoidf_(acc[mt][1][4 * g] + bgt.x) * siluf_(bflo(gb.x));
          float o1 = (acc[mt][0][4 * g + 1] + bv.y) * sigmoidf_(acc[mt][1][4 * g + 1] + bgt.y) * siluf_(bfhi(gb.x));
          float o2 = (acc[mt][0][4 * g + 2] + bv.z) * sigmoidf_(acc[mt][1][4 * g + 2] + bgt.z) * siluf_(bflo(gb.y));
          float o3 = (acc[mt][0][4 * g + 3] + bv.w) * sigmoidf_(acc[mt][1][4 * g + 3] + bgt.w) * siluf_(bfhi(gb.y));
          u32x2 o; o.x = pk2(o0, o1); o.y = pk2(o2, o3);
          *(u32x2*)(p.mix + (size_t)m * 1024 + 512 + col) = o;
        }
      }
    } else {
#pragma unroll
      for (int mt = 0; mt < 2; ++mt) {
        const int m = m0 + wm * 64 + mt * 32 + r;
        const float* xr = xrow(p, layer, m);
        float* orow = p.out + (size_t)m * 1024;
#pragma unroll
        for (int nt = 0; nt < 2; ++nt)
#pragma unroll
          for (int g = 0; g < 4; ++g) {
            const int ncol = n0 + wn * 64 + nt * 32 + 8 * g + 4 * h;
            float4 xv = *(const float4*)(xr + ncol);
            xv.x += acc[mt][nt][4 * g]; xv.y += acc[mt][nt][4 * g + 1]; xv.z += acc[mt][nt][4 * g + 2]; xv.w += acc[mt][nt][4 * g + 3];
            *(float4*)(orow + ncol) = xv;
          }
      }
    }
    zero_acc();
  }
}

constexpr int VS = 66;
DI void attn_item(const Params& p, int layer, int wi, bf16_t* vl) {
  const int lane = TID & 63, r = lane & 31, h = lane >> 5;
  const bool sample = wi >= 16384;
  int b, hd, qt, tok0, qabs0;
  if (!sample) { b = wi >> 9; hd = (wi >> 6) & 7; qt = wi & 63; tok0 = b * 2048; qabs0 = qt * 32; }
  else { int j = wi - 16384; b = j >> 3; hd = j & 7; qt = 0; tok0 = NTOK_P + b * 32; qabs0 = 4096; }
  const int tq0 = tok0 + qt * 32;
  bf16x8 qf[4];
  {
    const bf16_t* qp = p.P + (size_t)(tq0 + r) * D_IN + OFF_Q + hd * 64 + h * 8;
#pragma unroll
    for (int ks = 0; ks < 4; ++ks) qf[ks] = *(const bf16x8*)(qp + ks * 16);
  }
  f32x16 o[2];
#pragma unroll
  for (int d = 0; d < 2; ++d)
#pragma unroll
    for (int i = 0; i < 16; ++i) o[d][i] = 0.f;
  float run = 0.f;
  const int nblk = qabs0 / 32 + 1;
  const int pir = 16 * ((r >> 2) & 1) + 4 * (r >> 3) + (r & 3);
  const float* ck = p.cache_k + ((size_t)(layer * 16 + b) * 4096) * 512 + hd * 64;
  const float* cv = p.cache_v + ((size_t)(layer * 16 + b) * 4096) * 512 + hd * 64;

  for (int kb = nblk - 1; kb >= 0; --kb) {
    const int kp0 = kb * 32;
    const bool fromP = (!sample) || (kb == 128);
    bf16x8 kf[4];
    if (fromP) {
      const int tk = sample ? (tok0 + (kp0 + pir - 4096)) : (tok0 + kp0 + pir);
      const bf16_t* kp = p.P + (size_t)tk * D_IN + OFF_K + hd * 64 + h * 8;
#pragma unroll
      for (int ks = 0; ks < 4; ++ks) kf[ks] = *(const bf16x8*)(kp + ks * 16);
#pragma unroll
      for (int i = 0; i < 4; ++i) {
        const int key = i * 8 + (lane >> 3), dc = lane & 7;
        const int tv = sample ? (tok0 + (kp0 + key - 4096)) : (tok0 + kp0 + key);
        u32x4 v = *(const u32x4*)(p.P + (size_t)tv * D_IN + OFF_V + hd * 64 + dc * 8);
        unsigned* dst = (unsigned*)(vl + key * VS + dc * 8);
        dst[0] = v.x; dst[1] = v.y; dst[2] = v.z; dst[3] = v.w;
      }
    } else {
      const float* kp = ck + (size_t)(kp0 + pir) * 512 + h * 8;
#pragma unroll
      for (int ks = 0; ks < 4; ++ks) {
        float4 a = *(const float4*)(kp + ks * 16), c = *(const float4*)(kp + ks * 16 + 4);
        u32x4 t; t.x = pk2(a.x, a.y); t.y = pk2(a.z, a.w); t.z = pk2(c.x, c.y); t.w = pk2(c.z, c.w);
        kf[ks] = __builtin_bit_cast(bf16x8, t);
      }
#pragma unroll
      for (int i = 0; i < 4; ++i) {
        const int key = i * 8 + (lane >> 3), dc = lane & 7;
        const float* vp = cv + (size_t)(kp0 + key) * 512 + dc * 8;
        float4 a = *(const float4*)vp, c = *(const float4*)(vp + 4);
        unsigned* dst = (unsigned*)(vl + key * VS + dc * 8);
        dst[0] = pk2(a.x, a.y); dst[1] = pk2(a.z, a.w); dst[2] = pk2(c.x, c.y); dst[3] = pk2(c.z, c.w);
      }
    }
    f32x16 st;
#pragma unroll
    for (int i = 0; i < 16; ++i) st[i] = 0.f;
#pragma unroll
    for (int ks = 0; ks < 4; ++ks) st = MFMA(kf[ks], qf[ks], st);
    const bool diag = (kb == nblk - 1);
    float z[16], lk[16], lat[16];
#pragma unroll
    for (int i = 0; i < 16; ++i) {
      z[i] = st[i] * 0.125f;
      const bool msk = (!diag) || (16 * h + i < r);
      const float e = __expf(-fabsf(z[i]));
      const float sp = fmaxf(z[i], 0.f) + __logf(1.f + e);
      lk[i] = msk ? -sp : 0.f;
    }
    float suf = 0.f;
#pragma unroll
    for (int i = 15; i >= 0; --i) { lat[i] = suf; suf += lk[i]; }
    const float other = __shfl_xor(suf, 32);
    const float base = run + (h == 0 ? other : 0.f);
    float a[16];
#pragma unroll
    for (int i = 0; i < 16; ++i) {
      const bool msk = (!diag) || (16 * h + i < r);
      a[i] = msk ? __expf(z[i] + lk[i] + base + lat[i]) : 0.f;
    }
    run += suf + other;
    __builtin_amdgcn_wave_barrier();
#pragma unroll
    for (int s2 = 0; s2 < 2; ++s2) {
      u32x4 t; t.x = pk2(a[8 * s2], a[8 * s2 + 1]); t.y = pk2(a[8 * s2 + 2], a[8 * s2 + 3]); t.z = pk2(a[8 * s2 + 4], a[8 * s2 + 5]); t.w = pk2(a[8 * s2 + 6], a[8 * s2 + 7]);
      const bf16x8 pf = __builtin_bit_cast(bf16x8, t);
#pragma unroll
      for (int dt = 0; dt < 2; ++dt) {
        const bf16_t* vp = vl + (16 * h + 8 * s2) * VS + 32 * dt + r;
        bf16x8 vf;
#pragma unroll
        for (int j = 0; j < 8; ++j) vf[j] = (short)vp[j * VS];
        o[dt] = MFMA(vf, pf, o[dt]);
      }
    }
    __builtin_amdgcn_wave_barrier();
    if (__all(run < -104.f)) break;
  }
  const int tok = tq0 + r;
#pragma unroll
  for (int dt = 0; dt < 2; ++dt)
#pragma unroll
    for (int g = 0; g < 4; ++g) {
      const int d0 = 32 * dt + 8 * g + 4 * h;
      u32x2 ga = *(const u32x2*)(p.P + (size_t)tok * D_IN + OFF_GA + hd * 64 + d0);
      u32x2 ov;
      ov.x = pk2(o[dt][4 * g] * siluf_(bflo(ga.x)), o[dt][4 * g + 1] * siluf_(bfhi(ga.x)));
      ov.y = pk2(o[dt][4 * g + 2] * siluf_(bflo(ga.y)), o[dt][4 * g + 3] * siluf_(bfhi(ga.y)));
      *(u32x2*)(p.mix + (size_t)tok * 1024 + hd * 64 + d0) = ov;
    }
}

constexpr int S5_BU = 8192;
constexpr int S5_LDS = S5_BU + 8704 + 1024;
DI void s5_disc(const Params& p, int lg, int pi, float dt, float& ar, float& ai, float& fr, float& fi) {
  const float lr = fminf(p.lam_re[lg * 64 + pi], -1e-4f), li = p.lam_im[lg * 64 + pi];
  const float er = expf(lr * dt);
  ar = er * cosf(li * dt); ai = er * sinf(li * dt);
  const float den = lr * lr + li * li;
  fr = ((ar - 1.f) * lr + ai * li) / den; fi = (ai * lr - (ar - 1.f) * li) / den;
}
DI void s5_item(const Params& p, int layer, int item, char* lds) {
  float* BU = (float*)lds;
  char* Himg = lds + S5_BU;
  bf16_t* Ub = (bf16_t*)(lds + S5_BU + 8704);
  const int lane = TID & 63, r = lane & 31, h = lane >> 5;
  const int seq = item >> 4, g = item & 15;
  const bool sample = seq >= 32;
  const int b = sample ? seq - 32 : seq, L = sample ? 32 : 2048, tok0 = sample ? NTOK_P + b * 32 : b * 2048;
  const int lg = layer * 16 + g;
  const float dt = expf(p.log_dt[lg]);
  float ar, ai, fr_, fi_;
  s5_disc(p, lg, lane, dt, ar, ai, fr_, fi_);
  bf16x8 bbf[4];
#pragma unroll
  for (int half = 0; half < 2; ++half) {
    const int pi = 32 * half + r;
    float a_r, a_i, f_r, f_i;
    s5_disc(p, lg, pi, dt, a_r, a_i, f_r, f_i);
    const float* brp = p.b_re + ((size_t)lg * 64 + pi) * 16 + 8 * h;
    const float* bip = p.b_im + ((size_t)lg * 64 + pi) * 16 + 8 * h;
    float re[8], im[8];
#pragma unroll
    for (int j = 0; j < 8; ++j) { const float br = brp[j], bi = bip[j]; re[j] = f_r * br - f_i * bi; im[j] = f_r * bi + f_i * br; }
    u32x4 t0, t1;
    t0.x = pk2(re[0], re[1]); t0.y = pk2(re[2], re[3]); t0.z = pk2(re[4], re[5]); t0.w = pk2(re[6], re[7]);
    t1.x = pk2(im[0], im[1]); t1.y = pk2(im[2], im[3]); t1.z = pk2(im[4], im[5]); t1.w = pk2(im[6], im[7]);
    bbf[half] = __builtin_bit_cast(bf16x8, t0);
    bbf[2 + half] = __builtin_bit_cast(bf16x8, t1);
  }
  bf16x8 cf[8];
#pragma unroll
  for (int s = 0; s < 8; ++s) {
    u32x4 t; t.x = 0; t.y = 0; t.z = 0; t.w = 0;
    if (r < 16) {
      const int k0 = 16 * s + 8 * h;
      const float* src = (s < 4 ? p.c_re : p.c_im) + ((size_t)lg * 16 + r) * 64 + (k0 & 63);
      const float sg = s < 4 ? 1.f : -1.f;
      const float4 c0 = *(const float4*)src, c1 = *(const float4*)(src + 4);
      t.x = pk2(sg * c0.x, sg * c0.y); t.y = pk2(sg * c0.z, sg * c0.w); t.z = pk2(sg * c1.x, sg * c1.y); t.w = pk2(sg * c1.z, sg * c1.w);
    }
    cf[s] = __builtin_bit_cast(bf16x8, t);
  }
  const float dl = p.ssm_d[lg * 16 + (r & 15)];
  float hr = 0.f, hi = 0.f;
  if (sample) { hr = p.st_re[((size_t)(layer * 16 + b) * 16 + g) * 64 + lane]; hi = p.st_im[((size_t)(layer * 16 + b) * 16 + g) * 64 + lane]; }
  f32x16 zero;
#pragma unroll
  for (int i = 0; i < 16; ++i) zero[i] = 0.f;
  const bf16_t* upb = p.P + (size_t)(tok0 + r) * D_IN + OFF_U + g * 16 + 8 * h;
  bf16x8 uf = *(const bf16x8*)upb;
  for (int t0 = 0; t0 < L; t0 += 32) {
    const bf16x8 ucur = uf;
    if (t0 + 32 < L) uf = *(const bf16x8*)(upb + (size_t)(t0 + 32) * D_IN);
    *(bf16x8*)(Ub + r * 16 + 8 * h) = ucur;
    f32x16 d[4];
#pragma unroll
    for (int tile = 0; tile < 4; ++tile) d[tile] = MFMA(ucur, bbf[tile], zero);
#pragma unroll
    for (int hf = 0; hf < 2; ++hf) {
#pragma unroll
      for (int tile = 0; tile < 4; ++tile)
#pragma unroll
        for (int i = 0; i < 8; ++i) BU[((i & 3) + 8 * (i >> 2) + 4 * h) * 128 + 32 * tile + r] = d[tile][8 * hf + i];
      __builtin_amdgcn_wave_barrier();
#pragma unroll
      for (int tt = 0; tt < 16; ++tt) {
        const int t = 16 * hf + tt;
        const float bur = BU[tt * 128 + lane], bui = BU[tt * 128 + 64 + lane];
        const float nhr = ar * hr - ai * hi + bur, nhi = ar * hi + ai * hr + bui;
        hr = nhr; hi = nhi;
        *(bf16_t*)(Himg + t * 272 + lane * 2) = (bf16_t)f2bf(hr);
        *(bf16_t*)(Himg + t * 272 + 128 + lane * 2) = (bf16_t)f2bf(hi);
      }
      __builtin_amdgcn_wave_barrier();
    }
    f32x16 yacc = zero;
#pragma unroll
    for (int s = 0; s < 8; ++s) {
      const bf16x8 af = *(const bf16x8*)(Himg + r * 272 + s * 32 + h * 16);
      yacc = MFMA(af, cf[s], yacc);
    }
    if (r < 16) {
#pragma unroll
      for (int i = 0; i < 16; ++i) {
        const int t = (i & 3) + 8 * (i >> 2) + 4 * h;
        const float yv = yacc[i] + dl * bf2f(Ub[t * 16 + r]);
        const float gl = yv / (1.f + __expf(-1.5957691216f * (yv + 0.044715f * yv * yv * yv)));
        p.yb[(size_t)(tok0 + t0 + t) * 256 + g * 16 + r] = (bf16_t)f2bf(gl);
      }
    }
    __builtin_amdgcn_wave_barrier();
  }
  float* ore = p.out + (sample ? O_SRES : O_SREP) + ((size_t)(layer * (sample ? 16 : 32) + b) * 16 + g) * 64 + lane;
  float* oim = p.out + (sample ? O_SIMS : O_SIMP) + ((size_t)(layer * (sample ? 16 : 32) + b) * 16 + g) * 64 + lane;
  *ore = hr; *oim = hi;
}

DI void rwkv_item(const Params& p, int layer, int item, char* smem) {
  float* R = (float*)smem; float* W = R + 2048; float* KT = W + 2048; float* KH = KT + 2048; float* BB = KH + 2048;
  float* V = BB + 2048; float* Y = V + 2048; float* DSUM = Y + 2048; float* ASUM = DSUM + 2048; float* BON = ASUM + 2048;
  bf16_t* LORAb = (bf16_t*)(BON + 32);
  const int tid = TID, lane = tid & 63, wv = tid >> 6;
  const int seq = item >> 2, hd = item & 3;
  const bool sample = seq >= 32;
  const int b = sample ? seq - 32 : seq, L = sample ? 32 : 2048, tok0 = sample ? NTOK_P + b * 32 : b * 2048;
  const int cg_ = hd * 64 + lane;
  bf16x8 lb[2];
  {
    const int ll = (wv >> 1) & 1, nn = wv & 1, r_ = lane & 31, h_ = lane >> 5;
    const float* srcw = (ll ? p.a2 : p.w2) + (size_t)layer * 32 * 256 + hd * 64 + 32 * nn + r_;
#pragma unroll
    for (int s = 0; s < 2; ++s) {
      float t[8];
#pragma unroll
      for (int j = 0; j < 8; ++j) t[j] = srcw[(size_t)(16 * s + 8 * h_ + j) * 256];
      u32x4 u; u.x = pk2(t[0], t[1]); u.y = pk2(t[2], t[3]); u.z = pk2(t[4], t[5]); u.w = pk2(t[6], t[7]);
      lb[s] = __builtin_bit_cast(bf16x8, u);
    }
  }
  const float w0c = p.w0[layer * 256 + cg_], a0c = p.a0[layer * 256 + cg_], kkc = p.k_k[layer * 256 + cg_], kac = p.k_a[layer * 256 + cg_];
  const float ubc = p.u_bonus[layer * 256 + cg_], lnw = p.ln_w[layer * 256 + cg_], lnb = p.ln_b[layer * 256 + cg_];
  const float* mu = p.mu + layer * 832;
  const float mu_r = mu[cg_], mu_k = mu[256 + cg_], mu_v = mu[512 + cg_], mu_l = mu[768 + lane];
  const float* shp = p.st_shift + (size_t)(layer * 16 + b) * 832;
  const int row = tid >> 3, kq = tid & 7;
  f32x2 S[4];
  if (sample) {
    const float* sp = p.st_wkv + (((size_t)(layer * 16 + b) * 4 + hd) * 64 + row) * 64 + kq * 8;
#pragma unroll
    for (int j = 0; j < 4; ++j) { S[j].x = sp[2 * j]; S[j].y = sp[2 * j + 1]; }
  } else {
#pragma unroll
    for (int j = 0; j < 4; ++j) { S[j].x = 0.f; S[j].y = 0.f; }
  }
  bf16_t cr[4], ck[4], cv[4], cl[4], qr[4], qk[4], qv[4], ql[4], cgt[4];
#pragma unroll
  for (int i = 0; i < 4; ++i) {
    const bf16_t* cp = p.P + (size_t)(tok0 + wv + 8 * i) * D_IN + OFF_C;
    const bf16_t* pp = cp - D_IN;
    cr[i] = cp[cg_]; ck[i] = cp[256 + cg_]; cv[i] = cp[512 + cg_]; cl[i] = cp[768 + lane]; cgt[i] = cp[OFF_GC - OFF_C + cg_];
    qr[i] = pp[cg_]; qk[i] = pp[256 + cg_]; qv[i] = pp[512 + cg_]; ql[i] = pp[768 + lane];
  }
  for (int c0 = 0; c0 < L; c0 += 32) {
    float xr[4], xk[4], xv[4], gt[4];
#pragma unroll
    for (int i = 0; i < 4; ++i) {
      const int tl = wv + 8 * i;
      const bool first = (c0 + tl == 0);
      float pr, pk, pv, pl;
      if (first) {
        if (sample) { pr = shp[cg_]; pk = shp[256 + cg_]; pv = shp[512 + cg_]; pl = shp[768 + lane]; }
        else { pr = 0.f; pk = 0.f; pv = 0.f; pl = 0.f; }
      } else { pr = bf2f(qr[i]); pk = bf2f(qk[i]); pv = bf2f(qv[i]); pl = bf2f(ql[i]); }
      const float c_r = bf2f(cr[i]), c_k = bf2f(ck[i]), c_v = bf2f(cv[i]), c_l = bf2f(cl[i]);
      gt[i] = bf2f(cgt[i]);
      xr[i] = c_r + mu_r * (pr - c_r); xk[i] = c_k + mu_k * (pk - c_k); xv[i] = c_v + mu_v * (pv - c_v);
      const float xl = c_l + mu_l * (pl - c_l);
      LORAb[tl * 72 + lane] = (bf16_t)f2bf(lane < 32 ? fast_tanh(xl) : xl);
    }
    lds_barrier();
    if (c0 + 32 < L) {
#pragma unroll
      for (int i = 0; i < 4; ++i) {
        const bf16_t* cp = p.P + (size_t)(tok0 + c0 + 32 + wv + 8 * i) * D_IN + OFF_C;
        const bf16_t* pp = cp - D_IN;
        cr[i] = cp[cg_]; ck[i] = cp[256 + cg_]; cv[i] = cp[512 + cg_]; cl[i] = cp[768 + lane]; cgt[i] = cp[OFF_GC - OFF_C + cg_];
        qr[i] = pp[cg_]; qk[i] = pp[256 + cg_]; qv[i] = pp[512 + cg_]; ql[i] = pp[768 + lane];
      }
    }
    if (wv < 4) {
      const int r_ = lane & 31, h_ = lane >> 5, ll = wv >> 1, nn = wv & 1;
      f32x16 dacc;
#pragma unroll
      for (int i = 0; i < 16; ++i) dacc[i] = 0.f;
#pragma unroll
      for (int s = 0; s < 2; ++s) {
        const bf16x8 af = *(const bf16x8*)((const char*)LORAb + r_ * 144 + ll * 64 + s * 32 + h_ * 16);
        dacc = MFMA(af, lb[s], dacc);
      }
      float* dst = (ll ? ASUM : DSUM) + 32 * nn + r_;
#pragma unroll
      for (int i = 0; i < 16; ++i) dst[((i & 3) + 8 * (i >> 2) + 4 * h_) * 64] = dacc[i];
    }
    lds_barrier();
#pragma unroll
    for (int i = 0; i < 4; ++i) {
      const int tl = wv + 8 * i;
      const float dsum = w0c + DSUM[tl * 64 + lane], asum = a0c + ASUM[tl * 64 + lane];
      const float dec = __expf(-0.6065306597f * sigmoidf_(dsum));
      const float a = sigmoidf_(asum);
      const float kk = xk[i] * kkc;
      const float ss = wave_sum(kk * kk);
      const float kh = kk * rsqrtf(ss + 1e-12f);
      const float kt = xk[i] * (1.f + (a - 1.f) * kac);
      const float bon = wave_sum(xr[i] * kt * ubc);
      R[tl * 64 + lane] = xr[i]; W[tl * 64 + lane] = dec; KT[tl * 64 + lane] = kt; KH[tl * 64 + lane] = kh; BB[tl * 64 + lane] = a * kh; V[tl * 64 + lane] = xv[i];
      if (lane == 0) BON[tl] = bon;
    }
    lds_barrier();
    float ykeep[4];
    float4 nkh0, nkh1, nw0, nw1, nb0, nb1, nk0, nk1, nr0, nr1; float nvv;
    {
      const int o = kq * 8;
      nkh0 = *(const float4*)(KH + o); nkh1 = *(const float4*)(KH + o + 4); nw0 = *(const float4*)(W + o); nw1 = *(const float4*)(W + o + 4);
      nb0 = *(const float4*)(BB + o); nb1 = *(const float4*)(BB + o + 4); nk0 = *(const float4*)(KT + o); nk1 = *(const float4*)(KT + o + 4);
      nr0 = *(const float4*)(R + o); nr1 = *(const float4*)(R + o + 4); nvv = V[row];
    }
#pragma unroll
    for (int q = 0; q < 4; ++q) {
      ykeep[q] = 0.f;
#pragma unroll
      for (int e = 0; e < 8; ++e) {
        const int tl = q * 8 + e;
        const float4 kh0 = nkh0, kh1 = nkh1, w0_ = nw0, w1_ = nw1, b0 = nb0, b1 = nb1, k0 = nk0, k1 = nk1, r0 = nr0, r1 = nr1;
        const float vv = nvv;
        if (tl < 31) {
          const int o = (tl + 1) * 64 + kq * 8;
          nkh0 = *(const float4*)(KH + o); nkh1 = *(const float4*)(KH + o + 4); nw0 = *(const float4*)(W + o); nw1 = *(const float4*)(W + o + 4);
          nb0 = *(const float4*)(BB + o); nb1 = *(const float4*)(BB + o + 4); nk0 = *(const float4*)(KT + o); nk1 = *(const float4*)(KT + o + 4);
          nr0 = *(const float4*)(R + o); nr1 = *(const float4*)(R + o + 4); nvv = V[(tl + 1) * 64 + row];
        }
        const f32x2 khv[4] = {{kh0.x, kh0.y}, {kh0.z, kh0.w}, {kh1.x, kh1.y}, {kh1.z, kh1.w}};
        const f32x2 wvv[4] = {{w0_.x, w0_.y}, {w0_.z, w0_.w}, {w1_.x, w1_.y}, {w1_.z, w1_.w}};
        const f32x2 bv[4] = {{b0.x, b0.y}, {b0.z, b0.w}, {b1.x, b1.y}, {b1.z, b1.w}};
        const f32x2 kv[4] = {{k0.x, k0.y}, {k0.z, k0.w}, {k1.x, k1.y}, {k1.z, k1.w}};
        const f32x2 rv[4] = {{r0.x, r0.y}, {r0.z, r0.w}, {r1.x, r1.y}, {r1.z, r1.w}};
        const f32x2 vv2 = {vv, vv};
        f32x2 m[4];
#pragma unroll
        for (int j = 0; j < 4; ++j) m[j] = fma2(S[j], wvv[j], vv2 * kv[j]);
        f32x2 sa2 = fma2(S[1], khv[1], S[0] * khv[0]), sb2 = fma2(S[3], khv[3], S[2] * khv[2]);
        sa2 += sb2;
        const float sa = sum8(sa2.x + sa2.y);
        const f32x2 nsa = {-sa, -sa};
#pragma unroll
        for (int j = 0; j < 4; ++j) S[j] = fma2(nsa, bv[j], m[j]);
        f32x2 y2 = fma2(S[1], rv[1], S[0] * rv[0]), y3 = fma2(S[3], rv[3], S[2] * rv[2]);
        y2 += y3;
        const float yv = sum8(y2.x + y2.y);
        ykeep[q] = (e == kq) ? yv : ykeep[q];
      }
    }
#pragma unroll
    for (int q = 0; q < 4; ++q) Y[(q * 8 + kq) * 64 + row] = ykeep[q];
    lds_barrier();
#pragma unroll
    for (int i = 0; i < 4; ++i) {
      const int tl = wv + 8 * i;
      const int tok = tok0 + c0 + tl;
      const float y = Y[tl * 64 + lane];
      const float mean = wave_sum(y) * (1.f / 64.f);
      const float d = y - mean;
      const float var = wave_sum(d * d) * (1.f / 64.f);
      float yn = d * rsqrtf(var + 64e-5f) * lnw + lnb;
      yn += BON[tl] * V[tl * 64 + lane];
      p.mix[(size_t)tok * 1024 + 768 + cg_] = (bf16_t)f2bf(yn * siluf_(gt[i]));
    }
  }
  lds_barrier();
  float* so = p.out + (sample ? O_WKVS : O_WKVP) + (((size_t)(layer * (sample ? 16 : 32) + b) * 4 + hd) * 64 + row) * 64 + kq * 8;
  *(float4*)so = make_float4(S[0].x, S[0].y, S[1].x, S[1].y);
  *(float4*)(so + 4) = make_float4(S[2].x, S[2].y, S[3].x, S[3].y);
}

constexpr int ATT_LDS0 = 6 * S5_LDS;
DI void phase_mixers(const Params& p, int layer, char* smem, int cofs) {
  const int G = GDIM, bid = BID, half = G / 2;
  const int tid = TID, wv = tid >> 6, lane = tid & 63;
  if (bid < half) {
    for (int item = bid; item < 128; item += half) rwkv_item(p, layer, item, smem);
  } else {
    const int j = bid - half, nb2 = G - half;
    for (int item = 128 + j; item < 192; item += nb2) rwkv_item(p, layer, item, smem);
    if (wv < 6) { for (int it = j * 6 + wv; it < 768; it += nb2 * 6) s5_item(p, layer, it, smem + wv * S5_LDS); }
  }
  unsigned* ctr = p.counters + layer + cofs;
  bf16_t* vl = (bf16_t*)(smem + ATT_LDS0) + wv * (32 * VS);
  while (true) {
    int it = 0;
    if (lane == 0) it = (int)atomicAdd(ctr, 1u);
    it = __builtin_amdgcn_readfirstlane(it);
    if (it >= 16512) break;
    attn_item(p, layer, it, vl);
  }
}

__global__ void __launch_bounds__(NT) mega(Params p) {
  __shared__ __attribute__((aligned(16))) char smem[SMEM_BYTES];
  cg::grid_group grid = cg::this_grid();
  phase_weights(p, smem);
  phase_norm(p, 0);
  grid.sync();
  for (int layer = 0; layer < 2; ++layer) {
    if (layer == 1) { phase_norm(p, 1); grid.sync(); }
    gemm_phase<0>(p, layer, smem);
    grid.sync();
#if PROBE_GEMM0
    gemm_phase<0>(p, layer, smem);
    grid.sync();
#endif
    phase_mixers(p, layer, smem, 0);
    grid.sync();
#if PROBE_MIX
    phase_mixers(p, layer, smem, 2);
    grid.sync();
#endif
    gemm_phase<1>(p, layer, smem);
    grid.sync();
    gemm_phase<2>(p, layer, smem);
    if (layer == 0) grid.sync();
  }
}

#if MULTI_LAUNCH
template <int PH>
__global__ void __launch_bounds__(NT) phase_kernel(Params p, int layer) {
  __shared__ __attribute__((aligned(16))) char smem[SMEM_BYTES];
  if (PH == 0) { phase_weights(p, smem); }
  else if (PH == 1) phase_norm(p, layer);
  else if (PH == 2) gemm_phase<0>(p, layer, smem);
  else if (PH == 3) phase_mixers(p, layer, smem, 0);
  else if (PH == 4) gemm_phase<1>(p, layer, smem);
  else gemm_phase<2>(p, layer, smem);
}
#endif

extern "C" void kernel_launch(void* const* d_in, const int* in_sizes, int n_in, void* d_out, int out_size, void* d_ws, size_t ws_size, hipStream_t stream) {
  Params p{};
  const float** f = (const float**)&p;
  for (int i = 0; i < 33; ++i) f[i] = (const float*)d_in[i];
  p.out = (float*)d_out;
  char* ws = (char*)d_ws;
  size_t off = 0;
  auto take = [&](size_t bytes) { char* q = ws + off; off += (bytes + 255) & ~(size_t)255; return q; };
  p.WinT = (bf16_t*)take((size_t)2 * 3648 * 1024 * 2);
  p.WoutT = (bf16_t*)take((size_t)2 * 1024 * 1024 * 2);
  p.WgluT = (bf16_t*)take((size_t)2 * 512 * 256 * 2);
  p.hbf = (bf16_t*)take((size_t)NTOK * 1024 * 2);
  p.P = (bf16_t*)take((size_t)NTOK * D_IN * 2);
  p.mix = (bf16_t*)take((size_t)NTOK * 1024 * 2);
  p.yb = (bf16_t*)take((size_t)NTOK * 256 * 2);
  p.counters = (unsigned*)take(256);
  if (off > ws_size || (size_t)out_size != O_END || n_in != 33) fprintf(stderr, "kernel_launch: unexpected sizes ws=%zu need=%zu out=%d n_in=%d\n", ws_size, off, out_size, n_in);
#if MULTI_LAUNCH
  const int G = 256;
  phase_kernel<0><<<G, NT, 0, stream>>>(p, 0);
  for (int layer = 0; layer < 2; ++layer) {
    phase_kernel<1><<<G, NT, 0, stream>>>(p, layer);
    phase_kernel<2><<<G, NT, 0, stream>>>(p, layer);
    phase_kernel<3><<<G, NT, 0, stream>>>(p, layer);
    phase_kernel<4><<<G, NT, 0, stream>>>(p, layer);
    phase_kernel<5><<<G, NT, 0, stream>>>(p, layer);
  }
#else
  static int grid_blocks = 0;
  if (!grid_blocks) {
    int dev = 0, cus = 0, per_cu = 0;
    hipGetDevice(&dev);
    hipDeviceGetAttribute(&cus, hipDeviceAttributeMultiprocessorCount, dev);
    hipOccupancyMaxActiveBlocksPerMultiprocessor(&per_cu, mega, NT, 0);
    if (per_cu < 1) per_cu = 1;
    grid_blocks = cus * per_cu;
  }
  void* args[] = {&p};
  hipError_t e = hipLaunchCooperativeKernel((void*)mega, dim3(grid_blocks), dim3(NT), args, 0, stream);
  if (e != hipSuccess) fprintf(stderr, "cooperative launch failed: %s (grid %d)\n", hipGetErrorString(e), grid_blocks);
#endif
}
```

```cpp
#include <hip/hip_runtime.h>
#include <hip/hip_cooperative_groups.h>
#include <cstdio>
namespace cg = cooperative_groups;

#define PROBE_GEMM0 0
#define PROBE_MIX 0
#ifndef MULTI_LAUNCH
#define MULTI_LAUNCH 0
#endif

#define DI __device__ __forceinline__
typedef unsigned short bf16_t;
typedef short bf16x8 __attribute__((ext_vector_type(8)));
typedef float f32x16 __attribute__((ext_vector_type(16)));
typedef unsigned u32x4 __attribute__((ext_vector_type(4)));
typedef unsigned u32x2 __attribute__((ext_vector_type(2)));
#define MFMA(a, b, c) __builtin_amdgcn_mfma_f32_32x32x16_bf16((a), (b), (c), 0, 0, 0)

constexpr int NT = 512;
constexpr int NTOK_P = 65536, NTOK = 66048, D_IN = 3648;
constexpr int OFF_Q = 0, OFF_K = 512, OFF_V = 1024, OFF_GA = 1536, OFF_U = 2048, OFF_GB = 2304, OFF_C = 2560, OFF_GC = 3392;
constexpr size_t O_Y = 0, O_KP = 67633152, O_VP = 134742016, O_SREP = 201850880, O_SIMP = 201916416, O_WKVP = 201981952,
                 O_SHP = 203030528, O_KS = 203083776, O_VS = 203608064, O_SRES = 204132352, O_SIMS = 204165120,
                 O_WKVS = 204197888, O_SHS = 204722176, O_END = 204748800;
constexpr int SMEM_BYTES = 2 * 55296 + 8 * 4608;
constexpr int LDS_ROW = 144;
constexpr int STAGE = (256 + 128) * LDS_ROW;

struct Params {
  const float *x_prompt, *x_sample, *cache_k, *cache_v, *st_re, *st_im, *st_wkv, *st_shift;
  const float *norm_w, *w_in, *q_norm_w, *k_norm_w, *lam_re, *lam_im, *log_dt, *b_re, *b_im, *c_re, *c_im, *ssm_d, *w_glu, *b_glu;
  const float *mu, *w0, *w2, *a0, *a2, *k_k, *k_a, *u_bonus, *ln_w, *ln_b, *w_out;
  float* out;
  bf16_t *WinT, *WoutT, *WgluT, *hbf, *P, *mix, *yb;
  unsigned* counters;
  float* ssq;
};

DI int opq_v(int x) { asm volatile("" : "+v"(x)); return x; }
DI int opq_s(int x) { asm volatile("" : "+s"(x)); return x; }
#define TID opq_v((int)threadIdx.x)
#define BID opq_s((int)blockIdx.x)
#define GDIM opq_s((int)gridDim.x)
DI unsigned f2bf(float x) { unsigned u = __float_as_uint(x); u += 0x7fffu + ((u >> 16) & 1u); return u >> 16; }
DI unsigned pk2(float a, float b) { return f2bf(a) | (f2bf(b) << 16); }
DI float bf2f(unsigned v) { return __uint_as_float(v << 16); }
DI float bflo(unsigned w) { return __uint_as_float(w << 16); }
DI float bfhi(unsigned w) { return __uint_as_float(w & 0xffff0000u); }
DI float sigmoidf_(float x) { return 1.f / (1.f + __expf(-x)); }
DI float siluf_(float x) { return x / (1.f + __expf(-x)); }
typedef float f32x2 __attribute__((ext_vector_type(2)));
DI f32x2 fma2(f32x2 a, f32x2 b, f32x2 c) { return __builtin_elementwise_fma(a, b, c); }
template <int CTRL> DI float dpp_mov(float x) { return __int_as_float(__builtin_amdgcn_update_dpp(0, __float_as_int(x), CTRL, 0xF, 0xF, true)); }
DI float sum8(float x) { x += dpp_mov<0xB1>(x); x += dpp_mov<0x4E>(x); x += dpp_mov<0x141>(x); return x; }
DI float fast_tanh(float x) { return 1.f - 2.f / (1.f + __expf(2.f * x)); }
DI void lds_barrier() { asm volatile("s_waitcnt lgkmcnt(0)\n\ts_barrier" ::: "memory"); }
DI float wave_sum(float v) {
#pragma unroll
  for (int m = 32; m >= 1; m >>= 1) v += __shfl_xor(v, m);
  return v;
}
DI const float* xrow(const Params& p, int layer, int row) {
  if (layer == 0) return row < NTOK_P ? p.x_prompt + (size_t)row * 1024 : p.x_sample + (size_t)(row - NTOK_P) * 1024;
  return p.out + (size_t)row * 1024;
}

DI void transpose_tile(const float* __restrict__ src, int K, int N, bf16_t* __restrict__ dst, int k0, int n0, float* tile) {
  const int tid = TID;
#pragma unroll
  for (int i = 0; i < 8; ++i) { int idx = tid + NT * i; int kk = idx >> 6, nn = idx & 63; tile[kk * 65 + nn] = src[(size_t)(k0 + kk) * N + n0 + nn]; }
  __syncthreads();
#pragma unroll
  for (int i = 0; i < 8; ++i) { int idx = tid + NT * i; int nn = idx >> 6, kk = idx & 63; dst[(size_t)(n0 + nn) * K + k0 + kk] = (bf16_t)f2bf(tile[kk * 65 + nn]); }
  __syncthreads();
}
DI void phase_weights(const Params& p, char* smem) {
  float* tile = (float*)smem;
  const int bid = BID, gdim = GDIM;
  for (int t = bid; t < 2400; t += gdim) {
    int layer = t / 1200, j = t % 1200;
    if (j < 912) { int kt = j / 57, nt = j % 57; transpose_tile(p.w_in + (size_t)layer * 1024 * 3648, 1024, 3648, p.WinT + (size_t)layer * 3648 * 1024, kt * 64, nt * 64, tile); }
    else if (j < 1168) { j -= 912; int kt = j / 16, nt = j % 16; transpose_tile(p.w_out + (size_t)layer * 1024 * 1024, 1024, 1024, p.WoutT + (size_t)layer * 1024 * 1024, kt * 64, nt * 64, tile); }
    else { j -= 1168; int kt = j / 8, nt = j % 8; transpose_tile(p.w_glu + (size_t)layer * 256 * 512, 256, 512, p.WgluT + (size_t)layer * 512 * 256, kt * 64, nt * 64, tile); }
  }
  { const int tid = TID; if (bid == 0 && tid < 64) p.counters[tid] = 0;
    for (int i = bid * NT + tid; i < NTOK; i += gdim * NT) p.ssq[i] = 0.f; }
}

DI void phase_norm(const Params& p, int layer) {
  const int tid = TID, lane = tid & 63, w = tid >> 6;
  const int bid = BID, gdim = GDIM;
  const float* nw = p.norm_w + layer * 1024;
  const int stride = gdim * 8;
  for (int row0 = bid * 8 + w; row0 < NTOK; row0 += 2 * stride) {
    const int row1 = row0 + stride;
    const bool has1 = row1 < NTOK;
    const float* x0 = xrow(p, layer, row0);
    const float* x1 = xrow(p, layer, has1 ? row1 : row0);
    float4 v0[4], v1[4]; float s0 = 0.f, s1 = 0.f;
#pragma unroll
    for (int i = 0; i < 4; ++i) { v0[i] = *(const float4*)(x0 + i * 256 + lane * 4); v1[i] = *(const float4*)(x1 + i * 256 + lane * 4); }
#pragma unroll
    for (int i = 0; i < 4; ++i) {
      s0 += v0[i].x * v0[i].x + v0[i].y * v0[i].y + v0[i].z * v0[i].z + v0[i].w * v0[i].w;
      s1 += v1[i].x * v1[i].x + v1[i].y * v1[i].y + v1[i].z * v1[i].z + v1[i].w * v1[i].w;
    }
    s0 = wave_sum(s0); s1 = wave_sum(s1);
    const float c0 = rsqrtf(s0 * (1.f / 1024.f) + 1e-6f), c1 = rsqrtf(s1 * (1.f / 1024.f) + 1e-6f);
#pragma unroll
    for (int i = 0; i < 4; ++i) {
      float4 wv = *(const float4*)(nw + i * 256 + lane * 4);
      u32x2 o; o.x = pk2(v0[i].x * c0 * wv.x, v0[i].y * c0 * wv.y); o.y = pk2(v0[i].z * c0 * wv.z, v0[i].w * c0 * wv.w);
      *(u32x2*)(p.hbf + (size_t)row0 * 1024 + i * 256 + lane * 4) = o;
      if (has1) {
        u32x2 o1; o1.x = pk2(v1[i].x * c1 * wv.x, v1[i].y * c1 * wv.y); o1.y = pk2(v1[i].z * c1 * wv.z, v1[i].w * c1 * wv.w);
        *(u32x2*)(p.hbf + (size_t)row1 * 1024 + i * 256 + lane * 4) = o1;
      }
    }
  }
}

template <int MODE>
DI void gemm_phase(const Params& p, int layer, char* smem) {
  constexpr int K = (MODE == 1) ? 256 : 1024;
  constexpr int NTN = (MODE == 0) ? 29 : (MODE == 1 ? 4 : 8);
  constexpr int KT = K / 64;
  const bf16_t* __restrict__ A = MODE == 0 ? p.hbf : (MODE == 1 ? p.yb : p.mix);
  const bf16_t* __restrict__ Bt = MODE == 0 ? p.WinT + (size_t)layer * 3648 * 1024 : (MODE == 1 ? p.WgluT + (size_t)layer * 512 * 256 : p.WoutT + (size_t)layer * 1024 * 1024);
  const int tid = TID, lane = tid & 63, wv = tid >> 6, r = lane & 31, h = lane >> 5;
  const int wm = wv >> 1, wn = wv & 1;
  const int bid = BID, gdim = GDIM;
  const int xcd = bid & 7, jb = bid >> 3, nbx = (gdim - xcd + 7) >> 3;

  const int total_x = ((258 - xcd + 7) >> 3) * NTN;
  const int nmine = jb < total_x ? (total_x - jb + nbx - 1) / nbx : 0;
  if (nmine == 0) return;
  const int lrow = tid >> 3, kc = tid & 7;
  auto set_ptrs = [&](int idx, const bf16_t* (&ap)[4], const bf16_t* (&bp)[2]) {
    const int tmi_ = idx / NTN, tn_ = idx % NTN, m0_ = (xcd + 8 * tmi_) * 256, n0_ = tn_ * 128;
#pragma unroll
    for (int i = 0; i < 4; ++i) ap[i] = A + (size_t)(m0_ + lrow + 64 * i) * K + kc * 8;
#pragma unroll
    for (int i = 0; i < 2; ++i) {
      int row = lrow + 64 * i, brow;
      if (MODE == 0) { brow = n0_ + row; brow = brow < 3648 ? brow : 3647; }
      else if (MODE == 2) brow = n0_ + row;
      else { int wn_ = row >> 6, nt_ = (row >> 5) & 1, c_ = row & 31; brow = nt_ * 256 + tn_ * 64 + wn_ * 32 + c_; }
      bp[i] = Bt + (size_t)brow * K + kc * 8;
    }
  };
  f32x16 acc[2][2];
  auto zero_acc = [&]() {
#pragma unroll
    for (int a = 0; a < 2; ++a)
#pragma unroll
      for (int b = 0; b < 2; ++b)
#pragma unroll
        for (int i = 0; i < 16; ++i) acc[a][b][i] = 0.f;
  };
  auto compute = [&](const char* buf, char* nbuf, const u32x4 (&pa)[4], const u32x4 (&pb)[2]) {
    const char* As = buf; const char* Bs = buf + 256 * LDS_ROW;
    char* An = nbuf; char* Bn = nbuf + 256 * LDS_ROW;
#pragma unroll
    for (int s = 0; s < 4; ++s) {
      bf16x8 af[2], bfr[2];
#pragma unroll
      for (int mt = 0; mt < 2; ++mt) af[mt] = *(const bf16x8*)(As + (wm * 64 + mt * 32 + r) * LDS_ROW + s * 32 + h * 16);
#pragma unroll
      for (int nt = 0; nt < 2; ++nt) bfr[nt] = *(const bf16x8*)(Bs + (wn * 64 + nt * 32 + r) * LDS_ROW + s * 32 + h * 16);
#pragma unroll
      for (int mt = 0; mt < 2; ++mt)
#pragma unroll
        for (int nt = 0; nt < 2; ++nt) acc[mt][nt] = MFMA(bfr[nt], af[mt], acc[mt][nt]);
      if (s < 2) {
        *(u32x4*)(An + (lrow + 64 * (2 * s)) * LDS_ROW + kc * 16) = pa[2 * s];
        *(u32x4*)(An + (lrow + 64 * (2 * s + 1)) * LDS_ROW + kc * 16) = pa[2 * s + 1];
      } else {
        *(u32x4*)(Bn + (lrow + 64 * (s - 2)) * LDS_ROW + kc * 16) = pb[s - 2];
      }
    }
  };
  u32x4 sa[4][4], sb[4][2];
  const bf16_t* cap[4]; const bf16_t* cbp[2]; const bf16_t* nap[4]; const bf16_t* nbp[2];
  set_ptrs(jb, cap, cbp);
#pragma unroll
  for (int j = 0; j < 4; ++j) {
#pragma unroll
    for (int i = 0; i < 4; ++i) sa[j][i] = *(const u32x4*)(cap[i] + j * 64);
#pragma unroll
    for (int i = 0; i < 2; ++i) sb[j][i] = *(const u32x4*)(cbp[i] + j * 64);
  }
  {
    char* As = smem; char* Bs = smem + 256 * LDS_ROW;
#pragma unroll
    for (int i = 0; i < 4; ++i) *(u32x4*)(As + (lrow + 64 * i) * LDS_ROW + kc * 16) = sa[0][i];
#pragma unroll
    for (int i = 0; i < 2; ++i) *(u32x4*)(Bs + (lrow + 64 * i) * LDS_ROW + kc * 16) = sb[0][i];
  }
  lds_barrier();
  zero_acc();
  int c_idx = jb;
  for (int ti = 0; ti < nmine; ++ti) {
    set_ptrs(ti + 1 < nmine ? c_idx + nbx : c_idx, nap, nbp);
    for (int q = 0; q < KT / 4; ++q) {
      const bool lastq = (q == KT / 4 - 1);
      const int koff = lastq ? 0 : (4 * (q + 1)) * 64;
      const bf16_t* lap[4]; const bf16_t* lbp[2];
#pragma unroll
      for (int i = 0; i < 4; ++i) lap[i] = (lastq ? nap[i] : cap[i]) + koff;
#pragma unroll
      for (int i = 0; i < 2; ++i) lbp[i] = (lastq ? nbp[i] : cbp[i]) + koff;
#pragma unroll
      for (int j = 0; j < 4; ++j) {
#pragma unroll
        for (int i = 0; i < 4; ++i) sa[j][i] = *(const u32x4*)(lap[i] + j * 64);
#pragma unroll
        for (int i = 0; i < 2; ++i) sb[j][i] = *(const u32x4*)(lbp[i] + j * 64);
        compute(smem + (j & 1) * STAGE, smem + ((j + 1) & 1) * STAGE, sa[(j + 1) & 3], sb[(j + 1) & 3]);
        lds_barrier();
      }
    }
#pragma unroll
    for (int i = 0; i < 4; ++i) cap[i] = nap[i];
#pragma unroll
    for (int i = 0; i < 2; ++i) cbp[i] = nbp[i];
    const int idx = c_idx; c_idx += nbx;
    const int tmi = idx / NTN, tn = idx % NTN, tm = xcd + 8 * tmi;
    const int m0 = tm * 256, n0 = tn * 128;
    char* eps = smem + 2 * STAGE + wv * 4608;
    if (MODE == 0) {
      const int nb = n0 + wn * 64;
      if (nb < 3648) {
        if (layer == 1) {
#pragma unroll
          for (int mt = 0; mt < 2; ++mt) {
            const float rs = rsqrtf(p.ssq[m0 + wm * 64 + mt * 32 + r] * (1.f / 1024.f) + 1e-6f);
#pragma unroll
            for (int nt = 0; nt < 2; ++nt)
#pragma unroll
              for (int i = 0; i < 16; ++i) acc[mt][nt][i] *= rs;
          }
        }
        float scale[2] = {1.f, 1.f};
        if (nb < 1024) {
#pragma unroll
          for (int mt = 0; mt < 2; ++mt) {
            float ss = 0.f;
#pragma unroll
            for (int nt = 0; nt < 2; ++nt)
#pragma unroll
              for (int i = 0; i < 16; ++i) ss += acc[mt][nt][i] * acc[mt][nt][i];
            ss += __shfl_xor(ss, 32);
            scale[mt] = rsqrtf(ss * (1.f / 64.f) + 1e-6f);
          }
        }
        const float* nw = (nb < 512 ? p.q_norm_w : p.k_norm_w) + layer * 64;
#pragma unroll
        for (int mt = 0; mt < 2; ++mt) {
          const int mb = m0 + wm * 64 + mt * 32;
          const int m = mb + r;
          const bool is_p = m < NTOK_P;
#pragma unroll
          for (int nt = 0; nt < 2; ++nt) {
#pragma unroll
            for (int g = 0; g < 4; ++g) {
              const int ncol = nb + nt * 32 + 8 * g + 4 * h;
              float v0 = acc[mt][nt][4 * g], v1 = acc[mt][nt][4 * g + 1], v2 = acc[mt][nt][4 * g + 2], v3 = acc[mt][nt][4 * g + 3];
              if (nb < 1024) {
                float4 w4 = *(const float4*)(nw + (ncol - nb));
                v0 *= scale[mt] * w4.x; v1 *= scale[mt] * w4.y; v2 *= scale[mt] * w4.z; v3 *= scale[mt] * w4.w;
              }
              *(float4*)(eps + r * 144 + (8 * g + 4 * h) * 4) = make_float4(v0, v1, v2, v3);
              if (nb >= OFF_C && nb < OFF_GC) {
                const bool last = is_p ? ((m & 2047) == 2047) : (((m - NTOK_P) & 31) == 31);
                if (last) {
                  float* dst = p.out + (is_p ? O_SHP + ((size_t)layer * 32 + (m >> 11)) * 832 : O_SHS + ((size_t)layer * 16 + ((m - NTOK_P) >> 5)) * 832) + (ncol - OFF_C);
                  *(float4*)dst = make_float4(v0, v1, v2, v3);
                }
              }
            }
            __builtin_amdgcn_wave_barrier();
#pragma unroll
            for (int it = 0; it < 2; ++it) {
              const int row = (lane >> 2) + 16 * it, ch = lane & 3;
              const float4 a = *(const float4*)(eps + row * 144 + ch * 32), c = *(const float4*)(eps + row * 144 + ch * 32 + 16);
              u32x4 o; o.x = pk2(a.x, a.y); o.y = pk2(a.z, a.w); o.z = pk2(c.x, c.y); o.w = pk2(c.z, c.w);
              *(u32x4*)(p.P + (size_t)(mb + row) * D_IN + nb + nt * 32 + ch * 8) = o;
            }
            if (nb >= 512 && nb < 1536) {
#pragma unroll
              for (int it = 0; it < 4; ++it) {
                const int row = it * 8 + (lane >> 3), ch = lane & 7;
                const float4 a = *(const float4*)(eps + row * 144 + ch * 16);
                const int mm = mb + row;
                const bool pp = mm < NTOK_P;
                float* dst;
                if (nb < 1024) dst = p.out + (pp ? O_KP + ((size_t)layer * 65536 + mm) * 512 : O_KS + ((size_t)layer * 512 + (mm - NTOK_P)) * 512) + (nb - 512);
                else dst = p.out + (pp ? O_VP + ((size_t)layer * 65536 + mm) * 512 : O_VS + ((size_t)layer * 512 + (mm - NTOK_P)) * 512) + (nb - 1024);
                *(float4*)(dst + nt * 32 + ch * 4) = a;
              }
            }
            __builtin_amdgcn_wave_barrier();
          }
        }
      }
    } else if (MODE == 1) {
      const float* bg = p.b_glu + layer * 512;
#pragma unroll
      for (int mt = 0; mt < 2; ++mt) {
        const int m = m0 + wm * 64 + mt * 32 + r;
#pragma unroll
        for (int g = 0; g < 4; ++g) {
          const int col = tn * 64 + wn * 32 + 8 * g + 4 * h;
          float4 bv = *(const float4*)(bg + col), bgt = *(const float4*)(bg + 256 + col);
          u32x2 gb = *(const u32x2*)(p.P + (size_t)m * D_IN + OFF_GB + col);
          float o0 = (acc[mt][0][4 * g] + bv.x) * sigmoidf_(acc[mt][1][4 * g] + bgt.x) * siluf_(bflo(gb.x));
          float o1 = (acc[mt][0][4 * g + 1] + bv.y) * sigmoidf_(acc[mt][1][4 * g + 1] + bgt.y) * siluf_(bfhi(gb.x));
          float o2 = (acc[mt][0][4 * g + 2] + bv.z) * sigmoidf_(acc[mt][1][4 * g + 2] + bgt.z) * siluf_(bflo(gb.y));
          float o3 = (acc[mt][0][4 * g + 3] + bv.w) * sigmoidf_(acc[mt][1][4 * g + 3] + bgt.w) * siluf_(bfhi(gb.y));
          u32x2 o; o.x = pk2(o0, o1); o.y = pk2(o2, o3);
          *(u32x2*)(p.mix + (size_t)m * 1024 + 512 + col) = o;
        }
      }
    } else {
      const float* nw1 = p.norm_w + 1024;
#pragma unroll
      for (int mt = 0; mt < 2; ++mt) {
        const int mb = m0 + wm * 64 + mt * 32;
        float sq[4] = {0.f, 0.f, 0.f, 0.f};
#pragma unroll
        for (int nt = 0; nt < 2; ++nt) {
#pragma unroll
          for (int g = 0; g < 4; ++g)
            *(float4*)(eps + r * 144 + (8 * g + 4 * h) * 4) = make_float4(acc[mt][nt][4 * g], acc[mt][nt][4 * g + 1], acc[mt][nt][4 * g + 2], acc[mt][nt][4 * g + 3]);
          __builtin_amdgcn_wave_barrier();
#pragma unroll
          for (int it = 0; it < 4; ++it) {
            const int row = it * 8 + (lane >> 3), ch = lane & 7;
            const float4 a = *(const float4*)(eps + row * 144 + ch * 16);
            const int mm = mb + row, ncol = n0 + wn * 64 + nt * 32 + ch * 4;
            float4 xv = *(const float4*)(xrow(p, layer, mm) + ncol);
            xv.x += a.x; xv.y += a.y; xv.z += a.z; xv.w += a.w;
            *(float4*)(p.out + (size_t)mm * 1024 + ncol) = xv;
            if (layer == 0) {
              sq[it] += xv.x * xv.x + xv.y * xv.y + xv.z * xv.z + xv.w * xv.w;
              const float4 w4 = *(const float4*)(nw1 + ncol);
              u32x2 o; o.x = pk2(xv.x * w4.x, xv.y * w4.y); o.y = pk2(xv.z * w4.z, xv.w * w4.w);
              *(u32x2*)(p.hbf + (size_t)mm * 1024 + ncol) = o;
            }
          }
          __builtin_amdgcn_wave_barrier();
        }
        if (layer == 0) {
#pragma unroll
          for (int it = 0; it < 4; ++it) {
            const float s = sum8(sq[it]);
            if ((lane & 7) == 0) atomicAdd(p.ssq + mb + it * 8 + (lane >> 3), s);
          }
        }
      }
    }
    zero_acc();
  }
}

constexpr int VS = 66;
DI void attn_item(const Params& p, int layer, int wi, bf16_t* vl) {
  const int lane = TID & 63, r = lane & 31, h = lane >> 5;
  const bool sample = wi >= 16384;
  int b, hd, qt, tok0, qabs0;
  if (!sample) { b = wi >> 9; hd = (wi >> 6) & 7; qt = wi & 63; tok0 = b * 2048; qabs0 = qt * 32; }
  else { int j = wi - 16384; b = j >> 3; hd = j & 7; qt = 0; tok0 = NTOK_P + b * 32; qabs0 = 4096; }
  const int tq0 = tok0 + qt * 32;
  bf16x8 qf[4];
  {
    const bf16_t* qp = p.P + (size_t)(tq0 + r) * D_IN + OFF_Q + hd * 64 + h * 8;
#pragma unroll
    for (int ks = 0; ks < 4; ++ks) qf[ks] = *(const bf16x8*)(qp + ks * 16);
  }
  f32x16 o[2];
#pragma unroll
  for (int d = 0; d < 2; ++d)
#pragma unroll
    for (int i = 0; i < 16; ++i) o[d][i] = 0.f;
  float run = 0.f;
  const int nblk = qabs0 / 32 + 1;
  const int pir = 16 * ((r >> 2) & 1) + 4 * (r >> 3) + (r & 3);
  const float* ck = p.cache_k + ((size_t)(layer * 16 + b) * 4096) * 512 + hd * 64;
  const float* cv = p.cache_v + ((size_t)(layer * 16 + b) * 4096) * 512 + hd * 64;

  for (int kb = nblk - 1; kb >= 0; --kb) {
    const int kp0 = kb * 32;
    const bool fromP = (!sample) || (kb == 128);
    bf16x8 kf[4];
    if (fromP) {
      const int tk = sample ? (tok0 + (kp0 + pir - 4096)) : (tok0 + kp0 + pir);
      const bf16_t* kp = p.P + (size_t)tk * D_IN + OFF_K + hd * 64 + h * 8;
#pragma unroll
      for (int ks = 0; ks < 4; ++ks) kf[ks] = *(const bf16x8*)(kp + ks * 16);
#pragma unroll
      for (int i = 0; i < 4; ++i) {
        const int key = i * 8 + (lane >> 3), dc = lane & 7;
        const int tv = sample ? (tok0 + (kp0 + key - 4096)) : (tok0 + kp0 + key);
        u32x4 v = *(const u32x4*)(p.P + (size_t)tv * D_IN + OFF_V + hd * 64 + dc * 8);
        unsigned* dst = (unsigned*)(vl + key * VS + dc * 8);
        dst[0] = v.x; dst[1] = v.y; dst[2] = v.z; dst[3] = v.w;
      }
    } else {
      const float* kp = ck + (size_t)(kp0 + pir) * 512 + h * 8;
#pragma unroll
      for (int ks = 0; ks < 4; ++ks) {
        float4 a = *(const float4*)(kp + ks * 16), c = *(const float4*)(kp + ks * 16 + 4);
        u32x4 t; t.x = pk2(a.x, a.y); t.y = pk2(a.z, a.w); t.z = pk2(c.x, c.y); t.w = pk2(c.z, c.w);
        kf[ks] = __builtin_bit_cast(bf16x8, t);
      }
#pragma unroll
      for (int i = 0; i < 4; ++i) {
        const int key = i * 8 + (lane >> 3), dc = lane & 7;
        const float* vp = cv + (size_t)(kp0 + key) * 512 + dc * 8;
        float4 a = *(const float4*)vp, c = *(const float4*)(vp + 4);
        unsigned* dst = (unsigned*)(vl + key * VS + dc * 8);
        dst[0] = pk2(a.x, a.y); dst[1] = pk2(a.z, a.w); dst[2] = pk2(c.x, c.y); dst[3] = pk2(c.z, c.w);
      }
    }
    f32x16 st;
#pragma unroll
    for (int i = 0; i < 16; ++i) st[i] = 0.f;
#pragma unroll
    for (int ks = 0; ks < 4; ++ks) st = MFMA(kf[ks], qf[ks], st);
    const bool diag = (kb == nblk - 1);
    float z[16], lk[16], lat[16];
#pragma unroll
    for (int i = 0; i < 16; ++i) {
      z[i] = st[i] * 0.125f;
      const bool msk = (!diag) || (16 * h + i < r);
      const float e = __expf(-fabsf(z[i]));
      const float sp = fmaxf(z[i], 0.f) + __logf(1.f + e);
      lk[i] = msk ? -sp : 0.f;
    }
    float suf = 0.f;
#pragma unroll
    for (int i = 15; i >= 0; --i) { lat[i] = suf; suf += lk[i]; }
    const float other = __shfl_xor(suf, 32);
    const float base = run + (h == 0 ? other : 0.f);
    float a[16];
#pragma unroll
    for (int i = 0; i < 16; ++i) {
      const bool msk = (!diag) || (16 * h + i < r);
      a[i] = msk ? __expf(z[i] + lk[i] + base + lat[i]) : 0.f;
    }
    run += suf + other;
    __builtin_amdgcn_wave_barrier();
#pragma unroll
    for (int s2 = 0; s2 < 2; ++s2) {
      u32x4 t; t.x = pk2(a[8 * s2], a[8 * s2 + 1]); t.y = pk2(a[8 * s2 + 2], a[8 * s2 + 3]); t.z = pk2(a[8 * s2 + 4], a[8 * s2 + 5]); t.w = pk2(a[8 * s2 + 6], a[8 * s2 + 7]);
      const bf16x8 pf = __builtin_bit_cast(bf16x8, t);
#pragma unroll
      for (int dt = 0; dt < 2; ++dt) {
        const bf16_t* vp = vl + (16 * h + 8 * s2) * VS + 32 * dt + r;
        bf16x8 vf;
#pragma unroll
        for (int j = 0; j < 8; ++j) vf[j] = (short)vp[j * VS];
        o[dt] = MFMA(vf, pf, o[dt]);
      }
    }
    __builtin_amdgcn_wave_barrier();
    if (__all(run < -104.f)) break;
  }
  const int tok = tq0 + r;
#pragma unroll
  for (int dt = 0; dt < 2; ++dt)
#pragma unroll
    for (int g = 0; g < 4; ++g) {
      const int d0 = 32 * dt + 8 * g + 4 * h;
      u32x2 ga = *(const u32x2*)(p.P + (size_t)tok * D_IN + OFF_GA + hd * 64 + d0);
      u32x2 ov;
      ov.x = pk2(o[dt][4 * g] * siluf_(bflo(ga.x)), o[dt][4 * g + 1] * siluf_(bfhi(ga.x)));
      ov.y = pk2(o[dt][4 * g + 2] * siluf_(bflo(ga.y)), o[dt][4 * g + 3] * siluf_(bfhi(ga.y)));
      *(u32x2*)(p.mix + (size_t)tok * 1024 + hd * 64 + d0) = ov;
    }
}

constexpr int S5_BU = 8192;
constexpr int S5_LDS = S5_BU + 8704 + 1024;
DI void s5_disc(const Params& p, int lg, int pi, float dt, float& ar, float& ai, float& fr, float& fi) {
  const float lr = fminf(p.lam_re[lg * 64 + pi], -1e-4f), li = p.lam_im[lg * 64 + pi];
  const float er = expf(lr * dt);
  ar = er * cosf(li * dt); ai = er * sinf(li * dt);
  const float den = lr * lr + li * li;
  fr = ((ar - 1.f) * lr + ai * li) / den; fi = (ai * lr - (ar - 1.f) * li) / den;
}
DI void s5_item(const Params& p, int layer, int item, char* lds) {
  float* BU = (float*)lds;
  char* Himg = lds + S5_BU;
  bf16_t* Ub = (bf16_t*)(lds + S5_BU + 8704);
  const int lane = TID & 63, r = lane & 31, h = lane >> 5;
  const int seq = item >> 4, g = item & 15;
  const bool sample = seq >= 32;
  const int b = sample ? seq - 32 : seq, L = sample ? 32 : 2048, tok0 = sample ? NTOK_P + b * 32 : b * 2048;
  const int lg = layer * 16 + g;
  const float dt = expf(p.log_dt[lg]);
  float ar, ai, fr_, fi_;
  s5_disc(p, lg, lane, dt, ar, ai, fr_, fi_);
  bf16x8 bbf[4];
#pragma unroll
  for (int half = 0; half < 2; ++half) {
    const int pi = 32 * half + r;
    float a_r, a_i, f_r, f_i;
    s5_disc(p, lg, pi, dt, a_r, a_i, f_r, f_i);
    const float* brp = p.b_re + ((size_t)lg * 64 + pi) * 16 + 8 * h;
    const float* bip = p.b_im + ((size_t)lg * 64 + pi) * 16 + 8 * h;
    float re[8], im[8];
#pragma unroll
    for (int j = 0; j < 8; ++j) { const float br = brp[j], bi = bip[j]; re[j] = f_r * br - f_i * bi; im[j] = f_r * bi + f_i * br; }
    u32x4 t0, t1;
    t0.x = pk2(re[0], re[1]); t0.y = pk2(re[2], re[3]); t0.z = pk2(re[4], re[5]); t0.w = pk2(re[6], re[7]);
    t1.x = pk2(im[0], im[1]); t1.y = pk2(im[2], im[3]); t1.z = pk2(im[4], im[5]); t1.w = pk2(im[6], im[7]);
    bbf[half] = __builtin_bit_cast(bf16x8, t0);
    bbf[2 + half] = __builtin_bit_cast(bf16x8, t1);
  }
  bf16x8 cf[8];
#pragma unroll
  for (int s = 0; s < 8; ++s) {
    u32x4 t; t.x = 0; t.y = 0; t.z = 0; t.w = 0;
    if (r < 16) {
      const int k0 = 16 * s + 8 * h;
      const float* src = (s < 4 ? p.c_re : p.c_im) + ((size_t)lg * 16 + r) * 64 + (k0 & 63);
      const float sg = s < 4 ? 1.f : -1.f;
      const float4 c0 = *(const float4*)src, c1 = *(const float4*)(src + 4);
      t.x = pk2(sg * c0.x, sg * c0.y); t.y = pk2(sg * c0.z, sg * c0.w); t.z = pk2(sg * c1.x, sg * c1.y); t.w = pk2(sg * c1.z, sg * c1.w);
    }
    cf[s] = __builtin_bit_cast(bf16x8, t);
  }
  const float dl = p.ssm_d[lg * 16 + (r & 15)];
  float hr = 0.f, hi = 0.f;
  if (sample) { hr = p.st_re[((size_t)(layer * 16 + b) * 16 + g) * 64 + lane]; hi = p.st_im[((size_t)(layer * 16 + b) * 16 + g) * 64 + lane]; }
  f32x16 zero;
#pragma unroll
  for (int i = 0; i < 16; ++i) zero[i] = 0.f;
  const bf16_t* upb = p.P + (size_t)(tok0 + r) * D_IN + OFF_U + g * 16 + 8 * h;
  bf16x8 uf = *(const bf16x8*)upb;
  for (int t0 = 0; t0 < L; t0 += 32) {
    const bf16x8 ucur = uf;
    if (t0 + 32 < L) uf = *(const bf16x8*)(upb + (size_t)(t0 + 32) * D_IN);
    *(bf16x8*)(Ub + r * 16 + 8 * h) = ucur;
    f32x16 d[4];
#pragma unroll
    for (int tile = 0; tile < 4; ++tile) d[tile] = MFMA(ucur, bbf[tile], zero);
#pragma unroll
    for (int hf = 0; hf < 2; ++hf) {
#pragma unroll
      for (int tile = 0; tile < 4; ++tile)
#pragma unroll
        for (int i = 0; i < 8; ++i) BU[((i & 3) + 8 * (i >> 2) + 4 * h) * 128 + 32 * tile + r] = d[tile][8 * hf + i];
      __builtin_amdgcn_wave_barrier();
#pragma unroll
      for (int tt = 0; tt < 16; ++tt) {
        const int t = 16 * hf + tt;
        const float bur = BU[tt * 128 + lane], bui = BU[tt * 128 + 64 + lane];
        const float nhr = ar * hr - ai * hi + bur, nhi = ar * hi + ai * hr + bui;
        hr = nhr; hi = nhi;
        *(bf16_t*)(Himg + t * 272 + lane * 2) = (bf16_t)f2bf(hr);
        *(bf16_t*)(Himg + t * 272 + 128 + lane * 2) = (bf16_t)f2bf(hi);
      }
      __builtin_amdgcn_wave_barrier();
    }
    f32x16 yacc = zero;
#pragma unroll
    for (int s = 0; s < 8; ++s) {
      const bf16x8 af = *(const bf16x8*)(Himg + r * 272 + s * 32 + h * 16);
      yacc = MFMA(af, cf[s], yacc);
    }
    if (r < 16) {
#pragma unroll
      for (int i = 0; i < 16; ++i) {
        const int t = (i & 3) + 8 * (i >> 2) + 4 * h;
        const float yv = yacc[i] + dl * bf2f(Ub[t * 16 + r]);
        const float gl = yv / (1.f + __expf(-1.5957691216f * (yv + 0.044715f * yv * yv * yv)));
        p.yb[(size_t)(tok0 + t0 + t) * 256 + g * 16 + r] = (bf16_t)f2bf(gl);
      }
    }
    __builtin_amdgcn_wave_barrier();
  }
  float* ore = p.out + (sample ? O_SRES : O_SREP) + ((size_t)(layer * (sample ? 16 : 32) + b) * 16 + g) * 64 + lane;
  float* oim = p.out + (sample ? O_SIMS : O_SIMP) + ((size_t)(layer * (sample ? 16 : 32) + b) * 16 + g) * 64 + lane;
  *ore = hr; *oim = hi;
}

DI void rwkv_item(const Params& p, int layer, int item, char* smem) {
  float* R = (float*)smem; float* W = R + 2048; float* KT = W + 2048; float* KH = KT + 2048; float* BB = KH + 2048;
  float* V = BB + 2048; float* Y = V + 2048; float* DSUM = Y + 2048; float* ASUM = DSUM + 2048; float* BON = ASUM + 2048;
  bf16_t* LORAb = (bf16_t*)(BON + 32);
  const int tid = TID, lane = tid & 63, wv = tid >> 6;
  const int seq = item >> 2, hd = item & 3;
  const bool sample = seq >= 32;
  const int b = sample ? seq - 32 : seq, L = sample ? 32 : 2048, tok0 = sample ? NTOK_P + b * 32 : b * 2048;
  const int cg_ = hd * 64 + lane;
  bf16x8 lb[2];
  {
    const int ll = (wv >> 1) & 1, nn = wv & 1, r_ = lane & 31, h_ = lane >> 5;
    const float* srcw = (ll ? p.a2 : p.w2) + (size_t)layer * 32 * 256 + hd * 64 + 32 * nn + r_;
#pragma unroll
    for (int s = 0; s < 2; ++s) {
      float t[8];
#pragma unroll
      for (int j = 0; j < 8; ++j) t[j] = srcw[(size_t)(16 * s + 8 * h_ + j) * 256];
      u32x4 u; u.x = pk2(t[0], t[1]); u.y = pk2(t[2], t[3]); u.z = pk2(t[4], t[5]); u.w = pk2(t[6], t[7]);
      lb[s] = __builtin_bit_cast(bf16x8, u);
    }
  }
  const float w0c = p.w0[layer * 256 + cg_], a0c = p.a0[layer * 256 + cg_], kkc = p.k_k[layer * 256 + cg_], kac = p.k_a[layer * 256 + cg_];
  const float ubc = p.u_bonus[layer * 256 + cg_], lnw = p.ln_w[layer * 256 + cg_], lnb = p.ln_b[layer * 256 + cg_];
  const float* mu = p.mu + layer * 832;
  const float mu_r = mu[cg_], mu_k = mu[256 + cg_], mu_v = mu[512 + cg_], mu_l = mu[768 + lane];
  const float* shp = p.st_shift + (size_t)(layer * 16 + b) * 832;
  const int row = tid >> 3, kq = tid & 7;
  f32x2 S[4];
  if (sample) {
    const float* sp = p.st_wkv + (((size_t)(layer * 16 + b) * 4 + hd) * 64 + row) * 64 + kq * 8;
#pragma unroll
    for (int j = 0; j < 4; ++j) { S[j].x = sp[2 * j]; S[j].y = sp[2 * j + 1]; }
  } else {
#pragma unroll
    for (int j = 0; j < 4; ++j) { S[j].x = 0.f; S[j].y = 0.f; }
  }
  bf16_t cr[4], ck[4], cv[4], cl[4], qr[4], qk[4], qv[4], ql[4], cgt[4];
#pragma unroll
  for (int i = 0; i < 4; ++i) {
    const bf16_t* cp = p.P + (size_t)(tok0 + wv + 8 * i) * D_IN + OFF_C;
    const bf16_t* pp = cp - D_IN;
    cr[i] = cp[cg_]; ck[i] = cp[256 + cg_]; cv[i] = cp[512 + cg_]; cl[i] = cp[768 + lane]; cgt[i] = cp[OFF_GC - OFF_C + cg_];
    qr[i] = pp[cg_]; qk[i] = pp[256 + cg_]; qv[i] = pp[512 + cg_]; ql[i] = pp[768 + lane];
  }
  for (int c0 = 0; c0 < L; c0 += 32) {
    float xr[4], xk[4], xv[4], gt[4];
#pragma unroll
    for (int i = 0; i < 4; ++i) {
      const int tl = wv + 8 * i;
      const bool first = (c0 + tl == 0);
      float pr, pk, pv, pl;
      if (first) {
        if (sample) { pr = shp[cg_]; pk = shp[256 + cg_]; pv = shp[512 + cg_]; pl = shp[768 + lane]; }
        else { pr = 0.f; pk = 0.f; pv = 0.f; pl = 0.f; }
      } else { pr = bf2f(qr[i]); pk = bf2f(qk[i]); pv = bf2f(qv[i]); pl = bf2f(ql[i]); }
      const float c_r = bf2f(cr[i]), c_k = bf2f(ck[i]), c_v = bf2f(cv[i]), c_l = bf2f(cl[i]);
      gt[i] = bf2f(cgt[i]);
      xr[i] = c_r + mu_r * (pr - c_r); xk[i] = c_k + mu_k * (pk - c_k); xv[i] = c_v + mu_v * (pv - c_v);
      const float xl = c_l + mu_l * (pl - c_l);
      LORAb[tl * 72 + lane] = (bf16_t)f2bf(lane < 32 ? fast_tanh(xl) : xl);
    }
    lds_barrier();
    if (c0 + 32 < L) {
#pragma unroll
      for (int i = 0; i < 4; ++i) {
        const bf16_t* cp = p.P + (size_t)(tok0 + c0 + 32 + wv + 8 * i) * D_IN + OFF_C;
        const bf16_t* pp = cp - D_IN;
        cr[i] = cp[cg_]; ck[i] = cp[256 + cg_]; cv[i] = cp[512 + cg_]; cl[i] = cp[768 + lane]; cgt[i] = cp[OFF_GC - OFF_C + cg_];
        qr[i] = pp[cg_]; qk[i] = pp[256 + cg_]; qv[i] = pp[512 + cg_]; ql[i] = pp[768 + lane];
      }
    }
    if (wv < 4) {
      const int r_ = lane & 31, h_ = lane >> 5, ll = wv >> 1, nn = wv & 1;
      f32x16 dacc;
#pragma unroll
      for (int i = 0; i < 16; ++i) dacc[i] = 0.f;
#pragma unroll
      for (int s = 0; s < 2; ++s) {
        const bf16x8 af = *(const bf16x8*)((const char*)LORAb + r_ * 144 + ll * 64 + s * 32 + h_ * 16);
        dacc = MFMA(af, lb[s], dacc);
      }
      float* dst = (ll ? ASUM : DSUM) + 32 * nn + r_;
#pragma unroll
      for (int i = 0; i < 16; ++i) dst[((i & 3) + 8 * (i >> 2) + 4 * h_) * 64] = dacc[i];
    }
    lds_barrier();
#pragma unroll
    for (int i = 0; i < 4; ++i) {
      const int tl = wv + 8 * i;
      const float dsum = w0c + DSUM[tl * 64 + lane], asum = a0c + ASUM[tl * 64 + lane];
      const float dec = __expf(-0.6065306597f * sigmoidf_(dsum));
      const float a = sigmoidf_(asum);
      const float kk = xk[i] * kkc;
      const float ss = wave_sum(kk * kk);
      const float kh = kk * rsqrtf(ss + 1e-12f);
      const float kt = xk[i] * (1.f + (a - 1.f) * kac);
      const float bon = wave_sum(xr[i] * kt * ubc);
      R[tl * 64 + lane] = xr[i]; W[tl * 64 + lane] = dec; KT[tl * 64 + lane] = kt; KH[tl * 64 + lane] = kh; BB[tl * 64 + lane] = a * kh; V[tl * 64 + lane] = xv[i];
      if (lane == 0) BON[tl] = bon;
    }
    lds_barrier();
    float ykeep[4];
    float4 nkh0, nkh1, nw0, nw1, nb0, nb1, nk0, nk1, nr0, nr1; float nvv;
    {
      const int o = kq * 8;
      nkh0 = *(const float4*)(KH + o); nkh1 = *(const float4*)(KH + o + 4); nw0 = *(const float4*)(W + o); nw1 = *(const float4*)(W + o + 4);
      nb0 = *(const float4*)(BB + o); nb1 = *(const float4*)(BB + o + 4); nk0 = *(const float4*)(KT + o); nk1 = *(const float4*)(KT + o + 4);
      nr0 = *(const float4*)(R + o); nr1 = *(const float4*)(R + o + 4); nvv = V[row];
    }
#pragma unroll
    for (int q = 0; q < 4; ++q) {
      ykeep[q] = 0.f;
#pragma unroll
      for (int e = 0; e < 8; ++e) {
        const int tl = q * 8 + e;
        const float4 kh0 = nkh0, kh1 = nkh1, w0_ = nw0, w1_ = nw1, b0 = nb0, b1 = nb1, k0 = nk0, k1 = nk1, r0 = nr0, r1 = nr1;
        const float vv = nvv;
        if (tl < 31) {
          const int o = (tl + 1) * 64 + kq * 8;
          nkh0 = *(const float4*)(KH + o); nkh1 = *(const float4*)(KH + o + 4); nw0 = *(const float4*)(W + o); nw1 = *(const float4*)(W + o + 4);
          nb0 = *(const float4*)(BB + o); nb1 = *(const float4*)(BB + o + 4); nk0 = *(const float4*)(KT + o); nk1 = *(const float4*)(KT + o + 4);
          nr0 = *(const float4*)(R + o); nr1 = *(const float4*)(R + o + 4); nvv = V[(tl + 1) * 64 + row];
        }
        const f32x2 khv[4] = {{kh0.x, kh0.y}, {kh0.z, kh0.w}, {kh1.x, kh1.y}, {kh1.z, kh1.w}};
        const f32x2 wvv[4] = {{w0_.x, w0_.y}, {w0_.z, w0_.w}, {w1_.x, w1_.y}, {w1_.z, w1_.w}};
        const f32x2 bv[4] = {{b0.x, b0.y}, {b0.z, b0.w}, {b1.x, b1.y}, {b1.z, b1.w}};
        const f32x2 kv[4] = {{k0.x, k0.y}, {k0.z, k0.w}, {k1.x, k1.y}, {k1.z, k1.w}};
        const f32x2 rv[4] = {{r0.x, r0.y}, {r0.z, r0.w}, {r1.x, r1.y}, {r1.z, r1.w}};
        const f32x2 vv2 = {vv, vv};
        f32x2 m[4];
#pragma unroll
        for (int j = 0; j < 4; ++j) m[j] = fma2(S[j], wvv[j], vv2 * kv[j]);
        f32x2 sa2 = fma2(S[1], khv[1], S[0] * khv[0]), sb2 = fma2(S[3], khv[3], S[2] * khv[2]);
        sa2 += sb2;
        const float sa = sum8(sa2.x + sa2.y);
        const f32x2 nsa = {-sa, -sa};
#pragma unroll
        for (int j = 0; j < 4; ++j) S[j] = fma2(nsa, bv[j], m[j]);
        f32x2 y2 = fma2(S[1], rv[1], S[0] * rv[0]), y3 = fma2(S[3], rv[3], S[2] * rv[2]);
        y2 += y3;
        const float yv = sum8(y2.x + y2.y);
        ykeep[q] = (e == kq) ? yv : ykeep[q];
      }
    }
#pragma unroll
    for (int q = 0; q < 4; ++q) Y[(q * 8 + kq) * 64 + row] = ykeep[q];
    lds_barrier();
#pragma unroll
    for (int i = 0; i < 4; ++i) {
      const int tl = wv + 8 * i;
      const int tok = tok0 + c0 + tl;
      const float y = Y[tl * 64 + lane];
      const float mean = wave_sum(y) * (1.f / 64.f);
      const float d = y - mean;
      const float var = wave_sum(d * d) * (1.f / 64.f);
      float yn = d * rsqrtf(var + 64e-5f) * lnw + lnb;
      yn += BON[tl] * V[tl * 64 + lane];
      p.mix[(size_t)tok * 1024 + 768 + cg_] = (bf16_t)f2bf(yn * siluf_(gt[i]));
    }
  }
  lds_barrier();
  float* so = p.out + (sample ? O_WKVS : O_WKVP) + (((size_t)(layer * (sample ? 16 : 32) + b) * 4 + hd) * 64 + row) * 64 + kq * 8;
  *(float4*)so = make_float4(S[0].x, S[0].y, S[1].x, S[1].y);
  *(float4*)(so + 4) = make_float4(S[2].x, S[2].y, S[3].x, S[3].y);
}

constexpr int ATT_LDS0 = 6 * S5_LDS;
DI void phase_mixers(const Params& p, int layer, char* smem, int cofs) {
  const int G = GDIM, bid = BID, half = G / 2;
  const int tid = TID, wv = tid >> 6, lane = tid & 63;
  if (bid < half) {
    for (int item = bid; item < 128; item += half) rwkv_item(p, layer, item, smem);
  } else {
    const int j = bid - half, nb2 = G - half;
    for (int item = 128 + j; item < 192; item += nb2) rwkv_item(p, layer, item, smem);
    if (wv < 6) { for (int it = j * 6 + wv; it < 768; it += nb2 * 6) s5_item(p, layer, it, smem + wv * S5_LDS); }
  }
  unsigned* ctr = p.counters + layer + cofs;
  bf16_t* vl = (bf16_t*)(smem + ATT_LDS0) + wv * (32 * VS);
  while (true) {
    int it = 0;
    if (lane == 0) it = (int)atomicAdd(ctr, 1u);
    it = __builtin_amdgcn_readfirstlane(it);
    if (it >= 16512) break;
    attn_item(p, layer, it, vl);
  }
}

__global__ void __launch_bounds__(NT) mega(Params p) {
  __shared__ __attribute__((aligned(16))) char smem[SMEM_BYTES];
  cg::grid_group grid = cg::this_grid();
  phase_weights(p, smem);
  phase_norm(p, 0);
  grid.sync();
  for (int layer = 0; layer < 2; ++layer) {
    gemm_phase<0>(p, layer, smem);
    grid.sync();
#if PROBE_GEMM0
    gemm_phase<0>(p, layer, smem);
    grid.sync();
#endif
    phase_mixers(p, layer, smem, 0);
    grid.sync();
#if PROBE_MIX
    phase_mixers(p, layer, smem, 2);
    grid.sync();
#endif
    gemm_phase<1>(p, layer, smem);
    grid.sync();
    gemm_phase<2>(p, layer, smem);
    if (layer == 0) grid.sync();
  }
}

#if MULTI_LAUNCH
template <int PH>
__global__ void __launch_bounds__(NT) phase_kernel(Params p, int layer) {
  __shared__ __attribute__((aligned(16))) char smem[SMEM_BYTES];
  if (PH == 0) { phase_weights(p, smem); }
  else if (PH == 1) phase_norm(p, layer);
  else if (PH == 2) gemm_phase<0>(p, layer, smem);
  else if (PH == 3) phase_mixers(p, layer, smem, 0);
  else if (PH == 4) gemm_phase<1>(p, layer, smem);
  else gemm_phase<2>(p, layer, smem);
}
#endif

extern "C" void kernel_launch(void* const* d_in, const int* in_sizes, int n_in, void* d_out, int out_size, void* d_ws, size_t ws_size, hipStream_t stream) {
  Params p{};
  const float** f = (const float**)&p;
  for (int i = 0; i < 33; ++i) f[i] = (const float*)d_in[i];
  p.out = (float*)d_out;
  char* ws = (char*)d_ws;
  size_t off = 0;
  auto take = [&](size_t bytes) { char* q = ws + off; off += (bytes + 255) & ~(size_t)255; return q; };
  p.WinT = (bf16_t*)take((size_t)2 * 3648 * 1024 * 2);
  p.WoutT = (bf16_t*)take((size_t)2 * 1024 * 1024 * 2);
  p.WgluT = (bf16_t*)take((size_t)2 * 512 * 256 * 2);
  p.hbf = (bf16_t*)take((size_t)NTOK * 1024 * 2);
  p.P = (bf16_t*)take((size_t)NTOK * D_IN * 2);
  p.mix = (bf16_t*)take((size_t)NTOK * 1024 * 2);
  p.yb = (bf16_t*)take((size_t)NTOK * 256 * 2);
  p.counters = (unsigned*)take(256);
  p.ssq = (float*)take((size_t)NTOK * 4);
  if (off > ws_size || (size_t)out_size != O_END || n_in != 33) fprintf(stderr, "kernel_launch: unexpected sizes ws=%zu need=%zu out=%d n_in=%d\n", ws_size, off, out_size, n_in);
#if MULTI_LAUNCH
  const int G = 256;
  phase_kernel<0><<<G, NT, 0, stream>>>(p, 0);
  for (int layer = 0; layer < 2; ++layer) {
    phase_kernel<1><<<G, NT, 0, stream>>>(p, layer);
    phase_kernel<2><<<G, NT, 0, stream>>>(p, layer);
    phase_kernel<3><<<G, NT, 0, stream>>>(p, layer);
    phase_kernel<4><<<G, NT, 0, stream>>>(p, layer);
    phase_kernel<5><<<G, NT, 0, stream>>>(p, layer);
  }
#else
  static int grid_blocks = 0;
  if (!grid_blocks) {
    int dev = 0, cus = 0, per_cu = 0;
    hipGetDevice(&dev);
    hipDeviceGetAttribute(&cus, hipDeviceAttributeMultiprocessorCount, dev);
    hipOccupancyMaxActiveBlocksPerMultiprocessor(&per_cu, mega, NT, 0);
    if (per_cu < 1) per_cu = 1;
    grid_blocks = cus * per_cu;
  }
  void* args[] = {&p};
  hipError_t e = hipLaunchCooperativeKernel((void*)mega, dim3(grid_blocks), dim3(NT), args, 0, stream);
  if (e != hipSuccess) fprintf(stderr, "cooperative launch failed: %s (grid %d)\n", hipGetErrorString(e), grid_blocks);
#endif
}
```

```cpp
#include <hip/hip_runtime.h>
#include <hip/hip_cooperative_groups.h>
#include <cstdio>
namespace cg = cooperative_groups;

#define PROBE_GEMM0 0
#define PROBE_MIX 0
#ifndef MULTI_LAUNCH
#define MULTI_LAUNCH 0
#endif

#define DI __device__ __forceinline__
typedef unsigned short bf16_t;
typedef short bf16x8 __attribute__((ext_vector_type(8)));
typedef float f32x16 __attribute__((ext_vector_type(16)));
typedef unsigned u32x4 __attribute__((ext_vector_type(4)));
typedef unsigned u32x2 __attribute__((ext_vector_type(2)));
#define MFMA(a, b, c) __builtin_amdgcn_mfma_f32_32x32x16_bf16((a), (b), (c), 0, 0, 0)

constexpr int NT = 512;
constexpr int NTOK_P = 65536, NTOK = 66048, D_IN = 3648;
constexpr int OFF_Q = 0, OFF_K = 512, OFF_V = 1024, OFF_GA = 1536, OFF_U = 2048, OFF_GB = 2304, OFF_C = 2560, OFF_GC = 3392;
constexpr size_t O_Y = 0, O_KP = 67633152, O_VP = 134742016, O_SREP = 201850880, O_SIMP = 201916416, O_WKVP = 201981952,
                 O_SHP = 203030528, O_KS = 203083776, O_VS = 203608064, O_SRES = 204132352, O_SIMS = 204165120,
                 O_WKVS = 204197888, O_SHS = 204722176, O_END = 204748800;
constexpr int SMEM_BYTES = 2 * 55296 + 8 * 4608;
constexpr int LDS_ROW = 144;
constexpr int STAGE = (256 + 128) * LDS_ROW;

struct Params {
  const float *x_prompt, *x_sample, *cache_k, *cache_v, *st_re, *st_im, *st_wkv, *st_shift;
  const float *norm_w, *w_in, *q_norm_w, *k_norm_w, *lam_re, *lam_im, *log_dt, *b_re, *b_im, *c_re, *c_im, *ssm_d, *w_glu, *b_glu;
  const float *mu, *w0, *w2, *a0, *a2, *k_k, *k_a, *u_bonus, *ln_w, *ln_b, *w_out;
  float* out;
  bf16_t *WinT, *WoutT, *WgluT, *hbf, *P, *mix, *yb;
  unsigned* counters;
  float* ssq;
};

DI int opq_v(int x) { asm volatile("" : "+v"(x)); return x; }
DI int opq_s(int x) { asm volatile("" : "+s"(x)); return x; }
#define TID opq_v((int)threadIdx.x)
#define BID opq_s((int)blockIdx.x)
#define GDIM opq_s((int)gridDim.x)
DI unsigned f2bf(float x) { unsigned u = __float_as_uint(x); u += 0x7fffu + ((u >> 16) & 1u); return u >> 16; }
DI unsigned pk2(float a, float b) { return f2bf(a) | (f2bf(b) << 16); }
DI float bf2f(unsigned v) { return __uint_as_float(v << 16); }
DI float bflo(unsigned w) { return __uint_as_float(w << 16); }
DI float bfhi(unsigned w) { return __uint_as_float(w & 0xffff0000u); }
DI float sigmoidf_(float x) { return 1.f / (1.f + __expf(-x)); }
DI float siluf_(float x) { return x / (1.f + __expf(-x)); }
typedef float f32x2 __attribute__((ext_vector_type(2)));
DI f32x2 fma2(f32x2 a, f32x2 b, f32x2 c) { return __builtin_elementwise_fma(a, b, c); }
template <int CTRL> DI float dpp_mov(float x) { return __int_as_float(__builtin_amdgcn_update_dpp(0, __float_as_int(x), CTRL, 0xF, 0xF, true)); }
DI float sum8(float x) { x += dpp_mov<0xB1>(x); x += dpp_mov<0x4E>(x); x += dpp_mov<0x141>(x); return x; }
DI float fast_tanh(float x) { return 1.f - 2.f / (1.f + __expf(2.f * x)); }
DI void lds_barrier() { asm volatile("s_waitcnt lgkmcnt(0)\n\ts_barrier" ::: "memory"); }
DI float wave_sum(float v) {
  v += dpp_mov<0xB1>(v); v += dpp_mov<0x4E>(v); v += dpp_mov<0x141>(v); v += dpp_mov<0x140>(v);
  v += __int_as_float(__builtin_amdgcn_update_dpp(0, __float_as_int(v), 0x142, 0xA, 0xF, false));
  v += __int_as_float(__builtin_amdgcn_update_dpp(0, __float_as_int(v), 0x143, 0xC, 0xF, false));
  return __int_as_float(__builtin_amdgcn_readlane(__float_as_int(v), 63));
}
DI const float* xrow(const Params& p, int layer, int row) {
  if (layer == 0) return row < NTOK_P ? p.x_prompt + (size_t)row * 1024 : p.x_sample + (size_t)(row - NTOK_P) * 1024;
  return p.out + (size_t)row * 1024;
}

DI void transpose_tile(const float* __restrict__ src, int K, int N, bf16_t* __restrict__ dst, int k0, int n0, float* tile) {
  const int tid = TID;
#pragma unroll
  for (int i = 0; i < 8; ++i) { int idx = tid + NT * i; int kk = idx >> 6, nn = idx & 63; tile[kk * 65 + nn] = src[(size_t)(k0 + kk) * N + n0 + nn]; }
  __syncthreads();
#pragma unroll
  for (int i = 0; i < 8; ++i) { int idx = tid + NT * i; int nn = idx >> 6, kk = idx & 63; dst[(size_t)(n0 + nn) * K + k0 + kk] = (bf16_t)f2bf(tile[kk * 65 + nn]); }
  __syncthreads();
}
DI void phase_weights(const Params& p, char* smem) {
  float* tile = (float*)smem;
  const int bid = BID, gdim = GDIM;
  for (int t = bid; t < 2400; t += gdim) {
    int layer = t / 1200, j = t % 1200;
    if (j < 912) { int kt = j / 57, nt = j % 57; transpose_tile(p.w_in + (size_t)layer * 1024 * 3648, 1024, 3648, p.WinT + (size_t)layer * 3648 * 1024, kt * 64, nt * 64, tile); }
    else if (j < 1168) { j -= 912; int kt = j / 16, nt = j % 16; transpose_tile(p.w_out + (size_t)layer * 1024 * 1024, 1024, 1024, p.WoutT + (size_t)layer * 1024 * 1024, kt * 64, nt * 64, tile); }
    else { j -= 1168; int kt = j / 8, nt = j % 8; transpose_tile(p.w_glu + (size_t)layer * 256 * 512, 256, 512, p.WgluT + (size_t)layer * 512 * 256, kt * 64, nt * 64, tile); }
  }
  { const int tid = TID; if (bid == 0 && tid < 64) p.counters[tid] = 0;
    for (int i = bid * NT + tid; i < NTOK; i += gdim * NT) p.ssq[i] = 0.f; }
}

DI void phase_norm(const Params& p, int layer) {
  const int tid = TID, lane = tid & 63, w = tid >> 6;
  const int bid = BID, gdim = GDIM;
  const float* nw = p.norm_w + layer * 1024;
  const int stride = gdim * 8;
  for (int row0 = bid * 8 + w; row0 < NTOK; row0 += 2 * stride) {
    const int row1 = row0 + stride;
    const bool has1 = row1 < NTOK;
    const float* x0 = xrow(p, layer, row0);
    const float* x1 = xrow(p, layer, has1 ? row1 : row0);
    float4 v0[4], v1[4]; float s0 = 0.f, s1 = 0.f;
#pragma unroll
    for (int i = 0; i < 4; ++i) { v0[i] = *(const float4*)(x0 + i * 256 + lane * 4); v1[i] = *(const float4*)(x1 + i * 256 + lane * 4); }
#pragma unroll
    for (int i = 0; i < 4; ++i) {
      s0 += v0[i].x * v0[i].x + v0[i].y * v0[i].y + v0[i].z * v0[i].z + v0[i].w * v0[i].w;
      s1 += v1[i].x * v1[i].x + v1[i].y * v1[i].y + v1[i].z * v1[i].z + v1[i].w * v1[i].w;
    }
    s0 = wave_sum(s0); s1 = wave_sum(s1);
    const float c0 = rsqrtf(s0 * (1.f / 1024.f) + 1e-6f), c1 = rsqrtf(s1 * (1.f / 1024.f) + 1e-6f);
#pragma unroll
    for (int i = 0; i < 4; ++i) {
      float4 wv = *(const float4*)(nw + i * 256 + lane * 4);
      u32x2 o; o.x = pk2(v0[i].x * c0 * wv.x, v0[i].y * c0 * wv.y); o.y = pk2(v0[i].z * c0 * wv.z, v0[i].w * c0 * wv.w);
      *(u32x2*)(p.hbf + (size_t)row0 * 1024 + i * 256 + lane * 4) = o;
      if (has1) {
        u32x2 o1; o1.x = pk2(v1[i].x * c1 * wv.x, v1[i].y * c1 * wv.y); o1.y = pk2(v1[i].z * c1 * wv.z, v1[i].w * c1 * wv.w);
        *(u32x2*)(p.hbf + (size_t)row1 * 1024 + i * 256 + lane * 4) = o1;
      }
    }
  }
}

template <int MODE>
DI void gemm_phase(const Params& p, int layer, char* smem) {
  constexpr int K = (MODE == 1) ? 256 : 1024;
  constexpr int NTN = (MODE == 0) ? 29 : (MODE == 1 ? 4 : 8);
  constexpr int KT = K / 64;
  const bf16_t* __restrict__ A = MODE == 0 ? p.hbf : (MODE == 1 ? p.yb : p.mix);
  const bf16_t* __restrict__ Bt = MODE == 0 ? p.WinT + (size_t)layer * 3648 * 1024 : (MODE == 1 ? p.WgluT + (size_t)layer * 512 * 256 : p.WoutT + (size_t)layer * 1024 * 1024);
  const int tid = TID, lane = tid & 63, wv = tid >> 6, r = lane & 31, h = lane >> 5;
  const int wm = wv >> 1, wn = wv & 1;
  const int bid = BID, gdim = GDIM;
  const int xcd = bid & 7, jb = bid >> 3, nbx = (gdim - xcd + 7) >> 3;

  const int total_x = ((258 - xcd + 7) >> 3) * NTN;
  const int nmine = jb < total_x ? (total_x - jb + nbx - 1) / nbx : 0;
  if (nmine == 0) return;
  const int lrow = tid >> 3, kc = tid & 7;
  auto set_ptrs = [&](int idx, const bf16_t* (&ap)[4], const bf16_t* (&bp)[2]) {
    const int tmi_ = idx / NTN, tn_ = idx % NTN, m0_ = (xcd + 8 * tmi_) * 256, n0_ = tn_ * 128;
#pragma unroll
    for (int i = 0; i < 4; ++i) ap[i] = A + (size_t)(m0_ + lrow + 64 * i) * K + kc * 8;
#pragma unroll
    for (int i = 0; i < 2; ++i) {
      int row = lrow + 64 * i, brow;
      if (MODE == 0) { brow = n0_ + row; brow = brow < 3648 ? brow : 3647; }
      else if (MODE == 2) brow = n0_ + row;
      else { int wn_ = row >> 6, nt_ = (row >> 5) & 1, c_ = row & 31; brow = nt_ * 256 + tn_ * 64 + wn_ * 32 + c_; }
      bp[i] = Bt + (size_t)brow * K + kc * 8;
    }
  };
  f32x16 acc[2][2];
  auto zero_acc = [&]() {
#pragma unroll
    for (int a = 0; a < 2; ++a)
#pragma unroll
      for (int b = 0; b < 2; ++b)
#pragma unroll
        for (int i = 0; i < 16; ++i) acc[a][b][i] = 0.f;
  };
  auto compute = [&](const char* buf, char* nbuf, const u32x4 (&pa)[4], const u32x4 (&pb)[2]) {
    const char* As = buf; const char* Bs = buf + 256 * LDS_ROW;
    char* An = nbuf; char* Bn = nbuf + 256 * LDS_ROW;
#pragma unroll
    for (int s = 0; s < 4; ++s) {
      bf16x8 af[2], bfr[2];
#pragma unroll
      for (int mt = 0; mt < 2; ++mt) af[mt] = *(const bf16x8*)(As + (wm * 64 + mt * 32 + r) * LDS_ROW + s * 32 + h * 16);
#pragma unroll
      for (int nt = 0; nt < 2; ++nt) bfr[nt] = *(const bf16x8*)(Bs + (wn * 64 + nt * 32 + r) * LDS_ROW + s * 32 + h * 16);
#pragma unroll
      for (int mt = 0; mt < 2; ++mt)
#pragma unroll
        for (int nt = 0; nt < 2; ++nt) acc[mt][nt] = MFMA(bfr[nt], af[mt], acc[mt][nt]);
      if (s < 2) {
        *(u32x4*)(An + (lrow + 64 * (2 * s)) * LDS_ROW + kc * 16) = pa[2 * s];
        *(u32x4*)(An + (lrow + 64 * (2 * s + 1)) * LDS_ROW + kc * 16) = pa[2 * s + 1];
      } else {
        *(u32x4*)(Bn + (lrow + 64 * (s - 2)) * LDS_ROW + kc * 16) = pb[s - 2];
      }
    }
  };
  u32x4 sa[4][4], sb[4][2];
  const bf16_t* cap[4]; const bf16_t* cbp[2]; const bf16_t* nap[4]; const bf16_t* nbp[2];
  set_ptrs(jb, cap, cbp);
#pragma unroll
  for (int j = 0; j < 4; ++j) {
#pragma unroll
    for (int i = 0; i < 4; ++i) sa[j][i] = *(const u32x4*)(cap[i] + j * 64);
#pragma unroll
    for (int i = 0; i < 2; ++i) sb[j][i] = *(const u32x4*)(cbp[i] + j * 64);
  }
  {
    char* As = smem; char* Bs = smem + 256 * LDS_ROW;
#pragma unroll
    for (int i = 0; i < 4; ++i) *(u32x4*)(As + (lrow + 64 * i) * LDS_ROW + kc * 16) = sa[0][i];
#pragma unroll
    for (int i = 0; i < 2; ++i) *(u32x4*)(Bs + (lrow + 64 * i) * LDS_ROW + kc * 16) = sb[0][i];
  }
  lds_barrier();
  zero_acc();
  int c_idx = jb;
  for (int ti = 0; ti < nmine; ++ti) {
    set_ptrs(ti + 1 < nmine ? c_idx + nbx : c_idx, nap, nbp);
    for (int q = 0; q < KT / 4; ++q) {
      const bool lastq = (q == KT / 4 - 1);
      const int koff = lastq ? 0 : (4 * (q + 1)) * 64;
      const bf16_t* lap[4]; const bf16_t* lbp[2];
#pragma unroll
      for (int i = 0; i < 4; ++i) lap[i] = (lastq ? nap[i] : cap[i]) + koff;
#pragma unroll
      for (int i = 0; i < 2; ++i) lbp[i] = (lastq ? nbp[i] : cbp[i]) + koff;
#pragma unroll
      for (int j = 0; j < 4; ++j) {
#pragma unroll
        for (int i = 0; i < 4; ++i) sa[j][i] = *(const u32x4*)(lap[i] + j * 64);
#pragma unroll
        for (int i = 0; i < 2; ++i) sb[j][i] = *(const u32x4*)(lbp[i] + j * 64);
        compute(smem + (j & 1) * STAGE, smem + ((j + 1) & 1) * STAGE, sa[(j + 1) & 3], sb[(j + 1) & 3]);
        lds_barrier();
      }
    }
#pragma unroll
    for (int i = 0; i < 4; ++i) cap[i] = nap[i];
#pragma unroll
    for (int i = 0; i < 2; ++i) cbp[i] = nbp[i];
    const int idx = c_idx; c_idx += nbx;
    const int tmi = idx / NTN, tn = idx % NTN, tm = xcd + 8 * tmi;
    const int m0 = tm * 256, n0 = tn * 128;
    char* eps = smem + 2 * STAGE + wv * 4608;
    if (MODE == 0) {
      const int nb = n0 + wn * 64;
      if (nb < 3648) {
        if (layer == 1) {
#pragma unroll
          for (int mt = 0; mt < 2; ++mt) {
            const float rs = rsqrtf(p.ssq[m0 + wm * 64 + mt * 32 + r] * (1.f / 1024.f) + 1e-6f);
#pragma unroll
            for (int nt = 0; nt < 2; ++nt)
#pragma unroll
              for (int i = 0; i < 16; ++i) acc[mt][nt][i] *= rs;
          }
        }
        float scale[2] = {1.f, 1.f};
        if (nb < 1024) {
#pragma unroll
          for (int mt = 0; mt < 2; ++mt) {
            float ss = 0.f;
#pragma unroll
            for (int nt = 0; nt < 2; ++nt)
#pragma unroll
              for (int i = 0; i < 16; ++i) ss += acc[mt][nt][i] * acc[mt][nt][i];
            ss += __shfl_xor(ss, 32);
            scale[mt] = rsqrtf(ss * (1.f / 64.f) + 1e-6f);
          }
        }
        const float* nw = (nb < 512 ? p.q_norm_w : p.k_norm_w) + layer * 64;
#pragma unroll
        for (int mt = 0; mt < 2; ++mt) {
          const int mb = m0 + wm * 64 + mt * 32;
          const int m = mb + r;
          const bool is_p = m < NTOK_P;
#pragma unroll
          for (int nt = 0; nt < 2; ++nt) {
#pragma unroll
            for (int g = 0; g < 4; ++g) {
              const int ncol = nb + nt * 32 + 8 * g + 4 * h;
              float v0 = acc[mt][nt][4 * g], v1 = acc[mt][nt][4 * g + 1], v2 = acc[mt][nt][4 * g + 2], v3 = acc[mt][nt][4 * g + 3];
              if (nb < 1024) {
                float4 w4 = *(const float4*)(nw + (ncol - nb));
                v0 *= scale[mt] * w4.x; v1 *= scale[mt] * w4.y; v2 *= scale[mt] * w4.z; v3 *= scale[mt] * w4.w;
              }
              *(float4*)(eps + r * 144 + (8 * g + 4 * h) * 4) = make_float4(v0, v1, v2, v3);
              if (nb >= OFF_C && nb < OFF_GC) {
                const bool last = is_p ? ((m & 2047) == 2047) : (((m - NTOK_P) & 31) == 31);
                if (last) {
                  float* dst = p.out + (is_p ? O_SHP + ((size_t)layer * 32 + (m >> 11)) * 832 : O_SHS + ((size_t)layer * 16 + ((m - NTOK_P) >> 5)) * 832) + (ncol - OFF_C);
                  *(float4*)dst = make_float4(v0, v1, v2, v3);
                }
              }
            }
            __builtin_amdgcn_wave_barrier();
#pragma unroll
            for (int it = 0; it < 2; ++it) {
              const int row = (lane >> 2) + 16 * it, ch = lane & 3;
              const float4 a = *(const float4*)(eps + row * 144 + ch * 32), c = *(const float4*)(eps + row * 144 + ch * 32 + 16);
              u32x4 o; o.x = pk2(a.x, a.y); o.y = pk2(a.z, a.w); o.z = pk2(c.x, c.y); o.w = pk2(c.z, c.w);
              *(u32x4*)(p.P + (size_t)(mb + row) * D_IN + nb + nt * 32 + ch * 8) = o;
            }
            if (nb >= 512 && nb < 1536) {
#pragma unroll
              for (int it = 0; it < 4; ++it) {
                const int row = it * 8 + (lane >> 3), ch = lane & 7;
                const float4 a = *(const float4*)(eps + row * 144 + ch * 16);
                const int mm = mb + row;
                const bool pp = mm < NTOK_P;
                float* dst;
                if (nb < 1024) dst = p.out + (pp ? O_KP + ((size_t)layer * 65536 + mm) * 512 : O_KS + ((size_t)layer * 512 + (mm - NTOK_P)) * 512) + (nb - 512);
                else dst = p.out + (pp ? O_VP + ((size_t)layer * 65536 + mm) * 512 : O_VS + ((size_t)layer * 512 + (mm - NTOK_P)) * 512) + (nb - 1024);
                *(float4*)(dst + nt * 32 + ch * 4) = a;
              }
            }
            __builtin_amdgcn_wave_barrier();
          }
        }
      }
    } else if (MODE == 1) {
      const float* bg = p.b_glu + layer * 512;
#pragma unroll
      for (int mt = 0; mt < 2; ++mt) {
        const int m = m0 + wm * 64 + mt * 32 + r;
#pragma unroll
        for (int g = 0; g < 4; ++g) {
          const int col = tn * 64 + wn * 32 + 8 * g + 4 * h;
          float4 bv = *(const float4*)(bg + col), bgt = *(const float4*)(bg + 256 + col);
          u32x2 gb = *(const u32x2*)(p.P + (size_t)m * D_IN + OFF_GB + col);
          float o0 = (acc[mt][0][4 * g] + bv.x) * sigmoidf_(acc[mt][1][4 * g] + bgt.x) * siluf_(bflo(gb.x));
          float o1 = (acc[mt][0][4 * g + 1] + bv.y) * sigmoidf_(acc[mt][1][4 * g + 1] + bgt.y) * siluf_(bfhi(gb.x));
          float o2 = (acc[mt][0][4 * g + 2] + bv.z) * sigmoidf_(acc[mt][1][4 * g + 2] + bgt.z) * siluf_(bflo(gb.y));
          float o3 = (acc[mt][0][4 * g + 3] + bv.w) * sigmoidf_(acc[mt][1][4 * g + 3] + bgt.w) * siluf_(bfhi(gb.y));
          u32x2 o; o.x = pk2(o0, o1); o.y = pk2(o2, o3);
          *(u32x2*)(p.mix + (size_t)m * 1024 + 512 + col) = o;
        }
      }
    } else {
      const float* nw1 = p.norm_w + 1024;
#pragma unroll
      for (int mt = 0; mt < 2; ++mt) {
        const int mb = m0 + wm * 64 + mt * 32;
        float sq[4] = {0.f, 0.f, 0.f, 0.f};
#pragma unroll
        for (int nt = 0; nt < 2; ++nt) {
#pragma unroll
          for (int g = 0; g < 4; ++g)
            *(float4*)(eps + r * 144 + (8 * g + 4 * h) * 4) = make_float4(acc[mt][nt][4 * g], acc[mt][nt][4 * g + 1], acc[mt][nt][4 * g + 2], acc[mt][nt][4 * g + 3]);
          __builtin_amdgcn_wave_barrier();
#pragma unroll
          for (int it = 0; it < 4; ++it) {
            const int row = it * 8 + (lane >> 3), ch = lane & 7;
            const float4 a = *(const float4*)(eps + row * 144 + ch * 16);
            const int mm = mb + row, ncol = n0 + wn * 64 + nt * 32 + ch * 4;
            float4 xv = *(const float4*)(xrow(p, layer, mm) + ncol);
            xv.x += a.x; xv.y += a.y; xv.z += a.z; xv.w += a.w;
            *(float4*)(p.out + (size_t)mm * 1024 + ncol) = xv;
            if (layer == 0) {
              sq[it] += xv.x * xv.x + xv.y * xv.y + xv.z * xv.z + xv.w * xv.w;
              const float4 w4 = *(const float4*)(nw1 + ncol);
              u32x2 o; o.x = pk2(xv.x * w4.x, xv.y * w4.y); o.y = pk2(xv.z * w4.z, xv.w * w4.w);
              *(u32x2*)(p.hbf + (size_t)mm * 1024 + ncol) = o;
            }
          }
          __builtin_amdgcn_wave_barrier();
        }
        if (layer == 0) {
#pragma unroll
          for (int it = 0; it < 4; ++it) {
            const float s = sum8(sq[it]);
            if ((lane & 7) == 0) atomicAdd(p.ssq + mb + it * 8 + (lane >> 3), s);
          }
        }
      }
    }
    zero_acc();
  }
}

constexpr int VS = 66;
DI void attn_item(const Params& p, int layer, int wi, bf16_t* vl) {
  const int lane = TID & 63, r = lane & 31, h = lane >> 5;
  const bool sample = wi >= 16384;
  int b, hd, qt, tok0, qabs0;
  if (!sample) { b = wi >> 9; hd = (wi >> 6) & 7; qt = wi & 63; tok0 = b * 2048; qabs0 = qt * 32; }
  else { int j = wi - 16384; b = j >> 3; hd = j & 7; qt = 0; tok0 = NTOK_P + b * 32; qabs0 = 4096; }
  const int tq0 = tok0 + qt * 32;
  bf16x8 qf[4];
  {
    const bf16_t* qp = p.P + (size_t)(tq0 + r) * D_IN + OFF_Q + hd * 64 + h * 8;
#pragma unroll
    for (int ks = 0; ks < 4; ++ks) qf[ks] = *(const bf16x8*)(qp + ks * 16);
  }
  f32x16 o[2];
#pragma unroll
  for (int d = 0; d < 2; ++d)
#pragma unroll
    for (int i = 0; i < 16; ++i) o[d][i] = 0.f;
  float run = 0.f;
  const int nblk = qabs0 / 32 + 1;
  const int pir = 16 * ((r >> 2) & 1) + 4 * (r >> 3) + (r & 3);
  const float* ck = p.cache_k + ((size_t)(layer * 16 + b) * 4096) * 512 + hd * 64;
  const float* cv = p.cache_v + ((size_t)(layer * 16 + b) * 4096) * 512 + hd * 64;

  for (int kb = nblk - 1; kb >= 0; --kb) {
    const int kp0 = kb * 32;
    const bool fromP = (!sample) || (kb == 128);
    bf16x8 kf[4];
    if (fromP) {
      const int tk = sample ? (tok0 + (kp0 + pir - 4096)) : (tok0 + kp0 + pir);
      const bf16_t* kp = p.P + (size_t)tk * D_IN + OFF_K + hd * 64 + h * 8;
#pragma unroll
      for (int ks = 0; ks < 4; ++ks) kf[ks] = *(const bf16x8*)(kp + ks * 16);
#pragma unroll
      for (int i = 0; i < 4; ++i) {
        const int key = i * 8 + (lane >> 3), dc = lane & 7;
        const int tv = sample ? (tok0 + (kp0 + key - 4096)) : (tok0 + kp0 + key);
        u32x4 v = *(const u32x4*)(p.P + (size_t)tv * D_IN + OFF_V + hd * 64 + dc * 8);
        unsigned* dst = (unsigned*)(vl + key * VS + dc * 8);
        dst[0] = v.x; dst[1] = v.y; dst[2] = v.z; dst[3] = v.w;
      }
    } else {
      const float* kp = ck + (size_t)(kp0 + pir) * 512 + h * 8;
#pragma unroll
      for (int ks = 0; ks < 4; ++ks) {
        float4 a = *(const float4*)(kp + ks * 16), c = *(const float4*)(kp + ks * 16 + 4);
        u32x4 t; t.x = pk2(a.x, a.y); t.y = pk2(a.z, a.w); t.z = pk2(c.x, c.y); t.w = pk2(c.z, c.w);
        kf[ks] = __builtin_bit_cast(bf16x8, t);
      }
#pragma unroll
      for (int i = 0; i < 4; ++i) {
        const int key = i * 8 + (lane >> 3), dc = lane & 7;
        const float* vp = cv + (size_t)(kp0 + key) * 512 + dc * 8;
        float4 a = *(const float4*)vp, c = *(const float4*)(vp + 4);
        unsigned* dst = (unsigned*)(vl + key * VS + dc * 8);
        dst[0] = pk2(a.x, a.y); dst[1] = pk2(a.z, a.w); dst[2] = pk2(c.x, c.y); dst[3] = pk2(c.z, c.w);
      }
    }
    f32x16 st;
#pragma unroll
    for (int i = 0; i < 16; ++i) st[i] = 0.f;
#pragma unroll
    for (int ks = 0; ks < 4; ++ks) st = MFMA(kf[ks], qf[ks], st);
    const bool diag = (kb == nblk - 1);
    float z[16], lk[16], lat[16];
#pragma unroll
    for (int i = 0; i < 16; ++i) {
      z[i] = st[i] * 0.125f;
      const bool msk = (!diag) || (16 * h + i < r);
      const float e = __expf(-fabsf(z[i]));
      const float sp = fmaxf(z[i], 0.f) + __logf(1.f + e);
      lk[i] = msk ? -sp : 0.f;
    }
    float suf = 0.f;
#pragma unroll
    for (int i = 15; i >= 0; --i) { lat[i] = suf; suf += lk[i]; }
    const float other = __shfl_xor(suf, 32);
    const float base = run + (h == 0 ? other : 0.f);
    float a[16];
#pragma unroll
    for (int i = 0; i < 16; ++i) {
      const bool msk = (!diag) || (16 * h + i < r);
      a[i] = msk ? __expf(z[i] + lk[i] + base + lat[i]) : 0.f;
    }
    run += suf + other;
    __builtin_amdgcn_wave_barrier();
#pragma unroll
    for (int s2 = 0; s2 < 2; ++s2) {
      u32x4 t; t.x = pk2(a[8 * s2], a[8 * s2 + 1]); t.y = pk2(a[8 * s2 + 2], a[8 * s2 + 3]); t.z = pk2(a[8 * s2 + 4], a[8 * s2 + 5]); t.w = pk2(a[8 * s2 + 6], a[8 * s2 + 7]);
      const bf16x8 pf = __builtin_bit_cast(bf16x8, t);
#pragma unroll
      for (int dt = 0; dt < 2; ++dt) {
        const bf16_t* vp = vl + (16 * h + 8 * s2) * VS + 32 * dt + r;
        bf16x8 vf;
#pragma unroll
        for (int j = 0; j < 8; ++j) vf[j] = (short)vp[j * VS];
        o[dt] = MFMA(vf, pf, o[dt]);
      }
    }
    __builtin_amdgcn_wave_barrier();
    if (__all(run < -104.f)) break;
  }
  const int tok = tq0 + r;
#pragma unroll
  for (int dt = 0; dt < 2; ++dt)
#pragma unroll
    for (int g = 0; g < 4; ++g) {
      const int d0 = 32 * dt + 8 * g + 4 * h;
      u32x2 ga = *(const u32x2*)(p.P + (size_t)tok * D_IN + OFF_GA + hd * 64 + d0);
      u32x2 ov;
      ov.x = pk2(o[dt][4 * g] * siluf_(bflo(ga.x)), o[dt][4 * g + 1] * siluf_(bfhi(ga.x)));
      ov.y = pk2(o[dt][4 * g + 2] * siluf_(bflo(ga.y)), o[dt][4 * g + 3] * siluf_(bfhi(ga.y)));
      *(u32x2*)(p.mix + (size_t)tok * 1024 + hd * 64 + d0) = ov;
    }
}

constexpr int S5_BU = 8192;
constexpr int S5_LDS = S5_BU + 8704 + 1024;
DI void s5_disc(const Params& p, int lg, int pi, float dt, float& ar, float& ai, float& fr, float& fi) {
  const float lr = fminf(p.lam_re[lg * 64 + pi], -1e-4f), li = p.lam_im[lg * 64 + pi];
  const float er = expf(lr * dt);
  ar = er * cosf(li * dt); ai = er * sinf(li * dt);
  const float den = lr * lr + li * li;
  fr = ((ar - 1.f) * lr + ai * li) / den; fi = (ai * lr - (ar - 1.f) * li) / den;
}
DI void s5_item(const Params& p, int layer, int item, char* lds) {
  float* BU = (float*)lds;
  char* Himg = lds + S5_BU;
  bf16_t* Ub = (bf16_t*)(lds + S5_BU + 8704);
  const int lane = TID & 63, r = lane & 31, h = lane >> 5;
  const int seq = item >> 4, g = item & 15;
  const bool sample = seq >= 32;
  const int b = sample ? seq - 32 : seq, L = sample ? 32 : 2048, tok0 = sample ? NTOK_P + b * 32 : b * 2048;
  const int lg = layer * 16 + g;
  const float dt = expf(p.log_dt[lg]);
  float ar, ai, fr_, fi_;
  s5_disc(p, lg, lane, dt, ar, ai, fr_, fi_);
  bf16x8 bbf[4];
#pragma unroll
  for (int half = 0; half < 2; ++half) {
    const int pi = 32 * half + r;
    float a_r, a_i, f_r, f_i;
    s5_disc(p, lg, pi, dt, a_r, a_i, f_r, f_i);
    const float* brp = p.b_re + ((size_t)lg * 64 + pi) * 16 + 8 * h;
    const float* bip = p.b_im + ((size_t)lg * 64 + pi) * 16 + 8 * h;
    float re[8], im[8];
#pragma unroll
    for (int j = 0; j < 8; ++j) { const float br = brp[j], bi = bip[j]; re[j] = f_r * br - f_i * bi; im[j] = f_r * bi + f_i * br; }
    u32x4 t0, t1;
    t0.x = pk2(re[0], re[1]); t0.y = pk2(re[2], re[3]); t0.z = pk2(re[4], re[5]); t0.w = pk2(re[6], re[7]);
    t1.x = pk2(im[0], im[1]); t1.y = pk2(im[2], im[3]); t1.z = pk2(im[4], im[5]); t1.w = pk2(im[6], im[7]);
    bbf[half] = __builtin_bit_cast(bf16x8, t0);
    bbf[2 + half] = __builtin_bit_cast(bf16x8, t1);
  }
  bf16x8 cf[8];
#pragma unroll
  for (int s = 0; s < 8; ++s) {
    u32x4 t; t.x = 0; t.y = 0; t.z = 0; t.w = 0;
    if (r < 16) {
      const int k0 = 16 * s + 8 * h;
      const float* src = (s < 4 ? p.c_re : p.c_im) + ((size_t)lg * 16 + r) * 64 + (k0 & 63);
      const float sg = s < 4 ? 1.f : -1.f;
      const float4 c0 = *(const float4*)src, c1 = *(const float4*)(src + 4);
      t.x = pk2(sg * c0.x, sg * c0.y); t.y = pk2(sg * c0.z, sg * c0.w); t.z = pk2(sg * c1.x, sg * c1.y); t.w = pk2(sg * c1.z, sg * c1.w);
    }
    cf[s] = __builtin_bit_cast(bf16x8, t);
  }
  const float dl = p.ssm_d[lg * 16 + (r & 15)];
  float hr = 0.f, hi = 0.f;
  if (sample) { hr = p.st_re[((size_t)(layer * 16 + b) * 16 + g) * 64 + lane]; hi = p.st_im[((size_t)(layer * 16 + b) * 16 + g) * 64 + lane]; }
  f32x16 zero;
#pragma unroll
  for (int i = 0; i < 16; ++i) zero[i] = 0.f;
  const bf16_t* upb = p.P + (size_t)(tok0 + r) * D_IN + OFF_U + g * 16 + 8 * h;
  bf16x8 uf = *(const bf16x8*)upb;
  for (int t0 = 0; t0 < L; t0 += 32) {
    const bf16x8 ucur = uf;
    if (t0 + 32 < L) uf = *(const bf16x8*)(upb + (size_t)(t0 + 32) * D_IN);
    *(bf16x8*)(Ub + r * 16 + 8 * h) = ucur;
    f32x16 d[4];
#pragma unroll
    for (int tile = 0; tile < 4; ++tile) d[tile] = MFMA(ucur, bbf[tile], zero);
#pragma unroll
    for (int hf = 0; hf < 2; ++hf) {
#pragma unroll
      for (int tile = 0; tile < 4; ++tile)
#pragma unroll
        for (int i = 0; i < 8; ++i) BU[((i & 3) + 8 * (i >> 2) + 4 * h) * 128 + 32 * tile + r] = d[tile][8 * hf + i];
      __builtin_amdgcn_wave_barrier();
#pragma unroll
      for (int tt = 0; tt < 16; ++tt) {
        const int t = 16 * hf + tt;
        const float bur = BU[tt * 128 + lane], bui = BU[tt * 128 + 64 + lane];
        const float nhr = ar * hr - ai * hi + bur, nhi = ar * hi + ai * hr + bui;
        hr = nhr; hi = nhi;
        *(bf16_t*)(Himg + t * 272 + lane * 2) = (bf16_t)f2bf(hr);
        *(bf16_t*)(Himg + t * 272 + 128 + lane * 2) = (bf16_t)f2bf(hi);
      }
      __builtin_amdgcn_wave_barrier();
    }
    f32x16 yacc = zero;
#pragma unroll
    for (int s = 0; s < 8; ++s) {
      const bf16x8 af = *(const bf16x8*)(Himg + r * 272 + s * 32 + h * 16);
      yacc = MFMA(af, cf[s], yacc);
    }
    if (r < 16) {
#pragma unroll
      for (int i = 0; i < 16; ++i) {
        const int t = (i & 3) + 8 * (i >> 2) + 4 * h;
        const float yv = yacc[i] + dl * bf2f(Ub[t * 16 + r]);
        const float gl = yv / (1.f + __expf(-1.5957691216f * (yv + 0.044715f * yv * yv * yv)));
        p.yb[(size_t)(tok0 + t0 + t) * 256 + g * 16 + r] = (bf16_t)f2bf(gl);
      }
    }
    __builtin_amdgcn_wave_barrier();
  }
  float* ore = p.out + (sample ? O_SRES : O_SREP) + ((size_t)(layer * (sample ? 16 : 32) + b) * 16 + g) * 64 + lane;
  float* oim = p.out + (sample ? O_SIMS : O_SIMP) + ((size_t)(layer * (sample ? 16 : 32) + b) * 16 + g) * 64 + lane;
  *ore = hr; *oim = hi;
}

DI void rwkv_item(const Params& p, int layer, int item, char* smem) {
  float* R = (float*)smem; float* W = R + 2048; float* KT = W + 2048; float* KH = KT + 2048; float* BB = KH + 2048;
  float* V = BB + 2048; float* Y = V + 2048; float* DSUM = Y + 2048; float* ASUM = DSUM + 2048; float* BON = ASUM + 2048;
  bf16_t* LORAb = (bf16_t*)(BON + 32);
  const int tid = TID, lane = tid & 63, wv = tid >> 6;
  const int seq = item >> 2, hd = item & 3;
  const bool sample = seq >= 32;
  const int b = sample ? seq - 32 : seq, L = sample ? 32 : 2048, tok0 = sample ? NTOK_P + b * 32 : b * 2048;
  const int cg_ = hd * 64 + lane;
  bf16x8 lb[2];
  {
    const int ll = (wv >> 1) & 1, nn = wv & 1, r_ = lane & 31, h_ = lane >> 5;
    const float* srcw = (ll ? p.a2 : p.w2) + (size_t)layer * 32 * 256 + hd * 64 + 32 * nn + r_;
#pragma unroll
    for (int s = 0; s < 2; ++s) {
      float t[8];
#pragma unroll
      for (int j = 0; j < 8; ++j) t[j] = srcw[(size_t)(16 * s + 8 * h_ + j) * 256];
      u32x4 u; u.x = pk2(t[0], t[1]); u.y = pk2(t[2], t[3]); u.z = pk2(t[4], t[5]); u.w = pk2(t[6], t[7]);
      lb[s] = __builtin_bit_cast(bf16x8, u);
    }
  }
  const float w0c = p.w0[layer * 256 + cg_], a0c = p.a0[layer * 256 + cg_], kkc = p.k_k[layer * 256 + cg_], kac = p.k_a[layer * 256 + cg_];
  const float ubc = p.u_bonus[layer * 256 + cg_], lnw = p.ln_w[layer * 256 + cg_], lnb = p.ln_b[layer * 256 + cg_];
  const float* mu = p.mu + layer * 832;
  const float mu_r = mu[cg_], mu_k = mu[256 + cg_], mu_v = mu[512 + cg_], mu_l = mu[768 + lane];
  const float* shp = p.st_shift + (size_t)(layer * 16 + b) * 832;
  const int row = tid >> 3, kq = tid & 7;
  f32x2 S[4];
  if (sample) {
    const float* sp = p.st_wkv + (((size_t)(layer * 16 + b) * 4 + hd) * 64 + row) * 64 + kq * 8;
#pragma unroll
    for (int j = 0; j < 4; ++j) { S[j].x = sp[2 * j]; S[j].y = sp[2 * j + 1]; }
  } else {
#pragma unroll
    for (int j = 0; j < 4; ++j) { S[j].x = 0.f; S[j].y = 0.f; }
  }
  bf16_t cr[4], ck[4], cv[4], cl[4], qr[4], qk[4], qv[4], ql[4], cgt[4];
#pragma unroll
  for (int i = 0; i < 4; ++i) {
    const bf16_t* cp = p.P + (size_t)(tok0 + wv + 8 * i) * D_IN + OFF_C;
    const bf16_t* pp = cp - D_IN;
    cr[i] = cp[cg_]; ck[i] = cp[256 + cg_]; cv[i] = cp[512 + cg_]; cl[i] = cp[768 + lane]; cgt[i] = cp[OFF_GC - OFF_C + cg_];
    qr[i] = pp[cg_]; qk[i] = pp[256 + cg_]; qv[i] = pp[512 + cg_]; ql[i] = pp[768 + lane];
  }
  for (int c0 = 0; c0 < L; c0 += 32) {
    float xr[4], xk[4], xv[4], gt[4];
#pragma unroll
    for (int i = 0; i < 4; ++i) {
      const int tl = wv + 8 * i;
      const bool first = (c0 + tl == 0);
      float pr, pk, pv, pl;
      if (first) {
        if (sample) { pr = shp[cg_]; pk = shp[256 + cg_]; pv = shp[512 + cg_]; pl = shp[768 + lane]; }
        else { pr = 0.f; pk = 0.f; pv = 0.f; pl = 0.f; }
      } else { pr = bf2f(qr[i]); pk = bf2f(qk[i]); pv = bf2f(qv[i]); pl = bf2f(ql[i]); }
      const float c_r = bf2f(cr[i]), c_k = bf2f(ck[i]), c_v = bf2f(cv[i]), c_l = bf2f(cl[i]);
      gt[i] = bf2f(cgt[i]);
      xr[i] = c_r + mu_r * (pr - c_r); xk[i] = c_k + mu_k * (pk - c_k); xv[i] = c_v + mu_v * (pv - c_v);
      const float xl = c_l + mu_l * (pl - c_l);
      LORAb[tl * 72 + lane] = (bf16_t)f2bf(lane < 32 ? fast_tanh(xl) : xl);
    }
    lds_barrier();
    if (c0 + 32 < L) {
#pragma unroll
      for (int i = 0; i < 4; ++i) {
        const bf16_t* cp = p.P + (size_t)(tok0 + c0 + 32 + wv + 8 * i) * D_IN + OFF_C;
        const bf16_t* pp = cp - D_IN;
        cr[i] = cp[cg_]; ck[i] = cp[256 + cg_]; cv[i] = cp[512 + cg_]; cl[i] = cp[768 + lane]; cgt[i] = cp[OFF_GC - OFF_C + cg_];
        qr[i] = pp[cg_]; qk[i] = pp[256 + cg_]; qv[i] = pp[512 + cg_]; ql[i] = pp[768 + lane];
      }
    }
    if (wv < 4) {
      const int r_ = lane & 31, h_ = lane >> 5, ll = wv >> 1, nn = wv & 1;
      f32x16 dacc;
#pragma unroll
      for (int i = 0; i < 16; ++i) dacc[i] = 0.f;
#pragma unroll
      for (int s = 0; s < 2; ++s) {
        const bf16x8 af = *(const bf16x8*)((const char*)LORAb + r_ * 144 + ll * 64 + s * 32 + h_ * 16);
        dacc = MFMA(af, lb[s], dacc);
      }
      float* dst = (ll ? ASUM : DSUM) + 32 * nn + r_;
#pragma unroll
      for (int i = 0; i < 16; ++i) dst[((i & 3) + 8 * (i >> 2) + 4 * h_) * 64] = dacc[i];
    }
    lds_barrier();
#pragma unroll
    for (int i = 0; i < 4; ++i) {
      const int tl = wv + 8 * i;
      const float dsum = w0c + DSUM[tl * 64 + lane], asum = a0c + ASUM[tl * 64 + lane];
      const float dec = __expf(-0.6065306597f * sigmoidf_(dsum));
      const float a = sigmoidf_(asum);
      const float kk = xk[i] * kkc;
      const float ss = wave_sum(kk * kk);
      const float kh = kk * rsqrtf(ss + 1e-12f);
      const float kt = xk[i] * (1.f + (a - 1.f) * kac);
      const float bon = wave_sum(xr[i] * kt * ubc);
      R[tl * 64 + lane] = xr[i]; W[tl * 64 + lane] = dec; KT[tl * 64 + lane] = kt; KH[tl * 64 + lane] = kh; BB[tl * 64 + lane] = a * kh; V[tl * 64 + lane] = xv[i];
      if (lane == 0) BON[tl] = bon;
    }
    lds_barrier();
    float ykeep[4];
    float4 nkh0, nkh1, nw0, nw1, nb0, nb1, nk0, nk1, nr0, nr1; float nvv;
    {
      const int o = kq * 8;
      nkh0 = *(const float4*)(KH + o); nkh1 = *(const float4*)(KH + o + 4); nw0 = *(const float4*)(W + o); nw1 = *(const float4*)(W + o + 4);
      nb0 = *(const float4*)(BB + o); nb1 = *(const float4*)(BB + o + 4); nk0 = *(const float4*)(KT + o); nk1 = *(const float4*)(KT + o + 4);
      nr0 = *(const float4*)(R + o); nr1 = *(const float4*)(R + o + 4); nvv = V[row];
    }
#pragma unroll
    for (int q = 0; q < 4; ++q) {
      ykeep[q] = 0.f;
#pragma unroll
      for (int e = 0; e < 8; ++e) {
        const int tl = q * 8 + e;
        const float4 kh0 = nkh0, kh1 = nkh1, w0_ = nw0, w1_ = nw1, b0 = nb0, b1 = nb1, k0 = nk0, k1 = nk1, r0 = nr0, r1 = nr1;
        const float vv = nvv;
        if (tl < 31) {
          const int o = (tl + 1) * 64 + kq * 8;
          nkh0 = *(const float4*)(KH + o); nkh1 = *(const float4*)(KH + o + 4); nw0 = *(const float4*)(W + o); nw1 = *(const float4*)(W + o + 4);
          nb0 = *(const float4*)(BB + o); nb1 = *(const float4*)(BB + o + 4); nk0 = *(const float4*)(KT + o); nk1 = *(const float4*)(KT + o + 4);
          nr0 = *(const float4*)(R + o); nr1 = *(const float4*)(R + o + 4); nvv = V[(tl + 1) * 64 + row];
        }
        const f32x2 khv[4] = {{kh0.x, kh0.y}, {kh0.z, kh0.w}, {kh1.x, kh1.y}, {kh1.z, kh1.w}};
        const f32x2 wvv[4] = {{w0_.x, w0_.y}, {w0_.z, w0_.w}, {w1_.x, w1_.y}, {w1_.z, w1_.w}};
        const f32x2 bv[4] = {{b0.x, b0.y}, {b0.z, b0.w}, {b1.x, b1.y}, {b1.z, b1.w}};
        const f32x2 kv[4] = {{k0.x, k0.y}, {k0.z, k0.w}, {k1.x, k1.y}, {k1.z, k1.w}};
        const f32x2 rv[4] = {{r0.x, r0.y}, {r0.z, r0.w}, {r1.x, r1.y}, {r1.z, r1.w}};
        const f32x2 vv2 = {vv, vv};
        f32x2 m[4];
#pragma unroll
        for (int j = 0; j < 4; ++j) m[j] = fma2(S[j], wvv[j], vv2 * kv[j]);
        f32x2 sa2 = fma2(S[1], khv[1], S[0] * khv[0]), sb2 = fma2(S[3], khv[3], S[2] * khv[2]);
        sa2 += sb2;
        const float sa = sum8(sa2.x + sa2.y);
        const f32x2 nsa = {-sa, -sa};
#pragma unroll
        for (int j = 0; j < 4; ++j) S[j] = fma2(nsa, bv[j], m[j]);
        f32x2 y2 = fma2(S[1], rv[1], S[0] * rv[0]), y3 = fma2(S[3], rv[3], S[2] * rv[2]);
        y2 += y3;
        const float yv = sum8(y2.x + y2.y);
        ykeep[q] = (e == kq) ? yv : ykeep[q];
      }
    }
#pragma unroll
    for (int q = 0; q < 4; ++q) Y[(q * 8 + kq) * 64 + row] = ykeep[q];
    lds_barrier();
#pragma unroll
    for (int i = 0; i < 4; ++i) {
      const int tl = wv + 8 * i;
      const int tok = tok0 + c0 + tl;
      const float y = Y[tl * 64 + lane];
      const float mean = wave_sum(y) * (1.f / 64.f);
      const float msq = wave_sum(y * y) * (1.f / 64.f);
      const float d = y - mean;
      const float var = fmaxf(msq - mean * mean, 0.f);
      float yn = d * rsqrtf(var + 64e-5f) * lnw + lnb;
      yn += BON[tl] * V[tl * 64 + lane];
      p.mix[(size_t)tok * 1024 + 768 + cg_] = (bf16_t)f2bf(yn * siluf_(gt[i]));
    }
  }
  lds_barrier();
  float* so = p.out + (sample ? O_WKVS : O_WKVP) + (((size_t)(layer * (sample ? 16 : 32) + b) * 4 + hd) * 64 + row) * 64 + kq * 8;
  *(float4*)so = make_float4(S[0].x, S[0].y, S[1].x, S[1].y);
  *(float4*)(so + 4) = make_float4(S[2].x, S[2].y, S[3].x, S[3].y);
}

constexpr int ATT_LDS0 = 6 * S5_LDS;
DI void phase_mixers(const Params& p, int layer, char* smem, int cofs) {
  const int G = GDIM, bid = BID, half = G / 2;
  const int tid = TID, wv = tid >> 6, lane = tid & 63;
  if (bid < half) {
    for (int item = bid; item < 128; item += half) rwkv_item(p, layer, item, smem);
  } else {
    const int j = bid - half, nb2 = G - half;
    for (int item = 128 + j; item < 192; item += nb2) rwkv_item(p, layer, item, smem);
    if (wv < 6) { for (int it = j * 6 + wv; it < 768; it += nb2 * 6) s5_item(p, layer, it, smem + wv * S5_LDS); }
  }
  unsigned* ctr = p.counters + layer + cofs;
  bf16_t* vl = (bf16_t*)(smem + ATT_LDS0) + wv * (32 * VS);
  while (true) {
    int it = 0;
    if (lane == 0) it = (int)atomicAdd(ctr, 1u);
    it = __builtin_amdgcn_readfirstlane(it);
    if (it >= 16512) break;
    attn_item(p, layer, it, vl);
  }
}

__global__ void __launch_bounds__(NT) mega(Params p) {
  __shared__ __attribute__((aligned(16))) char smem[SMEM_BYTES];
  cg::grid_group grid = cg::this_grid();
  phase_weights(p, smem);
  phase_norm(p, 0);
  grid.sync();
  for (int layer = 0; layer < 2; ++layer) {
    gemm_phase<0>(p, layer, smem);
    grid.sync();
#if PROBE_GEMM0
    gemm_phase<0>(p, layer, smem);
    grid.sync();
#endif
    phase_mixers(p, layer, smem, 0);
    grid.sync();
#if PROBE_MIX
    phase_mixers(p, layer, smem, 2);
    grid.sync();
#endif
    gemm_phase<1>(p, layer, smem);
    grid.sync();
    gemm_phase<2>(p, layer, smem);
    if (layer == 0) grid.sync();
  }
}

#if MULTI_LAUNCH
template <int PH>
__global__ void __launch_bounds__(NT) phase_kernel(Params p, int layer) {
  __shared__ __attribute__((aligned(16))) char smem[SMEM_BYTES];
  if (PH == 0) { phase_weights(p, smem); }
  else if (PH == 1) phase_norm(p, layer);
  else if (PH == 2) gemm_phase<0>(p, layer, smem);
  else if (PH == 3) phase_mixers(p, layer, smem, 0);
  else if (PH == 4) gemm_phase<1>(p, layer, smem);
  else gemm_phase<2>(p, layer, smem);
}
#endif

extern "C" void kernel_launch(void* const* d_in, const int* in_sizes, int n_in, void* d_out, int out_size, void* d_ws, size_t ws_size, hipStream_t stream) {
  Params p{};
  const float** f = (const float**)&p;
  for (int i = 0; i < 33; ++i) f[i] = (const float*)d_in[i];
  p.out = (float*)d_out;
  char* ws = (char*)d_ws;
  size_t off = 0;
  auto take = [&](size_t bytes) { char* q = ws + off; off += (bytes + 255) & ~(size_t)255; return q; };
  p.WinT = (bf16_t*)take((size_t)2 * 3648 * 1024 * 2);
  p.WoutT = (bf16_t*)take((size_t)2 * 1024 * 1024 * 2);
  p.WgluT = (bf16_t*)take((size_t)2 * 512 * 256 * 2);
  p.hbf = (bf16_t*)take((size_t)NTOK * 1024 * 2);
  p.P = (bf16_t*)take((size_t)NTOK * D_IN * 2);
  p.mix = (bf16_t*)take((size_t)NTOK * 1024 * 2);
  p.yb = (bf16_t*)take((size_t)NTOK * 256 * 2);
  p.counters = (unsigned*)take(256);
  p.ssq = (float*)take((size_t)NTOK * 4);
  if (off > ws_size || (size_t)out_size != O_END || n_in != 33) fprintf(stderr, "kernel_launch: unexpected sizes ws=%zu need=%zu out=%d n_in=%d\n", ws_size, off, out_size, n_in);
#if MULTI_LAUNCH
  const int G = 256;
  phase_kernel<0><<<G, NT, 0, stream>>>(p, 0);
  for (int layer = 0; layer < 2; ++layer) {
    phase_kernel<1><<<G, NT, 0, stream>>>(p, layer);
    phase_kernel<2><<<G, NT, 0, stream>>>(p, layer);
    phase_kernel<3><<<G, NT, 0, stream>>>(p, layer);
    phase_kernel<4><<<G, NT, 0, stream>>>(p, layer);
    phase_kernel<5><<<G, NT, 0, stream>>>(p, layer);
  }
#else
  static int grid_blocks = 0;
  if (!grid_blocks) {
    int dev = 0, cus = 0, per_cu = 0;
    hipGetDevice(&dev);
    hipDeviceGetAttribute(&cus, hipDeviceAttributeMultiprocessorCount, dev);
    hipOccupancyMaxActiveBlocksPerMultiprocessor(&per_cu, mega, NT, 0);
    if (per_cu < 1) per_cu = 1;
    grid_blocks = cus * per_cu;
  }
  void* args[] = {&p};
  hipError_t e = hipLaunchCooperativeKernel((void*)mega, dim3(grid_blocks), dim3(NT), args, 0, stream);
  if (e != hipSuccess) fprintf(stderr, "cooperative launch failed: %s (grid %d)\n", hipGetErrorString(e), grid_blocks);
#endif
}
```

```cpp
#include <hip/hip_runtime.h>
#include <hip/hip_cooperative_groups.h>
#include <cstdio>
namespace cg = cooperative_groups;

#define PROBE_GEMM0 0
#define PROBE_MIX 0
#ifndef MULTI_LAUNCH
#define MULTI_LAUNCH 0
#endif

#define DI __device__ __forceinline__
typedef unsigned short bf16_t;
typedef short bf16x8 __attribute__((ext_vector_type(8)));
typedef float f32x16 __attribute__((ext_vector_type(16)));
typedef unsigned u32x4 __attribute__((ext_vector_type(4)));
typedef unsigned u32x2 __attribute__((ext_vector_type(2)));
#define MFMA(a, b, c) __builtin_amdgcn_mfma_f32_32x32x16_bf16((a), (b), (c), 0, 0, 0)

constexpr int NT = 512;
constexpr int NTOK_P = 65536, NTOK = 66048, D_IN = 3648;
constexpr int OFF_Q = 0, OFF_K = 512, OFF_V = 1024, OFF_GA = 1536, OFF_U = 2048, OFF_GB = 2304, OFF_C = 2560, OFF_GC = 3392;
constexpr size_t O_Y = 0, O_KP = 67633152, O_VP = 134742016, O_SREP = 201850880, O_SIMP = 201916416, O_WKVP = 201981952,
                 O_SHP = 203030528, O_KS = 203083776, O_VS = 203608064, O_SRES = 204132352, O_SIMS = 204165120,
                 O_WKVS = 204197888, O_SHS = 204722176, O_END = 204748800;
constexpr int SMEM_BYTES = 2 * 55296 + 8 * 4608;
constexpr int LDS_ROW = 144;
constexpr int STAGE = (256 + 128) * LDS_ROW;

struct Params {
  const float *x_prompt, *x_sample, *cache_k, *cache_v, *st_re, *st_im, *st_wkv, *st_shift;
  const float *norm_w, *w_in, *q_norm_w, *k_norm_w, *lam_re, *lam_im, *log_dt, *b_re, *b_im, *c_re, *c_im, *ssm_d, *w_glu, *b_glu;
  const float *mu, *w0, *w2, *a0, *a2, *k_k, *k_a, *u_bonus, *ln_w, *ln_b, *w_out;
  float* out;
  bf16_t *WinT, *WoutT, *WgluT, *hbf, *P, *mix, *yb;
  unsigned* counters;
  float* ssq;
};

DI int opq_v(int x) { asm volatile("" : "+v"(x)); return x; }
DI int opq_s(int x) { asm volatile("" : "+s"(x)); return x; }
#define TID opq_v((int)threadIdx.x)
#define BID opq_s((int)blockIdx.x)
#define GDIM opq_s((int)gridDim.x)
DI unsigned f2bf(float x) { unsigned u = __float_as_uint(x); u += 0x7fffu + ((u >> 16) & 1u); return u >> 16; }
DI unsigned pk2(float a, float b) { return f2bf(a) | (f2bf(b) << 16); }
DI float bf2f(unsigned v) { return __uint_as_float(v << 16); }
DI float bflo(unsigned w) { return __uint_as_float(w << 16); }
DI float bfhi(unsigned w) { return __uint_as_float(w & 0xffff0000u); }
DI float sigmoidf_(float x) { return 1.f / (1.f + __expf(-x)); }
DI float siluf_(float x) { return x / (1.f + __expf(-x)); }
typedef float f32x2 __attribute__((ext_vector_type(2)));
DI f32x2 fma2(f32x2 a, f32x2 b, f32x2 c) { return __builtin_elementwise_fma(a, b, c); }
template <int CTRL> DI float dpp_mov(float x) { return __int_as_float(__builtin_amdgcn_update_dpp(0, __float_as_int(x), CTRL, 0xF, 0xF, true)); }
DI float sum8(float x) { x += dpp_mov<0xB1>(x); x += dpp_mov<0x4E>(x); x += dpp_mov<0x141>(x); return x; }
DI float fast_tanh(float x) { return 1.f - 2.f / (1.f + __expf(2.f * x)); }
DI void lds_barrier() { asm volatile("s_waitcnt lgkmcnt(0)\n\ts_barrier" ::: "memory"); }
DI float wave_sum(float v) {
  v += dpp_mov<0xB1>(v); v += dpp_mov<0x4E>(v); v += dpp_mov<0x141>(v); v += dpp_mov<0x140>(v);
  v += __int_as_float(__builtin_amdgcn_update_dpp(0, __float_as_int(v), 0x142, 0xA, 0xF, false));
  v += __int_as_float(__builtin_amdgcn_update_dpp(0, __float_as_int(v), 0x143, 0xC, 0xF, false));
  return __int_as_float(__builtin_amdgcn_readlane(__float_as_int(v), 63));
}
DI const float* xrow(const Params& p, int layer, int row) {
  if (layer == 0) return row < NTOK_P ? p.x_prompt + (size_t)row * 1024 : p.x_sample + (size_t)(row - NTOK_P) * 1024;
  return p.out + (size_t)row * 1024;
}

DI void transpose_tile(const float* __restrict__ src, int K, int N, bf16_t* __restrict__ dst, int k0, int n0, float* tile) {
  const int tid = TID;
#pragma unroll
  for (int i = 0; i < 8; ++i) { int idx = tid + NT * i; int kk = idx >> 6, nn = idx & 63; tile[kk * 65 + nn] = src[(size_t)(k0 + kk) * N + n0 + nn]; }
  __syncthreads();
#pragma unroll
  for (int i = 0; i < 8; ++i) { int idx = tid + NT * i; int nn = idx >> 6, kk = idx & 63; dst[(size_t)(n0 + nn) * K + k0 + kk] = (bf16_t)f2bf(tile[kk * 65 + nn]); }
  __syncthreads();
}
DI void phase_weights(const Params& p, char* smem) {
  float* tile = (float*)smem;
  const int bid = BID, gdim = GDIM;
  for (int t = bid; t < 2400; t += gdim) {
    int layer = t / 1200, j = t % 1200;
    if (j < 912) { int kt = j / 57, nt = j % 57; transpose_tile(p.w_in + (size_t)layer * 1024 * 3648, 1024, 3648, p.WinT + (size_t)layer * 3648 * 1024, kt * 64, nt * 64, tile); }
    else if (j < 1168) { j -= 912; int kt = j / 16, nt = j % 16; transpose_tile(p.w_out + (size_t)layer * 1024 * 1024, 1024, 1024, p.WoutT + (size_t)layer * 1024 * 1024, kt * 64, nt * 64, tile); }
    else { j -= 1168; int kt = j / 8, nt = j % 8; transpose_tile(p.w_glu + (size_t)layer * 256 * 512, 256, 512, p.WgluT + (size_t)layer * 512 * 256, kt * 64, nt * 64, tile); }
  }
  { const int tid = TID; if (bid == 0 && tid < 64) p.counters[tid] = 0;
    for (int i = bid * NT + tid; i < NTOK; i += gdim * NT) p.ssq[i] = 0.f; }
}

DI void phase_norm(const Params& p, int layer) {
  const int tid = TID, lane = tid & 63, w = tid >> 6;
  const int bid = BID, gdim = GDIM;
  const float* nw = p.norm_w + layer * 1024;
  const int stride = gdim * 8;
  for (int row0 = bid * 8 + w; row0 < NTOK; row0 += 2 * stride) {
    const int row1 = row0 + stride;
    const bool has1 = row1 < NTOK;
    const float* x0 = xrow(p, layer, row0);
    const float* x1 = xrow(p, layer, has1 ? row1 : row0);
    float4 v0[4], v1[4]; float s0 = 0.f, s1 = 0.f;
#pragma unroll
    for (int i = 0; i < 4; ++i) { v0[i] = *(const float4*)(x0 + i * 256 + lane * 4); v1[i] = *(const float4*)(x1 + i * 256 + lane * 4); }
#pragma unroll
    for (int i = 0; i < 4; ++i) {
      s0 += v0[i].x * v0[i].x + v0[i].y * v0[i].y + v0[i].z * v0[i].z + v0[i].w * v0[i].w;
      s1 += v1[i].x * v1[i].x + v1[i].y * v1[i].y + v1[i].z * v1[i].z + v1[i].w * v1[i].w;
    }
    s0 = wave_sum(s0); s1 = wave_sum(s1);
    const float c0 = rsqrtf(s0 * (1.f / 1024.f) + 1e-6f), c1 = rsqrtf(s1 * (1.f / 1024.f) + 1e-6f);
#pragma unroll
    for (int i = 0; i < 4; ++i) {
      float4 wv = *(const float4*)(nw + i * 256 + lane * 4);
      u32x2 o; o.x = pk2(v0[i].x * c0 * wv.x, v0[i].y * c0 * wv.y); o.y = pk2(v0[i].z * c0 * wv.z, v0[i].w * c0 * wv.w);
      *(u32x2*)(p.hbf + (size_t)row0 * 1024 + i * 256 + lane * 4) = o;
      if (has1) {
        u32x2 o1; o1.x = pk2(v1[i].x * c1 * wv.x, v1[i].y * c1 * wv.y); o1.y = pk2(v1[i].z * c1 * wv.z, v1[i].w * c1 * wv.w);
        *(u32x2*)(p.hbf + (size_t)row1 * 1024 + i * 256 + lane * 4) = o1;
      }
    }
  }
}

template <int MODE>
DI void gemm_phase(const Params& p, int layer, char* smem) {
  constexpr int K = (MODE == 1) ? 256 : 1024;
  constexpr int NTN = (MODE == 0) ? 29 : (MODE == 1 ? 4 : 8);
  constexpr int KT = K / 64;
  const bf16_t* __restrict__ A = MODE == 0 ? p.hbf : (MODE == 1 ? p.yb : p.mix);
  const bf16_t* __restrict__ Bt = MODE == 0 ? p.WinT + (size_t)layer * 3648 * 1024 : (MODE == 1 ? p.WgluT + (size_t)layer * 512 * 256 : p.WoutT + (size_t)layer * 1024 * 1024);
  const int tid = TID, lane = tid & 63, wv = tid >> 6, r = lane & 31, h = lane >> 5;
  const int wm = wv >> 1, wn = wv & 1;
  const int bid = BID, gdim = GDIM;
  const int xcd = bid & 7, jb = bid >> 3, nbx = (gdim - xcd + 7) >> 3;

  const int total_x = ((258 - xcd + 7) >> 3) * NTN;
  const int nmine = jb < total_x ? (total_x - jb + nbx - 1) / nbx : 0;
  if (nmine == 0) return;
  const int lrow = tid >> 3, kc = tid & 7;
  auto set_ptrs = [&](int idx, const bf16_t* (&ap)[4], const bf16_t* (&bp)[2]) {
    const int tmi_ = idx / NTN, tn_ = idx % NTN, m0_ = (xcd + 8 * tmi_) * 256, n0_ = tn_ * 128;
#pragma unroll
    for (int i = 0; i < 4; ++i) ap[i] = A + (size_t)(m0_ + lrow + 64 * i) * K + kc * 8;
#pragma unroll
    for (int i = 0; i < 2; ++i) {
      int row = lrow + 64 * i, brow;
      if (MODE == 0) { brow = n0_ + row; brow = brow < 3648 ? brow : 3647; }
      else if (MODE == 2) brow = n0_ + row;
      else { int wn_ = row >> 6, nt_ = (row >> 5) & 1, c_ = row & 31; brow = nt_ * 256 + tn_ * 64 + wn_ * 32 + c_; }
      bp[i] = Bt + (size_t)brow * K + kc * 8;
    }
  };
  f32x16 acc[2][2];
  auto zero_acc = [&]() {
#pragma unroll
    for (int a = 0; a < 2; ++a)
#pragma unroll
      for (int b = 0; b < 2; ++b)
#pragma unroll
        for (int i = 0; i < 16; ++i) acc[a][b][i] = 0.f;
  };
  auto compute = [&](const char* buf, char* nbuf, const u32x4 (&pa)[4], const u32x4 (&pb)[2]) {
    const char* As = buf; const char* Bs = buf + 256 * LDS_ROW;
    char* An = nbuf; char* Bn = nbuf + 256 * LDS_ROW;
#pragma unroll
    for (int s = 0; s < 4; ++s) {
      bf16x8 af[2], bfr[2];
#pragma unroll
      for (int mt = 0; mt < 2; ++mt) af[mt] = *(const bf16x8*)(As + (wm * 64 + mt * 32 + r) * LDS_ROW + s * 32 + h * 16);
#pragma unroll
      for (int nt = 0; nt < 2; ++nt) bfr[nt] = *(const bf16x8*)(Bs + (wn * 64 + nt * 32 + r) * LDS_ROW + s * 32 + h * 16);
#pragma unroll
      for (int mt = 0; mt < 2; ++mt)
#pragma unroll
        for (int nt = 0; nt < 2; ++nt) acc[mt][nt] = MFMA(bfr[nt], af[mt], acc[mt][nt]);
      if (s < 2) {
        *(u32x4*)(An + (lrow + 64 * (2 * s)) * LDS_ROW + kc * 16) = pa[2 * s];
        *(u32x4*)(An + (lrow + 64 * (2 * s + 1)) * LDS_ROW + kc * 16) = pa[2 * s + 1];
      } else {
        *(u32x4*)(Bn + (lrow + 64 * (s - 2)) * LDS_ROW + kc * 16) = pb[s - 2];
      }
    }
  };
  u32x4 sa[4][4], sb[4][2];
  const bf16_t* cap[4]; const bf16_t* cbp[2]; const bf16_t* nap[4]; const bf16_t* nbp[2];
  set_ptrs(jb, cap, cbp);
#pragma unroll
  for (int j = 0; j < 4; ++j) {
#pragma unroll
    for (int i = 0; i < 4; ++i) sa[j][i] = *(const u32x4*)(cap[i] + j * 64);
#pragma unroll
    for (int i = 0; i < 2; ++i) sb[j][i] = *(const u32x4*)(cbp[i] + j * 64);
  }
  {
    char* As = smem; char* Bs = smem + 256 * LDS_ROW;
#pragma unroll
    for (int i = 0; i < 4; ++i) *(u32x4*)(As + (lrow + 64 * i) * LDS_ROW + kc * 16) = sa[0][i];
#pragma unroll
    for (int i = 0; i < 2; ++i) *(u32x4*)(Bs + (lrow + 64 * i) * LDS_ROW + kc * 16) = sb[0][i];
  }
  lds_barrier();
  zero_acc();
  int c_idx = jb;
  for (int ti = 0; ti < nmine; ++ti) {
    set_ptrs(ti + 1 < nmine ? c_idx + nbx : c_idx, nap, nbp);
    for (int q = 0; q < KT / 4; ++q) {
      const bool lastq = (q == KT / 4 - 1);
      const int koff = lastq ? 0 : (4 * (q + 1)) * 64;
      const bf16_t* lap[4]; const bf16_t* lbp[2];
#pragma unroll
      for (int i = 0; i < 4; ++i) lap[i] = (lastq ? nap[i] : cap[i]) + koff;
#pragma unroll
      for (int i = 0; i < 2; ++i) lbp[i] = (lastq ? nbp[i] : cbp[i]) + koff;
#pragma unroll
      for (int j = 0; j < 4; ++j) {
#pragma unroll
        for (int i = 0; i < 4; ++i) sa[j][i] = *(const u32x4*)(lap[i] + j * 64);
#pragma unroll
        for (int i = 0; i < 2; ++i) sb[j][i] = *(const u32x4*)(lbp[i] + j * 64);
        compute(smem + (j & 1) * STAGE, smem + ((j + 1) & 1) * STAGE, sa[(j + 1) & 3], sb[(j + 1) & 3]);
        lds_barrier();
      }
    }
#pragma unroll
    for (int i = 0; i < 4; ++i) cap[i] = nap[i];
#pragma unroll
    for (int i = 0; i < 2; ++i) cbp[i] = nbp[i];
    const int idx = c_idx; c_idx += nbx;
    const int tmi = idx / NTN, tn = idx % NTN, tm = xcd + 8 * tmi;
    const int m0 = tm * 256, n0 = tn * 128;
    char* eps = smem + 2 * STAGE + wv * 4608;
    if (MODE == 0) {
      const int nb = n0 + wn * 64;
      if (nb < 3648) {
        if (layer == 1) {
#pragma unroll
          for (int mt = 0; mt < 2; ++mt) {
            const float rs = rsqrtf(p.ssq[m0 + wm * 64 + mt * 32 + r] * (1.f / 1024.f) + 1e-6f);
#pragma unroll
            for (int nt = 0; nt < 2; ++nt)
#pragma unroll
              for (int i = 0; i < 16; ++i) acc[mt][nt][i] *= rs;
          }
        }
        float scale[2] = {1.f, 1.f};
        if (nb < 1024) {
#pragma unroll
          for (int mt = 0; mt < 2; ++mt) {
            float ss = 0.f;
#pragma unroll
            for (int nt = 0; nt < 2; ++nt)
#pragma unroll
              for (int i = 0; i < 16; ++i) ss += acc[mt][nt][i] * acc[mt][nt][i];
            ss += __shfl_xor(ss, 32);
            scale[mt] = rsqrtf(ss * (1.f / 64.f) + 1e-6f);
          }
        }
        const float* nw = (nb < 512 ? p.q_norm_w : p.k_norm_w) + layer * 64;
#pragma unroll
        for (int mt = 0; mt < 2; ++mt) {
          const int mb = m0 + wm * 64 + mt * 32;
          const int m = mb + r;
          const bool is_p = m < NTOK_P;
#pragma unroll
          for (int nt = 0; nt < 2; ++nt) {
#pragma unroll
            for (int g = 0; g < 4; ++g) {
              const int ncol = nb + nt * 32 + 8 * g + 4 * h;
              float v0 = acc[mt][nt][4 * g], v1 = acc[mt][nt][4 * g + 1], v2 = acc[mt][nt][4 * g + 2], v3 = acc[mt][nt][4 * g + 3];
              if (nb < 1024) {
                float4 w4 = *(const float4*)(nw + (ncol - nb));
                v0 *= scale[mt] * w4.x; v1 *= scale[mt] * w4.y; v2 *= scale[mt] * w4.z; v3 *= scale[mt] * w4.w;
              }
              *(float4*)(eps + r * 144 + (8 * g + 4 * h) * 4) = make_float4(v0, v1, v2, v3);
              if (nb >= OFF_C && nb < OFF_GC) {
                const bool last = is_p ? ((m & 2047) == 2047) : (((m - NTOK_P) & 31) == 31);
                if (last) {
                  float* dst = p.out + (is_p ? O_SHP + ((size_t)layer * 32 + (m >> 11)) * 832 : O_SHS + ((size_t)layer * 16 + ((m - NTOK_P) >> 5)) * 832) + (ncol - OFF_C);
                  *(float4*)dst = make_float4(v0, v1, v2, v3);
                }
              }
            }
            __builtin_amdgcn_wave_barrier();
#pragma unroll
            for (int it = 0; it < 2; ++it) {
              const int row = (lane >> 2) + 16 * it, ch = lane & 3;
              const float4 a = *(const float4*)(eps + row * 144 + ch * 32), c = *(const float4*)(eps + row * 144 + ch * 32 + 16);
              u32x4 o; o.x = pk2(a.x, a.y); o.y = pk2(a.z, a.w); o.z = pk2(c.x, c.y); o.w = pk2(c.z, c.w);
              *(u32x4*)(p.P + (size_t)(mb + row) * D_IN + nb + nt * 32 + ch * 8) = o;
            }
            if (nb >= 512 && nb < 1536) {
#pragma unroll
              for (int it = 0; it < 4; ++it) {
                const int row = it * 8 + (lane >> 3), ch = lane & 7;
                const float4 a = *(const float4*)(eps + row * 144 + ch * 16);
                const int mm = mb + row;
                const bool pp = mm < NTOK_P;
                float* dst;
                if (nb < 1024) dst = p.out + (pp ? O_KP + ((size_t)layer * 65536 + mm) * 512 : O_KS + ((size_t)layer * 512 + (mm - NTOK_P)) * 512) + (nb - 512);
                else dst = p.out + (pp ? O_VP + ((size_t)layer * 65536 + mm) * 512 : O_VS + ((size_t)layer * 512 + (mm - NTOK_P)) * 512) + (nb - 1024);
                *(float4*)(dst + nt * 32 + ch * 4) = a;
              }
            }
            __builtin_amdgcn_wave_barrier();
          }
        }
      }
    } else if (MODE == 1) {
      const float* bg = p.b_glu + layer * 512;
#pragma unroll
      for (int mt = 0; mt < 2; ++mt) {
        const int m = m0 + wm * 64 + mt * 32 + r;
#pragma unroll
        for (int g = 0; g < 4; ++g) {
          const int col = tn * 64 + wn * 32 + 8 * g + 4 * h;
          float4 bv = *(const float4*)(bg + col), bgt = *(const float4*)(bg + 256 + col);
          u32x2 gb = *(const u32x2*)(p.P + (size_t)m * D_IN + OFF_GB + col);
          float o0 = (acc[mt][0][4 * g] + bv.x) * sigmoidf_(acc[mt][1][4 * g] + bgt.x) * siluf_(bflo(gb.x));
          float o1 = (acc[mt][0][4 * g + 1] + bv.y) * sigmoidf_(acc[mt][1][4 * g + 1] + bgt.y) * siluf_(bfhi(gb.x));
          float o2 = (acc[mt][0][4 * g + 2] + bv.z) * sigmoidf_(acc[mt][1][4 * g + 2] + bgt.z) * siluf_(bflo(gb.y));
          float o3 = (acc[mt][0][4 * g + 3] + bv.w) * sigmoidf_(acc[mt][1][4 * g + 3] + bgt.w) * siluf_(bfhi(gb.y));
          u32x2 o; o.x = pk2(o0, o1); o.y = pk2(o2, o3);
          *(u32x2*)(p.mix + (size_t)m * 1024 + 512 + col) = o;
        }
      }
    } else {
      const float* nw1 = p.norm_w + 1024;
#pragma unroll
      for (int mt = 0; mt < 2; ++mt) {
        const int mb = m0 + wm * 64 + mt * 32;
        float sq[4] = {0.f, 0.f, 0.f, 0.f};
#pragma unroll
        for (int nt = 0; nt < 2; ++nt) {
#pragma unroll
          for (int g = 0; g < 4; ++g)
            *(float4*)(eps + r * 144 + (8 * g + 4 * h) * 4) = make_float4(acc[mt][nt][4 * g], acc[mt][nt][4 * g + 1], acc[mt][nt][4 * g + 2], acc[mt][nt][4 * g + 3]);
          __builtin_amdgcn_wave_barrier();
#pragma unroll
          for (int it = 0; it < 4; ++it) {
            const int row = it * 8 + (lane >> 3), ch = lane & 7;
            const float4 a = *(const float4*)(eps + row * 144 + ch * 16);
            const int mm = mb + row, ncol = n0 + wn * 64 + nt * 32 + ch * 4;
            float4 xv = *(const float4*)(xrow(p, layer, mm) + ncol);
            xv.x += a.x; xv.y += a.y; xv.z += a.z; xv.w += a.w;
            *(float4*)(p.out + (size_t)mm * 1024 + ncol) = xv;
            if (layer == 0) {
              sq[it] += xv.x * xv.x + xv.y * xv.y + xv.z * xv.z + xv.w * xv.w;
              const float4 w4 = *(const float4*)(nw1 + ncol);
              u32x2 o; o.x = pk2(xv.x * w4.x, xv.y * w4.y); o.y = pk2(xv.z * w4.z, xv.w * w4.w);
              *(u32x2*)(p.hbf + (size_t)mm * 1024 + ncol) = o;
            }
          }
          __builtin_amdgcn_wave_barrier();
        }
        if (layer == 0) {
#pragma unroll
          for (int it = 0; it < 4; ++it) {
            const float s = sum8(sq[it]);
            if ((lane & 7) == 0) atomicAdd(p.ssq + mb + it * 8 + (lane >> 3), s);
          }
        }
      }
    }
    zero_acc();
  }
}

constexpr int VS = 66;
DI void attn_item(const Params& p, int layer, int wi, bf16_t* vl) {
  const int lane = TID & 63, r = lane & 31, h = lane >> 5;
  const bool sample = wi >= 16384;
  int b, hd, qt, tok0, qabs0;
  if (!sample) { b = wi >> 9; hd = (wi >> 6) & 7; qt = wi & 63; tok0 = b * 2048; qabs0 = qt * 32; }
  else { int j = wi - 16384; b = j >> 3; hd = j & 7; qt = 0; tok0 = NTOK_P + b * 32; qabs0 = 4096; }
  const int tq0 = tok0 + qt * 32;
  bf16x8 qf[4];
  {
    const bf16_t* qp = p.P + (size_t)(tq0 + r) * D_IN + OFF_Q + hd * 64 + h * 8;
#pragma unroll
    for (int ks = 0; ks < 4; ++ks) qf[ks] = *(const bf16x8*)(qp + ks * 16);
  }
  f32x16 o[2];
#pragma unroll
  for (int d = 0; d < 2; ++d)
#pragma unroll
    for (int i = 0; i < 16; ++i) o[d][i] = 0.f;
  float run = 0.f;
  const int nblk = qabs0 / 32 + 1;
  const int pir = 16 * ((r >> 2) & 1) + 4 * (r >> 3) + (r & 3);
  const float* ck = p.cache_k + ((size_t)(layer * 16 + b) * 4096) * 512 + hd * 64;
  const float* cv = p.cache_v + ((size_t)(layer * 16 + b) * 4096) * 512 + hd * 64;

  for (int kb = nblk - 1; kb >= 0; --kb) {
    const int kp0 = kb * 32;
    const bool fromP = (!sample) || (kb == 128);
    bf16x8 kf[4];
    if (fromP) {
      const int tk = sample ? (tok0 + (kp0 + pir - 4096)) : (tok0 + kp0 + pir);
      const bf16_t* kp = p.P + (size_t)tk * D_IN + OFF_K + hd * 64 + h * 8;
#pragma unroll
      for (int ks = 0; ks < 4; ++ks) kf[ks] = *(const bf16x8*)(kp + ks * 16);
#pragma unroll
      for (int i = 0; i < 4; ++i) {
        const int key = i * 8 + (lane >> 3), dc = lane & 7;
        const int tv = sample ? (tok0 + (kp0 + key - 4096)) : (tok0 + kp0 + key);
        u32x4 v = *(const u32x4*)(p.P + (size_t)tv * D_IN + OFF_V + hd * 64 + dc * 8);
        unsigned* dst = (unsigned*)(vl + key * VS + dc * 8);
        dst[0] = v.x; dst[1] = v.y; dst[2] = v.z; dst[3] = v.w;
      }
    } else {
      const float* kp = ck + (size_t)(kp0 + pir) * 512 + h * 8;
#pragma unroll
      for (int ks = 0; ks < 4; ++ks) {
        float4 a = *(const float4*)(kp + ks * 16), c = *(const float4*)(kp + ks * 16 + 4);
        u32x4 t; t.x = pk2(a.x, a.y); t.y = pk2(a.z, a.w); t.z = pk2(c.x, c.y); t.w = pk2(c.z, c.w);
        kf[ks] = __builtin_bit_cast(bf16x8, t);
      }
#pragma unroll
      for (int i = 0; i < 4; ++i) {
        const int key = i * 8 + (lane >> 3), dc = lane & 7;
        const float* vp = cv + (size_t)(kp0 + key) * 512 + dc * 8;
        float4 a = *(const float4*)vp, c = *(const float4*)(vp + 4);
        unsigned* dst = (unsigned*)(vl + key * VS + dc * 8);
        dst[0] = pk2(a.x, a.y); dst[1] = pk2(a.z, a.w); dst[2] = pk2(c.x, c.y); dst[3] = pk2(c.z, c.w);
      }
    }
    f32x16 st;
#pragma unroll
    for (int i = 0; i < 16; ++i) st[i] = 0.f;
#pragma unroll
    for (int ks = 0; ks < 4; ++ks) st = MFMA(kf[ks], qf[ks], st);
    const bool diag = (kb == nblk - 1);
    float z[16], lk[16], lat[16];
#pragma unroll
    for (int i = 0; i < 16; ++i) {
      z[i] = st[i] * 0.125f;
      const bool msk = (!diag) || (16 * h + i < r);
      const float e = __expf(-fabsf(z[i]));
      const float sp = fmaxf(z[i], 0.f) + __logf(1.f + e);
      lk[i] = msk ? -sp : 0.f;
    }
    float suf = 0.f;
#pragma unroll
    for (int i = 15; i >= 0; --i) { lat[i] = suf; suf += lk[i]; }
    const float other = __shfl_xor(suf, 32);
    const float base = run + (h == 0 ? other : 0.f);
    float a[16];
#pragma unroll
    for (int i = 0; i < 16; ++i) {
      const bool msk = (!diag) || (16 * h + i < r);
      a[i] = msk ? __expf(z[i] + lk[i] + base + lat[i]) : 0.f;
    }
    run += suf + other;
    __builtin_amdgcn_wave_barrier();
#pragma unroll
    for (int s2 = 0; s2 < 2; ++s2) {
      u32x4 t; t.x = pk2(a[8 * s2], a[8 * s2 + 1]); t.y = pk2(a[8 * s2 + 2], a[8 * s2 + 3]); t.z = pk2(a[8 * s2 + 4], a[8 * s2 + 5]); t.w = pk2(a[8 * s2 + 6], a[8 * s2 + 7]);
      const bf16x8 pf = __builtin_bit_cast(bf16x8, t);
#pragma unroll
      for (int dt = 0; dt < 2; ++dt) {
        const bf16_t* vp = vl + (16 * h + 8 * s2) * VS + 32 * dt + r;
        bf16x8 vf;
#pragma unroll
        for (int j = 0; j < 8; ++j) vf[j] = (short)vp[j * VS];
        o[dt] = MFMA(vf, pf, o[dt]);
      }
    }
    __builtin_amdgcn_wave_barrier();
    if (__all(run < -104.f)) break;
  }
  const int tok = tq0 + r;
#pragma unroll
  for (int dt = 0; dt < 2; ++dt)
#pragma unroll
    for (int g = 0; g < 4; ++g) {
      const int d0 = 32 * dt + 8 * g + 4 * h;
      u32x2 ga = *(const u32x2*)(p.P + (size_t)tok * D_IN + OFF_GA + hd * 64 + d0);
      u32x2 ov;
      ov.x = pk2(o[dt][4 * g] * siluf_(bflo(ga.x)), o[dt][4 * g + 1] * siluf_(bfhi(ga.x)));
      ov.y = pk2(o[dt][4 * g + 2] * siluf_(bflo(ga.y)), o[dt][4 * g + 3] * siluf_(bfhi(ga.y)));
      *(u32x2*)(p.mix + (size_t)tok * 1024 + hd * 64 + d0) = ov;
    }
}

constexpr int S5_BU = 8192;
constexpr int S5_LDS = S5_BU + 8704 + 1024;
DI void s5_disc(const Params& p, int lg, int pi, float dt, float& ar, float& ai, float& fr, float& fi) {
  const float lr = fminf(p.lam_re[lg * 64 + pi], -1e-4f), li = p.lam_im[lg * 64 + pi];
  const float er = expf(lr * dt);
  ar = er * cosf(li * dt); ai = er * sinf(li * dt);
  const float den = lr * lr + li * li;
  fr = ((ar - 1.f) * lr + ai * li) / den; fi = (ai * lr - (ar - 1.f) * li) / den;
}
DI void s5_item(const Params& p, int layer, int item, char* lds) {
  float* BU = (float*)lds;
  char* Himg = lds + S5_BU;
  bf16_t* Ub = (bf16_t*)(lds + S5_BU + 8704);
  const int lane = TID & 63, r = lane & 31, h = lane >> 5;
  const int seq = item >> 4, g = item & 15;
  const bool sample = seq >= 32;
  const int b = sample ? seq - 32 : seq, L = sample ? 32 : 2048, tok0 = sample ? NTOK_P + b * 32 : b * 2048;
  const int lg = layer * 16 + g;
  const float dt = expf(p.log_dt[lg]);
  float ar, ai, fr_, fi_;
  s5_disc(p, lg, lane, dt, ar, ai, fr_, fi_);
  bf16x8 bbf[4];
#pragma unroll
  for (int half = 0; half < 2; ++half) {
    const int pi = 32 * half + r;
    float a_r, a_i, f_r, f_i;
    s5_disc(p, lg, pi, dt, a_r, a_i, f_r, f_i);
    const float* brp = p.b_re + ((size_t)lg * 64 + pi) * 16 + 8 * h;
    const float* bip = p.b_im + ((size_t)lg * 64 + pi) * 16 + 8 * h;
    float re[8], im[8];
#pragma unroll
    for (int j = 0; j < 8; ++j) { const float br = brp[j], bi = bip[j]; re[j] = f_r * br - f_i * bi; im[j] = f_r * bi + f_i * br; }
    u32x4 t0, t1;
    t0.x = pk2(re[0], re[1]); t0.y = pk2(re[2], re[3]); t0.z = pk2(re[4], re[5]); t0.w = pk2(re[6], re[7]);
    t1.x = pk2(im[0], im[1]); t1.y = pk2(im[2], im[3]); t1.z = pk2(im[4], im[5]); t1.w = pk2(im[6], im[7]);
    bbf[half] = __builtin_bit_cast(bf16x8, t0);
    bbf[2 + half] = __builtin_bit_cast(bf16x8, t1);
  }
  bf16x8 cf[8];
#pragma unroll
  for (int s = 0; s < 8; ++s) {
    u32x4 t; t.x = 0; t.y = 0; t.z = 0; t.w = 0;
    if (r < 16) {
      const int k0 = 16 * s + 8 * h;
      const float* src = (s < 4 ? p.c_re : p.c_im) + ((size_t)lg * 16 + r) * 64 + (k0 & 63);
      const float sg = s < 4 ? 1.f : -1.f;
      const float4 c0 = *(const float4*)src, c1 = *(const float4*)(src + 4);
      t.x = pk2(sg * c0.x, sg * c0.y); t.y = pk2(sg * c0.z, sg * c0.w); t.z = pk2(sg * c1.x, sg * c1.y); t.w = pk2(sg * c1.z, sg * c1.w);
    }
    cf[s] = __builtin_bit_cast(bf16x8, t);
  }
  const float dl = p.ssm_d[lg * 16 + (r & 15)];
  float hr = 0.f, hi = 0.f;
  if (sample) { hr = p.st_re[((size_t)(layer * 16 + b) * 16 + g) * 64 + lane]; hi = p.st_im[((size_t)(layer * 16 + b) * 16 + g) * 64 + lane]; }
  f32x16 zero;
#pragma unroll
  for (int i = 0; i < 16; ++i) zero[i] = 0.f;
  const bf16_t* upb = p.P + (size_t)(tok0 + r) * D_IN + OFF_U + g * 16 + 8 * h;
  bf16x8 uf = *(const bf16x8*)upb;
  for (int t0 = 0; t0 < L; t0 += 32) {
    const bf16x8 ucur = uf;
    if (t0 + 32 < L) uf = *(const bf16x8*)(upb + (size_t)(t0 + 32) * D_IN);
    *(bf16x8*)(Ub + r * 16 + 8 * h) = ucur;
    f32x16 d[4];
#pragma unroll
    for (int tile = 0; tile < 4; ++tile) d[tile] = MFMA(ucur, bbf[tile], zero);
#pragma unroll
    for (int hf = 0; hf < 2; ++hf) {
#pragma unroll
      for (int tile = 0; tile < 4; ++tile)
#pragma unroll
        for (int i = 0; i < 8; ++i) BU[((i & 3) + 8 * (i >> 2) + 4 * h) * 128 + 32 * tile + r] = d[tile][8 * hf + i];
      __builtin_amdgcn_wave_barrier();
#pragma unroll
      for (int tt = 0; tt < 16; ++tt) {
        const int t = 16 * hf + tt;
        const float bur = BU[tt * 128 + lane], bui = BU[tt * 128 + 64 + lane];
        const float nhr = ar * hr - ai * hi + bur, nhi = ar * hi + ai * hr + bui;
        hr = nhr; hi = nhi;
        *(bf16_t*)(Himg + t * 272 + lane * 2) = (bf16_t)f2bf(hr);
        *(bf16_t*)(Himg + t * 272 + 128 + lane * 2) = (bf16_t)f2bf(hi);
      }
      __builtin_amdgcn_wave_barrier();
    }
    f32x16 yacc = zero;
#pragma unroll
    for (int s = 0; s < 8; ++s) {
      const bf16x8 af = *(const bf16x8*)(Himg + r * 272 + s * 32 + h * 16);
      yacc = MFMA(af, cf[s], yacc);
    }
    if (r < 16) {
#pragma unroll
      for (int i = 0; i < 16; ++i) {
        const int t = (i & 3) + 8 * (i >> 2) + 4 * h;
        const float yv = yacc[i] + dl * bf2f(Ub[t * 16 + r]);
        const float gl = yv / (1.f + __expf(-1.5957691216f * (yv + 0.044715f * yv * yv * yv)));
        p.yb[(size_t)(tok0 + t0 + t) * 256 + g * 16 + r] = (bf16_t)f2bf(gl);
      }
    }
    __builtin_amdgcn_wave_barrier();
  }
  float* ore = p.out + (sample ? O_SRES : O_SREP) + ((size_t)(layer * (sample ? 16 : 32) + b) * 16 + g) * 64 + lane;
  float* oim = p.out + (sample ? O_SIMS : O_SIMP) + ((size_t)(layer * (sample ? 16 : 32) + b) * 16 + g) * 64 + lane;
  *ore = hr; *oim = hi;
}

DI void rwkv_item(const Params& p, int layer, int item, char* smem) {
  constexpr int SETF = 6 * 2048;
  float* SET0 = (float*)smem;
  float* YB = SET0 + 2 * SETF;
  char* PW = (char*)(YB + 2 * 2048);
  const int tid = TID, lane = tid & 63, wv = tid >> 6;
  const int seq = item >> 2, hd = item & 3;
  const bool sample = seq >= 32;
  const int b = sample ? seq - 32 : seq, L = sample ? 32 : 2048, tok0 = sample ? NTOK_P + b * 32 : b * 2048;
  const int nch = L >> 5;
  if (wv < 4) {
    const int rp = tid >> 3, kq = tid & 7;
    f32x2 S0[4], S1[4];
    if (sample) {
      const float* sp = p.st_wkv + (((size_t)(layer * 16 + b) * 4 + hd) * 64 + rp) * 64 + kq * 8;
#pragma unroll
      for (int j = 0; j < 4; ++j) { S0[j].x = sp[2 * j]; S0[j].y = sp[2 * j + 1]; S1[j].x = sp[2048 + 2 * j]; S1[j].y = sp[2048 + 2 * j + 1]; }
    } else {
#pragma unroll
      for (int j = 0; j < 4; ++j) { S0[j].x = 0.f; S0[j].y = 0.f; S1[j].x = 0.f; S1[j].y = 0.f; }
    }
    lds_barrier();
    for (int c = 0; c < nch; ++c) {
      const float* R = SET0 + (c & 1) * SETF; const float* W = R + 2048; const float* KT = W + 2048; const float* KH = KT + 2048;
      const float* BB = KH + 2048; const float* V = BB + 2048;
      float* Y = YB + (c & 1) * 2048;
      float yk0[4], yk1[4];
      float4 nkh0, nkh1, nw0, nw1, nb0, nb1, nk0, nk1, nr0, nr1; float nv0, nv1;
      {
        const int o = kq * 8;
        nkh0 = *(const float4*)(KH + o); nkh1 = *(const float4*)(KH + o + 4); nw0 = *(const float4*)(W + o); nw1 = *(const float4*)(W + o + 4);
        nb0 = *(const float4*)(BB + o); nb1 = *(const float4*)(BB + o + 4); nk0 = *(const float4*)(KT + o); nk1 = *(const float4*)(KT + o + 4);
        nr0 = *(const float4*)(R + o); nr1 = *(const float4*)(R + o + 4); nv0 = V[rp]; nv1 = V[rp + 32];
      }
#pragma unroll
      for (int q = 0; q < 4; ++q) {
        yk0[q] = 0.f; yk1[q] = 0.f;
#pragma unroll
        for (int e = 0; e < 8; ++e) {
          const int tl = q * 8 + e;
          const float4 kh0 = nkh0, kh1 = nkh1, w0_ = nw0, w1_ = nw1, b0 = nb0, b1 = nb1, k0 = nk0, k1 = nk1, r0 = nr0, r1 = nr1;
          const float va = nv0, vb = nv1;
          if (tl < 31) {
            const int o = (tl + 1) * 64 + kq * 8;
            nkh0 = *(const float4*)(KH + o); nkh1 = *(const float4*)(KH + o + 4); nw0 = *(const float4*)(W + o); nw1 = *(const float4*)(W + o + 4);
            nb0 = *(const float4*)(BB + o); nb1 = *(const float4*)(BB + o + 4); nk0 = *(const float4*)(KT + o); nk1 = *(const float4*)(KT + o + 4);
            nr0 = *(const float4*)(R + o); nr1 = *(const float4*)(R + o + 4); nv0 = V[(tl + 1) * 64 + rp]; nv1 = V[(tl + 1) * 64 + rp + 32];
          }
          const f32x2 khv[4] = {{kh0.x, kh0.y}, {kh0.z, kh0.w}, {kh1.x, kh1.y}, {kh1.z, kh1.w}};
          const f32x2 wvv[4] = {{w0_.x, w0_.y}, {w0_.z, w0_.w}, {w1_.x, w1_.y}, {w1_.z, w1_.w}};
          const f32x2 bv[4] = {{b0.x, b0.y}, {b0.z, b0.w}, {b1.x, b1.y}, {b1.z, b1.w}};
          const f32x2 kv[4] = {{k0.x, k0.y}, {k0.z, k0.w}, {k1.x, k1.y}, {k1.z, k1.w}};
          const f32x2 rv[4] = {{r0.x, r0.y}, {r0.z, r0.w}, {r1.x, r1.y}, {r1.z, r1.w}};
          const f32x2 va2 = {va, va}, vb2 = {vb, vb};
          f32x2 ma[4], mb[4];
#pragma unroll
          for (int j = 0; j < 4; ++j) { ma[j] = fma2(S0[j], wvv[j], va2 * kv[j]); mb[j] = fma2(S1[j], wvv[j], vb2 * kv[j]); }
          f32x2 sa2 = fma2(S0[1], khv[1], S0[0] * khv[0]) + fma2(S0[3], khv[3], S0[2] * khv[2]);
          f32x2 sb2 = fma2(S1[1], khv[1], S1[0] * khv[0]) + fma2(S1[3], khv[3], S1[2] * khv[2]);
          const float sa = sum8(sa2.x + sa2.y), sb = sum8(sb2.x + sb2.y);
          const f32x2 nsa = {-sa, -sa}, nsb = {-sb, -sb};
#pragma unroll
          for (int j = 0; j < 4; ++j) { S0[j] = fma2(nsa, bv[j], ma[j]); S1[j] = fma2(nsb, bv[j], mb[j]); }
          f32x2 ya2 = fma2(S0[1], rv[1], S0[0] * rv[0]) + fma2(S0[3], rv[3], S0[2] * rv[2]);
          f32x2 yb2 = fma2(S1[1], rv[1], S1[0] * rv[0]) + fma2(S1[3], rv[3], S1[2] * rv[2]);
          const float ya = sum8(ya2.x + ya2.y), ybv = sum8(yb2.x + yb2.y);
          yk0[q] = (e == kq) ? ya : yk0[q];
          yk1[q] = (e == kq) ? ybv : yk1[q];
        }
      }
#pragma unroll
      for (int q = 0; q < 4; ++q) { Y[(q * 8 + kq) * 64 + rp] = yk0[q]; Y[(q * 8 + kq) * 64 + rp + 32] = yk1[q]; }
      lds_barrier();
    }
    float* so = p.out + (sample ? O_WKVS : O_WKVP) + (((size_t)(layer * (sample ? 16 : 32) + b) * 4 + hd) * 64 + rp) * 64 + kq * 8;
    *(float4*)so = make_float4(S0[0].x, S0[0].y, S0[1].x, S0[1].y);
    *(float4*)(so + 4) = make_float4(S0[2].x, S0[2].y, S0[3].x, S0[3].y);
    *(float4*)(so + 2048) = make_float4(S1[0].x, S1[0].y, S1[1].x, S1[1].y);
    *(float4*)(so + 2052) = make_float4(S1[2].x, S1[2].y, S1[3].x, S1[3].y);
  } else {
    const int pw = wv - 4, r_ = lane & 31, h_ = lane >> 5;
    const int cg_ = hd * 64 + lane;
    bf16_t* LORAb = (bf16_t*)(PW + pw * 5248);
    float* DSA = (float*)(PW + pw * 5248 + 1152);
    bf16x8 lb[2][2][2];
#pragma unroll
    for (int ll = 0; ll < 2; ++ll)
#pragma unroll
      for (int nn = 0; nn < 2; ++nn) {
        const float* srcw = (ll ? p.a2 : p.w2) + (size_t)layer * 32 * 256 + hd * 64 + 32 * nn + r_;
#pragma unroll
        for (int s = 0; s < 2; ++s) {
          float t[8];
#pragma unroll
          for (int j = 0; j < 8; ++j) t[j] = srcw[(size_t)(16 * s + 8 * h_ + j) * 256];
          u32x4 u; u.x = pk2(t[0], t[1]); u.y = pk2(t[2], t[3]); u.z = pk2(t[4], t[5]); u.w = pk2(t[6], t[7]);
          lb[ll][nn][s] = __builtin_bit_cast(bf16x8, u);
        }
      }
    const float w0c = p.w0[layer * 256 + cg_], a0c = p.a0[layer * 256 + cg_], kkc = p.k_k[layer * 256 + cg_], kac = p.k_a[layer * 256 + cg_];
    const float ubc = p.u_bonus[layer * 256 + cg_], lnw = p.ln_w[layer * 256 + cg_], lnb = p.ln_b[layer * 256 + cg_];
    const float* mu = p.mu + layer * 832;
    const float mu_r = mu[cg_], mu_k = mu[256 + cg_], mu_v = mu[512 + cg_], mu_l = mu[768 + lane];
    const float* shp = p.st_shift + (size_t)(layer * 16 + b) * 832;
    auto pre = [&](int c, float (&xvk)[8], float (&bonk)[8], float (&gtk)[8]) {
      float* R = SET0 + (c & 1) * SETF; float* W = R + 2048; float* KT = W + 2048; float* KH = KT + 2048; float* BB = KH + 2048; float* V = BB + 2048;
      const bf16_t* base = p.P + (size_t)(tok0 + c * 32 + 8 * pw) * D_IN + OFF_C;
      bf16_t cr[8], ck[8], cv[8], cl[8], cgt[8];
#pragma unroll
      for (int i = 0; i < 8; ++i) {
        const bf16_t* cp = base + (size_t)i * D_IN;
        cr[i] = cp[cg_]; ck[i] = cp[256 + cg_]; cv[i] = cp[512 + cg_]; cl[i] = cp[768 + lane]; cgt[i] = cp[OFF_GC - OFF_C + cg_];
      }
      float pr, pk, pv, pl;
      if (c * 32 + 8 * pw == 0) {
        if (sample) { pr = shp[cg_]; pk = shp[256 + cg_]; pv = shp[512 + cg_]; pl = shp[768 + lane]; }
        else { pr = 0.f; pk = 0.f; pv = 0.f; pl = 0.f; }
      } else {
        const bf16_t* pp = base - D_IN;
        pr = bf2f(pp[cg_]); pk = bf2f(pp[256 + cg_]); pv = bf2f(pp[512 + cg_]); pl = bf2f(pp[768 + lane]);
      }
      float xr_[8], xk_[8];
#pragma unroll
      for (int i = 0; i < 8; ++i) {
        const float c_r = bf2f(cr[i]), c_k = bf2f(ck[i]), c_v = bf2f(cv[i]), c_l = bf2f(cl[i]);
        xr_[i] = c_r + mu_r * (pr - c_r); xk_[i] = c_k + mu_k * (pk - c_k); xvk[i] = c_v + mu_v * (pv - c_v);
        const float xl = c_l + mu_l * (pl - c_l);
        pr = c_r; pk = c_k; pv = c_v; pl = c_l;
        gtk[i] = bf2f(cgt[i]);
        LORAb[i * 72 + lane] = (bf16_t)f2bf(lane < 32 ? fast_tanh(xl) : xl);
      }
      __builtin_amdgcn_wave_barrier();
#pragma unroll
      for (int ll = 0; ll < 2; ++ll) {
        const bf16x8 af0 = *(const bf16x8*)((const char*)LORAb + (r_ & 7) * 144 + ll * 64 + h_ * 16);
        const bf16x8 af1 = *(const bf16x8*)((const char*)LORAb + (r_ & 7) * 144 + ll * 64 + 32 + h_ * 16);
#pragma unroll
        for (int nn = 0; nn < 2; ++nn) {
          f32x16 dacc;
#pragma unroll
          for (int i = 0; i < 16; ++i) dacc[i] = 0.f;
          dacc = MFMA(af0, lb[ll][nn][0], dacc);
          dacc = MFMA(af1, lb[ll][nn][1], dacc);
#pragma unroll
          for (int i = 0; i < 4; ++i) DSA[ll * 512 + (i + 4 * h_) * 64 + 32 * nn + r_] = dacc[i];
        }
      }
      __builtin_amdgcn_wave_barrier();
#pragma unroll
      for (int i = 0; i < 8; ++i) {
        const int tl = 8 * pw + i;
        const float dsum = w0c + DSA[i * 64 + lane], asum = a0c + DSA[512 + i * 64 + lane];
        const float dec = __expf(-0.6065306597f * sigmoidf_(dsum));
        const float a = sigmoidf_(asum);
        const float kk = xk_[i] * kkc;
        const float ss = wave_sum(kk * kk);
        const float kh = kk * rsqrtf(ss + 1e-12f);
        const float kt = xk_[i] * (1.f + (a - 1.f) * kac);
        bonk[i] = wave_sum(xr_[i] * kt * ubc);
        R[tl * 64 + lane] = xr_[i]; W[tl * 64 + lane] = dec; KT[tl * 64 + lane] = kt; KH[tl * 64 + lane] = kh; BB[tl * 64 + lane] = a * kh; V[tl * 64 + lane] = xvk[i];
      }
      __builtin_amdgcn_wave_barrier();
    };
    auto post = [&](int c, const float (&xvk)[8], const float (&bonk)[8], const float (&gtk)[8]) {
      const float* Y = YB + (c & 1) * 2048;
#pragma unroll
      for (int i = 0; i < 8; ++i) {
        const int tl = 8 * pw + i;
        const float y = Y[tl * 64 + lane];
        const float mean = wave_sum(y) * (1.f / 64.f);
        const float msq = wave_sum(y * y) * (1.f / 64.f);
        const float var = fmaxf(msq - mean * mean, 0.f);
        float yn = (y - mean) * rsqrtf(var + 64e-5f) * lnw + lnb;
        yn += bonk[i] * xvk[i];
        p.mix[(size_t)(tok0 + c * 32 + tl) * 1024 + 768 + cg_] = (bf16_t)f2bf(yn * siluf_(gtk[i]));
      }
    };
    float xvA[8], bonA[8], gtA[8], xvB[8], bonB[8], gtB[8];
#pragma unroll
    for (int i = 0; i < 8; ++i) { xvB[i] = 0.f; bonB[i] = 0.f; gtB[i] = 0.f; }
    pre(0, xvA, bonA, gtA);
    lds_barrier();
    for (int c = 0; c < nch; c += 2) {
      if (c >= 1) post(c - 1, xvB, bonB, gtB);
      if (c + 1 < nch) pre(c + 1, xvB, bonB, gtB);
      lds_barrier();
      if (c + 1 < nch) {
        post(c, xvA, bonA, gtA);
        if (c + 2 < nch) pre(c + 2, xvA, bonA, gtA);
        lds_barrier();
      }
    }
    if ((nch - 1) & 1) post(nch - 1, xvB, bonB, gtB); else post(nch - 1, xvA, bonA, gtA);
  }
  lds_barrier();
}

constexpr int ATT_LDS0 = 6 * S5_LDS;
DI void phase_mixers(const Params& p, int layer, char* smem, int cofs) {
  const int G = GDIM, bid = BID, half = G / 2;
  const int tid = TID, wv = tid >> 6, lane = tid & 63;
  if (bid < half) {
    for (int item = bid; item < 128; item += half) rwkv_item(p, layer, item, smem);
  } else {
    const int j = bid - half, nb2 = G - half;
    for (int item = 128 + j; item < 192; item += nb2) rwkv_item(p, layer, item, smem);
    if (wv < 6) { for (int it = j * 6 + wv; it < 768; it += nb2 * 6) s5_item(p, layer, it, smem + wv * S5_LDS); }
  }
  unsigned* ctr = p.counters + layer + cofs;
  bf16_t* vl = (bf16_t*)(smem + ATT_LDS0) + wv * (32 * VS);
  while (true) {
    int it = 0;
    if (lane == 0) it = (int)atomicAdd(ctr, 1u);
    it = __builtin_amdgcn_readfirstlane(it);
    if (it >= 16512) break;
    attn_item(p, layer, it, vl);
  }
}

__global__ void __launch_bounds__(NT) mega(Params p) {
  __shared__ __attribute__((aligned(16))) char smem[SMEM_BYTES];
  cg::grid_group grid = cg::this_grid();
  phase_weights(p, smem);
  phase_norm(p, 0);
  grid.sync();
  for (int layer = 0; layer < 2; ++layer) {
    gemm_phase<0>(p, layer, smem);
    grid.sync();
#if PROBE_GEMM0
    gemm_phase<0>(p, layer, smem);
    grid.sync();
#endif
    phase_mixers(p, layer, smem, 0);
    grid.sync();
#if PROBE_MIX
    phase_mixers(p, layer, smem, 2);
    grid.sync();
#endif
    gemm_phase<1>(p, layer, smem);
    grid.sync();
    gemm_phase<2>(p, layer, smem);
    if (layer == 0) grid.sync();
  }
}

#if MULTI_LAUNCH
template <int PH>
__global__ void __launch_bounds__(NT) phase_kernel(Params p, int layer) {
  __shared__ __attribute__((aligned(16))) char smem[SMEM_BYTES];
  if (PH == 0) { phase_weights(p, smem); }
  else if (PH == 1) phase_norm(p, layer);
  else if (PH == 2) gemm_phase<0>(p, layer, smem);
  else if (PH == 3) phase_mixers(p, layer, smem, 0);
  else if (PH == 4) gemm_phase<1>(p, layer, smem);
  else gemm_phase<2>(p, layer, smem);
}
#endif

extern "C" void kernel_launch(void* const* d_in, const int* in_sizes, int n_in, void* d_out, int out_size, void* d_ws, size_t ws_size, hipStream_t stream) {
  Params p{};
  const float** f = (const float**)&p;
  for (int i = 0; i < 33; ++i) f[i] = (const float*)d_in[i];
  p.out = (float*)d_out;
  char* ws = (char*)d_ws;
  size_t off = 0;
  auto take = [&](size_t bytes) { char* q = ws + off; off += (bytes + 255) & ~(size_t)255; return q; };
  p.WinT = (bf16_t*)take((size_t)2 * 3648 * 1024 * 2);
  p.WoutT = (bf16_t*)take((size_t)2 * 1024 * 1024 * 2);
  p.WgluT = (bf16_t*)take((size_t)2 * 512 * 256 * 2);
  p.hbf = (bf16_t*)take((size_t)NTOK * 1024 * 2);
  p.P = (bf16_t*)take((size_t)NTOK * D_IN * 2);
  p.mix = (bf16_t*)take((size_t)NTOK * 1024 * 2);
  p.yb = (bf16_t*)take((size_t)NTOK * 256 * 2);
  p.counters = (unsigned*)take(256);
  p.ssq = (float*)take((size_t)NTOK * 4);
  if (off > ws_size || (size_t)out_size != O_END || n_in != 33) fprintf(stderr, "kernel_launch: unexpected sizes ws=%zu need=%zu out=%d n_in=%d\n", ws_size, off, out_size, n_in);
#if MULTI_LAUNCH
  const int G = 256;
  phase_kernel<0><<<G, NT, 0, stream>>>(p, 0);
  for (int layer = 0; layer < 2; ++layer) {
    phase_kernel<1><<<G, NT, 0, stream>>>(p, layer);
    phase_kernel<2><<<G, NT, 0, stream>>>(p, layer);
    phase_kernel<3><<<G, NT, 0, stream>>>(p, layer);
    phase_kernel<4><<<G, NT, 0, stream>>>(p, layer);
    phase_kernel<5><<<G, NT, 0, stream>>>(p, layer);
  }
#else
  static int grid_blocks = 0;
  if (!grid_blocks) {
    int dev = 0, cus = 0, per_cu = 0;
    hipGetDevice(&dev);
    hipDeviceGetAttribute(&cus, hipDeviceAttributeMultiprocessorCount, dev);
    hipOccupancyMaxActiveBlocksPerMultiprocessor(&per_cu, mega, NT, 0);
    if (per_cu < 1) per_cu = 1;
    grid_blocks = cus * per_cu;
  }
  void* args[] = {&p};
  hipError_t e = hipLaunchCooperativeKernel((void*)mega, dim3(grid_blocks), dim3(NT), args, 0, stream);
  if (e != hipSuccess) fprintf(stderr, "cooperative launch failed: %s (grid %d)\n", hipGetErrorString(e), grid_blocks);
#endif
}
```

```cpp
#include <hip/hip_runtime.h>
#include <hip/hip_cooperative_groups.h>
#include <cstdio>
namespace cg = cooperative_groups;

#define PROBE_GEMM0 0
#define PROBE_MIX 0
#ifndef MULTI_LAUNCH
#define MULTI_LAUNCH 0
#endif

#define DI __device__ __forceinline__
typedef unsigned short bf16_t;
typedef short bf16x8 __attribute__((ext_vector_type(8)));
typedef float f32x16 __attribute__((ext_vector_type(16)));
typedef unsigned u32x4 __attribute__((ext_vector_type(4)));
typedef unsigned u32x2 __attribute__((ext_vector_type(2)));
#define MFMA(a, b, c) __builtin_amdgcn_mfma_f32_32x32x16_bf16((a), (b), (c), 0, 0, 0)

constexpr int NT = 512;
constexpr int NTOK_P = 65536, NTOK = 66048, D_IN = 3648;
constexpr int OFF_Q = 0, OFF_K = 512, OFF_V = 1024, OFF_GA = 1536, OFF_U = 2048, OFF_GB = 2304, OFF_C = 2560, OFF_GC = 3392;
constexpr size_t O_Y = 0, O_KP = 67633152, O_VP = 134742016, O_SREP = 201850880, O_SIMP = 201916416, O_WKVP = 201981952,
                 O_SHP = 203030528, O_KS = 203083776, O_VS = 203608064, O_SRES = 204132352, O_SIMS = 204165120,
                 O_WKVS = 204197888, O_SHS = 204722176, O_END = 204748800;
constexpr int SMEM_BYTES = 2 * 55296 + 8 * 4608;
constexpr int LDS_ROW = 144;
constexpr int STAGE = (256 + 128) * LDS_ROW;

struct Params {
  const float *x_prompt, *x_sample, *cache_k, *cache_v, *st_re, *st_im, *st_wkv, *st_shift;
  const float *norm_w, *w_in, *q_norm_w, *k_norm_w, *lam_re, *lam_im, *log_dt, *b_re, *b_im, *c_re, *c_im, *ssm_d, *w_glu, *b_glu;
  const float *mu, *w0, *w2, *a0, *a2, *k_k, *k_a, *u_bonus, *ln_w, *ln_b, *w_out;
  float* out;
  bf16_t *WinT, *WoutT, *WgluT, *hbf, *P, *mix, *yb;
  unsigned* counters;
  float* ssq;
};

DI int opq_v(int x) { asm volatile("" : "+v"(x)); return x; }
DI int opq_s(int x) { asm volatile("" : "+s"(x)); return x; }
#define TID opq_v((int)threadIdx.x)
#define BID opq_s((int)blockIdx.x)
#define GDIM opq_s((int)gridDim.x)
DI unsigned f2bf(float x) { unsigned u = __float_as_uint(x); u += 0x7fffu + ((u >> 16) & 1u); return u >> 16; }
DI unsigned pk2(float a, float b) { return f2bf(a) | (f2bf(b) << 16); }
DI float bf2f(unsigned v) { return __uint_as_float(v << 16); }
DI float bflo(unsigned w) { return __uint_as_float(w << 16); }
DI float bfhi(unsigned w) { return __uint_as_float(w & 0xffff0000u); }
DI float sigmoidf_(float x) { return 1.f / (1.f + __expf(-x)); }
DI float siluf_(float x) { return x / (1.f + __expf(-x)); }
typedef float f32x2 __attribute__((ext_vector_type(2)));
DI f32x2 fma2(f32x2 a, f32x2 b, f32x2 c) { return __builtin_elementwise_fma(a, b, c); }
template <int CTRL> DI float dpp_mov(float x) { return __int_as_float(__builtin_amdgcn_update_dpp(0, __float_as_int(x), CTRL, 0xF, 0xF, true)); }
DI float sum8(float x) { x += dpp_mov<0xB1>(x); x += dpp_mov<0x4E>(x); x += dpp_mov<0x141>(x); return x; }
DI float fast_tanh(float x) { return 1.f - 2.f / (1.f + __expf(2.f * x)); }
DI void lds_barrier() { asm volatile("s_waitcnt lgkmcnt(0)\n\ts_barrier" ::: "memory"); }
DI float wave_sum(float v) {
  v += dpp_mov<0xB1>(v); v += dpp_mov<0x4E>(v); v += dpp_mov<0x141>(v); v += dpp_mov<0x140>(v);
  v += __int_as_float(__builtin_amdgcn_update_dpp(0, __float_as_int(v), 0x142, 0xA, 0xF, false));
  v += __int_as_float(__builtin_amdgcn_update_dpp(0, __float_as_int(v), 0x143, 0xC, 0xF, false));
  return __int_as_float(__builtin_amdgcn_readlane(__float_as_int(v), 63));
}
DI const float* xrow(const Params& p, int layer, int row) {
  if (layer == 0) return row < NTOK_P ? p.x_prompt + (size_t)row * 1024 : p.x_sample + (size_t)(row - NTOK_P) * 1024;
  return p.out + (size_t)row * 1024;
}

DI void transpose_tile(const float* __restrict__ src, int K, int N, bf16_t* __restrict__ dst, int k0, int n0, float* tile) {
  const int tid = TID;
#pragma unroll
  for (int i = 0; i < 8; ++i) { int idx = tid + NT * i; int kk = idx >> 6, nn = idx & 63; tile[kk * 65 + nn] = src[(size_t)(k0 + kk) * N + n0 + nn]; }
  __syncthreads();
#pragma unroll
  for (int i = 0; i < 8; ++i) { int idx = tid + NT * i; int nn = idx >> 6, kk = idx & 63; dst[(size_t)(n0 + nn) * K + k0 + kk] = (bf16_t)f2bf(tile[kk * 65 + nn]); }
  __syncthreads();
}
DI void phase_weights(const Params& p, char* smem) {
  float* tile = (float*)smem;
  const int bid = BID, gdim = GDIM;
  for (int t = bid; t < 2400; t += gdim) {
    int layer = t / 1200, j = t % 1200;
    if (j < 912) { int kt = j / 57, nt = j % 57; transpose_tile(p.w_in + (size_t)layer * 1024 * 3648, 1024, 3648, p.WinT + (size_t)layer * 3648 * 1024, kt * 64, nt * 64, tile); }
    else if (j < 1168) { j -= 912; int kt = j / 16, nt = j % 16; transpose_tile(p.w_out + (size_t)layer * 1024 * 1024, 1024, 1024, p.WoutT + (size_t)layer * 1024 * 1024, kt * 64, nt * 64, tile); }
    else { j -= 1168; int kt = j / 8, nt = j % 8; transpose_tile(p.w_glu + (size_t)layer * 256 * 512, 256, 512, p.WgluT + (size_t)layer * 512 * 256, kt * 64, nt * 64, tile); }
  }
  { const int tid = TID; if (bid == 0 && tid < 64) p.counters[tid] = 0;
    for (int i = bid * NT + tid; i < NTOK; i += gdim * NT) p.ssq[i] = 0.f; }
}

DI void phase_norm(const Params& p, int layer) {
  const int tid = TID, lane = tid & 63, w = tid >> 6;
  const int bid = BID, gdim = GDIM;
  const float* nw = p.norm_w + layer * 1024;
  const int stride = gdim * 8;
  for (int row0 = bid * 8 + w; row0 < NTOK; row0 += 2 * stride) {
    const int row1 = row0 + stride;
    const bool has1 = row1 < NTOK;
    const float* x0 = xrow(p, layer, row0);
    const float* x1 = xrow(p, layer, has1 ? row1 : row0);
    float4 v0[4], v1[4]; float s0 = 0.f, s1 = 0.f;
#pragma unroll
    for (int i = 0; i < 4; ++i) { v0[i] = *(const float4*)(x0 + i * 256 + lane * 4); v1[i] = *(const float4*)(x1 + i * 256 + lane * 4); }
#pragma unroll
    for (int i = 0; i < 4; ++i) {
      s0 += v0[i].x * v0[i].x + v0[i].y * v0[i].y + v0[i].z * v0[i].z + v0[i].w * v0[i].w;
      s1 += v1[i].x * v1[i].x + v1[i].y * v1[i].y + v1[i].z * v1[i].z + v1[i].w * v1[i].w;
    }
    s0 = wave_sum(s0); s1 = wave_sum(s1);
    const float c0 = rsqrtf(s0 * (1.f / 1024.f) + 1e-6f), c1 = rsqrtf(s1 * (1.f / 1024.f) + 1e-6f);
#pragma unroll
    for (int i = 0; i < 4; ++i) {
      float4 wv = *(const float4*)(nw + i * 256 + lane * 4);
      u32x2 o; o.x = pk2(v0[i].x * c0 * wv.x, v0[i].y * c0 * wv.y); o.y = pk2(v0[i].z * c0 * wv.z, v0[i].w * c0 * wv.w);
      *(u32x2*)(p.hbf + (size_t)row0 * 1024 + i * 256 + lane * 4) = o;
      if (has1) {
        u32x2 o1; o1.x = pk2(v1[i].x * c1 * wv.x, v1[i].y * c1 * wv.y); o1.y = pk2(v1[i].z * c1 * wv.z, v1[i].w * c1 * wv.w);
        *(u32x2*)(p.hbf + (size_t)row1 * 1024 + i * 256 + lane * 4) = o1;
      }
    }
  }
}

template <int MODE>
DI void gemm_phase(const Params& p, int layer, char* smem) {
  constexpr int K = (MODE == 1) ? 256 : 1024;
  constexpr int NTN = (MODE == 0) ? 29 : (MODE == 1 ? 4 : 8);
  constexpr int KT = K / 64;
  const bf16_t* __restrict__ A = MODE == 0 ? p.hbf : (MODE == 1 ? p.yb : p.mix);
  const bf16_t* __restrict__ Bt = MODE == 0 ? p.WinT + (size_t)layer * 3648 * 1024 : (MODE == 1 ? p.WgluT + (size_t)layer * 512 * 256 : p.WoutT + (size_t)layer * 1024 * 1024);
  const int tid = TID, lane = tid & 63, wv = tid >> 6, r = lane & 31, h = lane >> 5;
  const int wm = wv >> 1, wn = wv & 1;
  const int bid = BID, gdim = GDIM;
  const int xcd = bid & 7, jb = bid >> 3, nbx = (gdim - xcd + 7) >> 3;

  const int total_x = ((258 - xcd + 7) >> 3) * NTN;
  const int nmine = jb < total_x ? (total_x - jb + nbx - 1) / nbx : 0;
  if (nmine == 0) return;
  const int lrow = tid >> 3, kc = tid & 7;
  auto set_ptrs = [&](int idx, const bf16_t* (&ap)[4], const bf16_t* (&bp)[2]) {
    const int tmi_ = idx / NTN, tn_ = idx % NTN, m0_ = (xcd + 8 * tmi_) * 256, n0_ = tn_ * 128;
#pragma unroll
    for (int i = 0; i < 4; ++i) ap[i] = A + (size_t)(m0_ + lrow + 64 * i) * K + kc * 8;
#pragma unroll
    for (int i = 0; i < 2; ++i) {
      int row = lrow + 64 * i, brow;
      if (MODE == 0) { brow = n0_ + row; brow = brow < 3648 ? brow : 3647; }
      else if (MODE == 2) brow = n0_ + row;
      else { int wn_ = row >> 6, nt_ = (row >> 5) & 1, c_ = row & 31; brow = nt_ * 256 + tn_ * 64 + wn_ * 32 + c_; }
      bp[i] = Bt + (size_t)brow * K + kc * 8;
    }
  };
  f32x16 acc[2][2];
  auto zero_acc = [&]() {
#pragma unroll
    for (int a = 0; a < 2; ++a)
#pragma unroll
      for (int b = 0; b < 2; ++b)
#pragma unroll
        for (int i = 0; i < 16; ++i) acc[a][b][i] = 0.f;
  };
  auto compute = [&](const char* buf, char* nbuf, const u32x4 (&pa)[4], const u32x4 (&pb)[2]) {
    const char* As = buf; const char* Bs = buf + 256 * LDS_ROW;
    char* An = nbuf; char* Bn = nbuf + 256 * LDS_ROW;
    __builtin_amdgcn_iglp_opt(0);
#pragma unroll
    for (int s = 0; s < 4; ++s) {
      bf16x8 af[2], bfr[2];
#pragma unroll
      for (int mt = 0; mt < 2; ++mt) af[mt] = *(const bf16x8*)(As + (wm * 64 + mt * 32 + r) * LDS_ROW + s * 32 + h * 16);
#pragma unroll
      for (int nt = 0; nt < 2; ++nt) bfr[nt] = *(const bf16x8*)(Bs + (wn * 64 + nt * 32 + r) * LDS_ROW + s * 32 + h * 16);
#pragma unroll
      for (int mt = 0; mt < 2; ++mt)
#pragma unroll
        for (int nt = 0; nt < 2; ++nt) acc[mt][nt] = MFMA(bfr[nt], af[mt], acc[mt][nt]);
      if (s < 2) {
        *(u32x4*)(An + (lrow + 64 * (2 * s)) * LDS_ROW + kc * 16) = pa[2 * s];
        *(u32x4*)(An + (lrow + 64 * (2 * s + 1)) * LDS_ROW + kc * 16) = pa[2 * s + 1];
      } else {
        *(u32x4*)(Bn + (lrow + 64 * (s - 2)) * LDS_ROW + kc * 16) = pb[s - 2];
      }
    }
  };
  u32x4 sa[4][4], sb[4][2];
  const bf16_t* cap[4]; const bf16_t* cbp[2]; const bf16_t* nap[4]; const bf16_t* nbp[2];
  set_ptrs(jb, cap, cbp);
#pragma unroll
  for (int j = 0; j < 4; ++j) {
#pragma unroll
    for (int i = 0; i < 4; ++i) sa[j][i] = *(const u32x4*)(cap[i] + j * 64);
#pragma unroll
    for (int i = 0; i < 2; ++i) sb[j][i] = *(const u32x4*)(cbp[i] + j * 64);
  }
  {
    char* As = smem; char* Bs = smem + 256 * LDS_ROW;
#pragma unroll
    for (int i = 0; i < 4; ++i) *(u32x4*)(As + (lrow + 64 * i) * LDS_ROW + kc * 16) = sa[0][i];
#pragma unroll
    for (int i = 0; i < 2; ++i) *(u32x4*)(Bs + (lrow + 64 * i) * LDS_ROW + kc * 16) = sb[0][i];
  }
  lds_barrier();
  zero_acc();
  int c_idx = jb;
  for (int ti = 0; ti < nmine; ++ti) {
    set_ptrs(ti + 1 < nmine ? c_idx + nbx : c_idx, nap, nbp);
    for (int q = 0; q < KT / 4; ++q) {
      const bool lastq = (q == KT / 4 - 1);
      const int koff = lastq ? 0 : (4 * (q + 1)) * 64;
      const bf16_t* lap[4]; const bf16_t* lbp[2];
#pragma unroll
      for (int i = 0; i < 4; ++i) lap[i] = (lastq ? nap[i] : cap[i]) + koff;
#pragma unroll
      for (int i = 0; i < 2; ++i) lbp[i] = (lastq ? nbp[i] : cbp[i]) + koff;
#pragma unroll
      for (int j = 0; j < 4; ++j) {
#pragma unroll
        for (int i = 0; i < 4; ++i) sa[j][i] = *(const u32x4*)(lap[i] + j * 64);
#pragma unroll
        for (int i = 0; i < 2; ++i) sb[j][i] = *(const u32x4*)(lbp[i] + j * 64);
        compute(smem + (j & 1) * STAGE, smem + ((j + 1) & 1) * STAGE, sa[(j + 1) & 3], sb[(j + 1) & 3]);
        lds_barrier();
      }
    }
#pragma unroll
    for (int i = 0; i < 4; ++i) cap[i] = nap[i];
#pragma unroll
    for (int i = 0; i < 2; ++i) cbp[i] = nbp[i];
    const int idx = c_idx; c_idx += nbx;
    const int tmi = idx / NTN, tn = idx % NTN, tm = xcd + 8 * tmi;
    const int m0 = tm * 256, n0 = tn * 128;
    char* eps = smem + 2 * STAGE + wv * 4608;
    if (MODE == 0) {
      const int nb = n0 + wn * 64;
      if (nb < 3648) {
        if (layer == 1) {
#pragma unroll
          for (int mt = 0; mt < 2; ++mt) {
            const float rs = rsqrtf(p.ssq[m0 + wm * 64 + mt * 32 + r] * (1.f / 1024.f) + 1e-6f);
#pragma unroll
            for (int nt = 0; nt < 2; ++nt)
#pragma unroll
              for (int i = 0; i < 16; ++i) acc[mt][nt][i] *= rs;
          }
        }
        float scale[2] = {1.f, 1.f};
        if (nb < 1024) {
#pragma unroll
          for (int mt = 0; mt < 2; ++mt) {
            float ss = 0.f;
#pragma unroll
            for (int nt = 0; nt < 2; ++nt)
#pragma unroll
              for (int i = 0; i < 16; ++i) ss += acc[mt][nt][i] * acc[mt][nt][i];
            ss += __shfl_xor(ss, 32);
            scale[mt] = rsqrtf(ss * (1.f / 64.f) + 1e-6f);
          }
        }
        const float* nw = (nb < 512 ? p.q_norm_w : p.k_norm_w) + layer * 64;
#pragma unroll
        for (int mt = 0; mt < 2; ++mt) {
          const int mb = m0 + wm * 64 + mt * 32;
          const int m = mb + r;
          const bool is_p = m < NTOK_P;
#pragma unroll
          for (int nt = 0; nt < 2; ++nt) {
#pragma unroll
            for (int g = 0; g < 4; ++g) {
              const int ncol = nb + nt * 32 + 8 * g + 4 * h;
              float v0 = acc[mt][nt][4 * g], v1 = acc[mt][nt][4 * g + 1], v2 = acc[mt][nt][4 * g + 2], v3 = acc[mt][nt][4 * g + 3];
              if (nb < 1024) {
                float4 w4 = *(const float4*)(nw + (ncol - nb));
                v0 *= scale[mt] * w4.x; v1 *= scale[mt] * w4.y; v2 *= scale[mt] * w4.z; v3 *= scale[mt] * w4.w;
              }
              *(float4*)(eps + r * 144 + (8 * g + 4 * h) * 4) = make_float4(v0, v1, v2, v3);
              if (nb >= OFF_C && nb < OFF_GC) {
                const bool last = is_p ? ((m & 2047) == 2047) : (((m - NTOK_P) & 31) == 31);
                if (last) {
                  float* dst = p.out + (is_p ? O_SHP + ((size_t)layer * 32 + (m >> 11)) * 832 : O_SHS + ((size_t)layer * 16 + ((m - NTOK_P) >> 5)) * 832) + (ncol - OFF_C);
                  *(float4*)dst = make_float4(v0, v1, v2, v3);
                }
              }
            }
            __builtin_amdgcn_wave_barrier();
#pragma unroll
            for (int it = 0; it < 2; ++it) {
              const int row = (lane >> 2) + 16 * it, ch = lane & 3;
              const float4 a = *(const float4*)(eps + row * 144 + ch * 32), c = *(const float4*)(eps + row * 144 + ch * 32 + 16);
              u32x4 o; o.x = pk2(a.x, a.y); o.y = pk2(a.z, a.w); o.z = pk2(c.x, c.y); o.w = pk2(c.z, c.w);
              *(u32x4*)(p.P + (size_t)(mb + row) * D_IN + nb + nt * 32 + ch * 8) = o;
            }
            if (nb >= 512 && nb < 1536) {
#pragma unroll
              for (int it = 0; it < 4; ++it) {
                const int row = it * 8 + (lane >> 3), ch = lane & 7;
                const float4 a = *(const float4*)(eps + row * 144 + ch * 16);
                const int mm = mb + row;
                const bool pp = mm < NTOK_P;
                float* dst;
                if (nb < 1024) dst = p.out + (pp ? O_KP + ((size_t)layer * 65536 + mm) * 512 : O_KS + ((size_t)layer * 512 + (mm - NTOK_P)) * 512) + (nb - 512);
                else dst = p.out + (pp ? O_VP + ((size_t)layer * 65536 + mm) * 512 : O_VS + ((size_t)layer * 512 + (mm - NTOK_P)) * 512) + (nb - 1024);
                *(float4*)(dst + nt * 32 + ch * 4) = a;
              }
            }
            __builtin_amdgcn_wave_barrier();
          }
        }
      }
    } else if (MODE == 1) {
      const float* bg = p.b_glu + layer * 512;
#pragma unroll
      for (int mt = 0; mt < 2; ++mt) {
        const int m = m0 + wm * 64 + mt * 32 + r;
#pragma unroll
        for (int g = 0; g < 4; ++g) {
          const int col = tn * 64 + wn * 32 + 8 * g + 4 * h;
          float4 bv = *(const float4*)(bg + col), bgt = *(const float4*)(bg + 256 + col);
          u32x2 gb = *(const u32x2*)(p.P + (size_t)m * D_IN + OFF_GB + col);
          float o0 = (acc[mt][0][4 * g] + bv.x) * sigmoidf_(acc[mt][1][4 * g] + bgt.x) * siluf_(bflo(gb.x));
          float o1 = (acc[mt][0][4 * g + 1] + bv.y) * sigmoidf_(acc[mt][1][4 * g + 1] + bgt.y) * siluf_(bfhi(gb.x));
          float o2 = (acc[mt][0][4 * g + 2] + bv.z) * sigmoidf_(acc[mt][1][4 * g + 2] + bgt.z) * siluf_(bflo(gb.y));
          float o3 = (acc[mt][0][4 * g + 3] + bv.w) * sigmoidf_(acc[mt][1][4 * g + 3] + bgt.w) * siluf_(bfhi(gb.y));
          u32x2 o; o.x = pk2(o0, o1); o.y = pk2(o2, o3);
          *(u32x2*)(p.mix + (size_t)m * 1024 + 512 + col) = o;
        }
      }
    } else {
      const float* nw1 = p.norm_w + 1024;
#pragma unroll
      for (int mt = 0; mt < 2; ++mt) {
        const int mb = m0 + wm * 64 + mt * 32;
        float sq[4] = {0.f, 0.f, 0.f, 0.f};
#pragma unroll
        for (int nt = 0; nt < 2; ++nt) {
#pragma unroll
          for (int g = 0; g < 4; ++g)
            *(float4*)(eps + r * 144 + (8 * g + 4 * h) * 4) = make_float4(acc[mt][nt][4 * g], acc[mt][nt][4 * g + 1], acc[mt][nt][4 * g + 2], acc[mt][nt][4 * g + 3]);
          __builtin_amdgcn_wave_barrier();
#pragma unroll
          for (int it = 0; it < 4; ++it) {
            const int row = it * 8 + (lane >> 3), ch = lane & 7;
            const float4 a = *(const float4*)(eps + row * 144 + ch * 16);
            const int mm = mb + row, ncol = n0 + wn * 64 + nt * 32 + ch * 4;
            float4 xv = *(const float4*)(xrow(p, layer, mm) + ncol);
            xv.x += a.x; xv.y += a.y; xv.z += a.z; xv.w += a.w;
            *(float4*)(p.out + (size_t)mm * 1024 + ncol) = xv;
            if (layer == 0) {
              sq[it] += xv.x * xv.x + xv.y * xv.y + xv.z * xv.z + xv.w * xv.w;
              const float4 w4 = *(const float4*)(nw1 + ncol);
              u32x2 o; o.x = pk2(xv.x * w4.x, xv.y * w4.y); o.y = pk2(xv.z * w4.z, xv.w * w4.w);
              *(u32x2*)(p.hbf + (size_t)mm * 1024 + ncol) = o;
            }
          }
          __builtin_amdgcn_wave_barrier();
        }
        if (layer == 0) {
#pragma unroll
          for (int it = 0; it < 4; ++it) {
            const float s = sum8(sq[it]);
            if ((lane & 7) == 0) atomicAdd(p.ssq + mb + it * 8 + (lane >> 3), s);
          }
        }
      }
    }
    zero_acc();
  }
}

constexpr int VS = 66;
DI void attn_item(const Params& p, int layer, int wi, bf16_t* vl) {
  const int lane = TID & 63, r = lane & 31, h = lane >> 5;
  const bool sample = wi >= 16384;
  int b, hd, qt, tok0, qabs0;
  if (!sample) { b = wi >> 9; hd = (wi >> 6) & 7; qt = wi & 63; tok0 = b * 2048; qabs0 = qt * 32; }
  else { int j = wi - 16384; b = j >> 3; hd = j & 7; qt = 0; tok0 = NTOK_P + b * 32; qabs0 = 4096; }
  const int tq0 = tok0 + qt * 32;
  bf16x8 qf[4];
  {
    const bf16_t* qp = p.P + (size_t)(tq0 + r) * D_IN + OFF_Q + hd * 64 + h * 8;
#pragma unroll
    for (int ks = 0; ks < 4; ++ks) qf[ks] = *(const bf16x8*)(qp + ks * 16);
  }
  f32x16 o[2];
#pragma unroll
  for (int d = 0; d < 2; ++d)
#pragma unroll
    for (int i = 0; i < 16; ++i) o[d][i] = 0.f;
  float run = 0.f;
  const int nblk = qabs0 / 32 + 1;
  const int pir = 16 * ((r >> 2) & 1) + 4 * (r >> 3) + (r & 3);
  const float* ck = p.cache_k + ((size_t)(layer * 16 + b) * 4096) * 512 + hd * 64;
  const float* cv = p.cache_v + ((size_t)(layer * 16 + b) * 4096) * 512 + hd * 64;

  for (int kb = nblk - 1; kb >= 0; --kb) {
    const int kp0 = kb * 32;
    const bool fromP = (!sample) || (kb == 128);
    bf16x8 kf[4];
    if (fromP) {
      const int tk = sample ? (tok0 + (kp0 + pir - 4096)) : (tok0 + kp0 + pir);
      const bf16_t* kp = p.P + (size_t)tk * D_IN + OFF_K + hd * 64 + h * 8;
#pragma unroll
      for (int ks = 0; ks < 4; ++ks) kf[ks] = *(const bf16x8*)(kp + ks * 16);
#pragma unroll
      for (int i = 0; i < 4; ++i) {
        const int key = i * 8 + (lane >> 3), dc = lane & 7;
        const int tv = sample ? (tok0 + (kp0 + key - 4096)) : (tok0 + kp0 + key);
        u32x4 v = *(const u32x4*)(p.P + (size_t)tv * D_IN + OFF_V + hd * 64 + dc * 8);
        unsigned* dst = (unsigned*)(vl + key * VS + dc * 8);
        dst[0] = v.x; dst[1] = v.y; dst[2] = v.z; dst[3] = v.w;
      }
    } else {
      const float* kp = ck + (size_t)(kp0 + pir) * 512 + h * 8;
#pragma unroll
      for (int ks = 0; ks < 4; ++ks) {
        float4 a = *(const float4*)(kp + ks * 16), c = *(const float4*)(kp + ks * 16 + 4);
        u32x4 t; t.x = pk2(a.x, a.y); t.y = pk2(a.z, a.w); t.z = pk2(c.x, c.y); t.w = pk2(c.z, c.w);
        kf[ks] = __builtin_bit_cast(bf16x8, t);
      }
#pragma unroll
      for (int i = 0; i < 4; ++i) {
        const int key = i * 8 + (lane >> 3), dc = lane & 7;
        const float* vp = cv + (size_t)(kp0 + key) * 512 + dc * 8;
        float4 a = *(const float4*)vp, c = *(const float4*)(vp + 4);
        unsigned* dst = (unsigned*)(vl + key * VS + dc * 8);
        dst[0] = pk2(a.x, a.y); dst[1] = pk2(a.z, a.w); dst[2] = pk2(c.x, c.y); dst[3] = pk2(c.z, c.w);
      }
    }
    f32x16 st;
#pragma unroll
    for (int i = 0; i < 16; ++i) st[i] = 0.f;
#pragma unroll
    for (int ks = 0; ks < 4; ++ks) st = MFMA(kf[ks], qf[ks], st);
    const bool diag = (kb == nblk - 1);
    float z[16], lk[16], lat[16];
#pragma unroll
    for (int i = 0; i < 16; ++i) {
      z[i] = st[i] * 0.125f;
      const bool msk = (!diag) || (16 * h + i < r);
      const float e = __expf(-fabsf(z[i]));
      const float sp = fmaxf(z[i], 0.f) + __logf(1.f + e);
      lk[i] = msk ? -sp : 0.f;
    }
    float suf = 0.f;
#pragma unroll
    for (int i = 15; i >= 0; --i) { lat[i] = suf; suf += lk[i]; }
    const float other = __shfl_xor(suf, 32);
    const float base = run + (h == 0 ? other : 0.f);
    float a[16];
#pragma unroll
    for (int i = 0; i < 16; ++i) {
      const bool msk = (!diag) || (16 * h + i < r);
      a[i] = msk ? __expf(z[i] + lk[i] + base + lat[i]) : 0.f;
    }
    run += suf + other;
    __builtin_amdgcn_wave_barrier();
#pragma unroll
    for (int s2 = 0; s2 < 2; ++s2) {
      u32x4 t; t.x = pk2(a[8 * s2], a[8 * s2 + 1]); t.y = pk2(a[8 * s2 + 2], a[8 * s2 + 3]); t.z = pk2(a[8 * s2 + 4], a[8 * s2 + 5]); t.w = pk2(a[8 * s2 + 6], a[8 * s2 + 7]);
      const bf16x8 pf = __builtin_bit_cast(bf16x8, t);
#pragma unroll
      for (int dt = 0; dt < 2; ++dt) {
        const bf16_t* vp = vl + (16 * h + 8 * s2) * VS + 32 * dt + r;
        bf16x8 vf;
#pragma unroll
        for (int j = 0; j < 8; ++j) vf[j] = (short)vp[j * VS];
        o[dt] = MFMA(vf, pf, o[dt]);
      }
    }
    __builtin_amdgcn_wave_barrier();
    if (__all(run < -104.f)) break;
  }
  const int tok = tq0 + r;
#pragma unroll
  for (int dt = 0; dt < 2; ++dt)
#pragma unroll
    for (int g = 0; g < 4; ++g) {
      const int d0 = 32 * dt + 8 * g + 4 * h;
      u32x2 ga = *(const u32x2*)(p.P + (size_t)tok * D_IN + OFF_GA + hd * 64 + d0);
      u32x2 ov;
      ov.x = pk2(o[dt][4 * g] * siluf_(bflo(ga.x)), o[dt][4 * g + 1] * siluf_(bfhi(ga.x)));
      ov.y = pk2(o[dt][4 * g + 2] * siluf_(bflo(ga.y)), o[dt][4 * g + 3] * siluf_(bfhi(ga.y)));
      *(u32x2*)(p.mix + (size_t)tok * 1024 + hd * 64 + d0) = ov;
    }
}

constexpr int S5_BU = 8192;
constexpr int S5_LDS = S5_BU + 8704 + 1024;
DI void s5_disc(const Params& p, int lg, int pi, float dt, float& ar, float& ai, float& fr, float& fi) {
  const float lr = fminf(p.lam_re[lg * 64 + pi], -1e-4f), li = p.lam_im[lg * 64 + pi];
  const float er = expf(lr * dt);
  ar = er * cosf(li * dt); ai = er * sinf(li * dt);
  const float den = lr * lr + li * li;
  fr = ((ar - 1.f) * lr + ai * li) / den; fi = (ai * lr - (ar - 1.f) * li) / den;
}
DI void s5_item(const Params& p, int layer, int item, char* lds) {
  float* BU = (float*)lds;
  char* Himg = lds + S5_BU;
  bf16_t* Ub = (bf16_t*)(lds + S5_BU + 8704);
  const int lane = TID & 63, r = lane & 31, h = lane >> 5;
  const int seq = item >> 4, g = item & 15;
  const bool sample = seq >= 32;
  const int b = sample ? seq - 32 : seq, L = sample ? 32 : 2048, tok0 = sample ? NTOK_P + b * 32 : b * 2048;
  const int lg = layer * 16 + g;
  const float dt = expf(p.log_dt[lg]);
  float ar, ai, fr_, fi_;
  s5_disc(p, lg, lane, dt, ar, ai, fr_, fi_);
  bf16x8 bbf[4];
#pragma unroll
  for (int half = 0; half < 2; ++half) {
    const int pi = 32 * half + r;
    float a_r, a_i, f_r, f_i;
    s5_disc(p, lg, pi, dt, a_r, a_i, f_r, f_i);
    const float* brp = p.b_re + ((size_t)lg * 64 + pi) * 16 + 8 * h;
    const float* bip = p.b_im + ((size_t)lg * 64 + pi) * 16 + 8 * h;
    float re[8], im[8];
#pragma unroll
    for (int j = 0; j < 8; ++j) { const float br = brp[j], bi = bip[j]; re[j] = f_r * br - f_i * bi; im[j] = f_r * bi + f_i * br; }
    u32x4 t0, t1;
    t0.x = pk2(re[0], re[1]); t0.y = pk2(re[2], re[3]); t0.z = pk2(re[4], re[5]); t0.w = pk2(re[6], re[7]);
    t1.x = pk2(im[0], im[1]); t1.y = pk2(im[2], im[3]); t1.z = pk2(im[4], im[5]); t1.w = pk2(im[6], im[7]);
    bbf[half] = __builtin_bit_cast(bf16x8, t0);
    bbf[2 + half] = __builtin_bit_cast(bf16x8, t1);
  }
  bf16x8 cf[8];
#pragma unroll
  for (int s = 0; s < 8; ++s) {
    u32x4 t; t.x = 0; t.y = 0; t.z = 0; t.w = 0;
    if (r < 16) {
      const int k0 = 16 * s + 8 * h;
      const float* src = (s < 4 ? p.c_re : p.c_im) + ((size_t)lg * 16 + r) * 64 + (k0 & 63);
      const float sg = s < 4 ? 1.f : -1.f;
      const float4 c0 = *(const float4*)src, c1 = *(const float4*)(src + 4);
      t.x = pk2(sg * c0.x, sg * c0.y); t.y = pk2(sg * c0.z, sg * c0.w); t.z = pk2(sg * c1.x, sg * c1.y); t.w = pk2(sg * c1.z, sg * c1.w);
    }
    cf[s] = __builtin_bit_cast(bf16x8, t);
  }
  const float dl = p.ssm_d[lg * 16 + (r & 15)];
  float hr = 0.f, hi = 0.f;
  if (sample) { hr = p.st_re[((size_t)(layer * 16 + b) * 16 + g) * 64 + lane]; hi = p.st_im[((size_t)(layer * 16 + b) * 16 + g) * 64 + lane]; }
  f32x16 zero;
#pragma unroll
  for (int i = 0; i < 16; ++i) zero[i] = 0.f;
  const bf16_t* upb = p.P + (size_t)(tok0 + r) * D_IN + OFF_U + g * 16 + 8 * h;
  bf16x8 uf = *(const bf16x8*)upb;
  for (int t0 = 0; t0 < L; t0 += 32) {
    const bf16x8 ucur = uf;
    if (t0 + 32 < L) uf = *(const bf16x8*)(upb + (size_t)(t0 + 32) * D_IN);
    *(bf16x8*)(Ub + r * 16 + 8 * h) = ucur;
    f32x16 d[4];
#pragma unroll
    for (int tile = 0; tile < 4; ++tile) d[tile] = MFMA(ucur, bbf[tile], zero);
#pragma unroll
    for (int hf = 0; hf < 2; ++hf) {
#pragma unroll
      for (int tile = 0; tile < 4; ++tile)
#pragma unroll
        for (int i = 0; i < 8; ++i) BU[((i & 3) + 8 * (i >> 2) + 4 * h) * 128 + 32 * tile + r] = d[tile][8 * hf + i];
      __builtin_amdgcn_wave_barrier();
#pragma unroll
      for (int tt = 0; tt < 16; ++tt) {
        const int t = 16 * hf + tt;
        const float bur = BU[tt * 128 + lane], bui = BU[tt * 128 + 64 + lane];
        const float nhr = ar * hr - ai * hi + bur, nhi = ar * hi + ai * hr + bui;
        hr = nhr; hi = nhi;
        *(bf16_t*)(Himg + t * 272 + lane * 2) = (bf16_t)f2bf(hr);
        *(bf16_t*)(Himg + t * 272 + 128 + lane * 2) = (bf16_t)f2bf(hi);
      }
      __builtin_amdgcn_wave_barrier();
    }
    f32x16 yacc = zero;
#pragma unroll
    for (int s = 0; s < 8; ++s) {
      const bf16x8 af = *(const bf16x8*)(Himg + r * 272 + s * 32 + h * 16);
      yacc = MFMA(af, cf[s], yacc);
    }
    if (r < 16) {
#pragma unroll
      for (int i = 0; i < 16; ++i) {
        const int t = (i & 3) + 8 * (i >> 2) + 4 * h;
        const float yv = yacc[i] + dl * bf2f(Ub[t * 16 + r]);
        const float gl = yv / (1.f + __expf(-1.5957691216f * (yv + 0.044715f * yv * yv * yv)));
        p.yb[(size_t)(tok0 + t0 + t) * 256 + g * 16 + r] = (bf16_t)f2bf(gl);
      }
    }
    __builtin_amdgcn_wave_barrier();
  }
  float* ore = p.out + (sample ? O_SRES : O_SREP) + ((size_t)(layer * (sample ? 16 : 32) + b) * 16 + g) * 64 + lane;
  float* oim = p.out + (sample ? O_SIMS : O_SIMP) + ((size_t)(layer * (sample ? 16 : 32) + b) * 16 + g) * 64 + lane;
  *ore = hr; *oim = hi;
}

DI void rwkv_item(const Params& p, int layer, int item, char* smem) {
  constexpr int SETF = 6 * 2048;
  float* SET0 = (float*)smem;
  float* YB = SET0 + 2 * SETF;
  char* PW = (char*)(YB + 2 * 2048);
  const int tid = TID, lane = tid & 63, wv = tid >> 6;
  const int seq = item >> 2, hd = item & 3;
  const bool sample = seq >= 32;
  const int b = sample ? seq - 32 : seq, L = sample ? 32 : 2048, tok0 = sample ? NTOK_P + b * 32 : b * 2048;
  const int nch = L >> 5;
  if (wv < 4) {
    const int rp = tid >> 3, kq = tid & 7;
    f32x2 S0[4], S1[4];
    if (sample) {
      const float* sp = p.st_wkv + (((size_t)(layer * 16 + b) * 4 + hd) * 64 + rp) * 64 + kq * 8;
#pragma unroll
      for (int j = 0; j < 4; ++j) { S0[j].x = sp[2 * j]; S0[j].y = sp[2 * j + 1]; S1[j].x = sp[2048 + 2 * j]; S1[j].y = sp[2048 + 2 * j + 1]; }
    } else {
#pragma unroll
      for (int j = 0; j < 4; ++j) { S0[j].x = 0.f; S0[j].y = 0.f; S1[j].x = 0.f; S1[j].y = 0.f; }
    }
    lds_barrier();
    for (int c = 0; c < nch; ++c) {
      const float* R = SET0 + (c & 1) * SETF; const float* W = R + 2048; const float* KT = W + 2048; const float* KH = KT + 2048;
      const float* BB = KH + 2048; const float* V = BB + 2048;
      float* Y = YB + (c & 1) * 2048;
      float yk0[4], yk1[4];
      float4 nkh0, nkh1, nw0, nw1, nb0, nb1, nk0, nk1, nr0, nr1; float nv0, nv1;
      {
        const int o = kq * 8;
        nkh0 = *(const float4*)(KH + o); nkh1 = *(const float4*)(KH + o + 4); nw0 = *(const float4*)(W + o); nw1 = *(const float4*)(W + o + 4);
        nb0 = *(const float4*)(BB + o); nb1 = *(const float4*)(BB + o + 4); nk0 = *(const float4*)(KT + o); nk1 = *(const float4*)(KT + o + 4);
        nr0 = *(const float4*)(R + o); nr1 = *(const float4*)(R + o + 4); nv0 = V[rp]; nv1 = V[rp + 32];
      }
#pragma unroll
      for (int q = 0; q < 4; ++q) {
        yk0[q] = 0.f; yk1[q] = 0.f;
#pragma unroll
        for (int e = 0; e < 8; ++e) {
          const int tl = q * 8 + e;
          const float4 kh0 = nkh0, kh1 = nkh1, w0_ = nw0, w1_ = nw1, b0 = nb0, b1 = nb1, k0 = nk0, k1 = nk1, r0 = nr0, r1 = nr1;
          const float va = nv0, vb = nv1;
          if (tl < 31) {
            const int o = (tl + 1) * 64 + kq * 8;
            nkh0 = *(const float4*)(KH + o); nkh1 = *(const float4*)(KH + o + 4); nw0 = *(const float4*)(W + o); nw1 = *(const float4*)(W + o + 4);
            nb0 = *(const float4*)(BB + o); nb1 = *(const float4*)(BB + o + 4); nk0 = *(const float4*)(KT + o); nk1 = *(const float4*)(KT + o + 4);
            nr0 = *(const float4*)(R + o); nr1 = *(const float4*)(R + o + 4); nv0 = V[(tl + 1) * 64 + rp]; nv1 = V[(tl + 1) * 64 + rp + 32];
          }
          const f32x2 khv[4] = {{kh0.x, kh0.y}, {kh0.z, kh0.w}, {kh1.x, kh1.y}, {kh1.z, kh1.w}};
          const f32x2 wvv[4] = {{w0_.x, w0_.y}, {w0_.z, w0_.w}, {w1_.x, w1_.y}, {w1_.z, w1_.w}};
          const f32x2 bv[4] = {{b0.x, b0.y}, {b0.z, b0.w}, {b1.x, b1.y}, {b1.z, b1.w}};
          const f32x2 kv[4] = {{k0.x, k0.y}, {k0.z, k0.w}, {k1.x, k1.y}, {k1.z, k1.w}};
          const f32x2 rv[4] = {{r0.x, r0.y}, {r0.z, r0.w}, {r1.x, r1.y}, {r1.z, r1.w}};
          const f32x2 va2 = {va, va}, vb2 = {vb, vb};
          f32x2 ma[4], mb[4];
#pragma unroll
          for (int j = 0; j < 4; ++j) { ma[j] = fma2(S0[j], wvv[j], va2 * kv[j]); mb[j] = fma2(S1[j], wvv[j], vb2 * kv[j]); }
          f32x2 sa2 = fma2(S0[1], khv[1], S0[0] * khv[0]) + fma2(S0[3], khv[3], S0[2] * khv[2]);
          f32x2 sb2 = fma2(S1[1], khv[1], S1[0] * khv[0]) + fma2(S1[3], khv[3], S1[2] * khv[2]);
          const float sa = sum8(sa2.x + sa2.y), sb = sum8(sb2.x + sb2.y);
          const f32x2 nsa = {-sa, -sa}, nsb = {-sb, -sb};
#pragma unroll
          for (int j = 0; j < 4; ++j) { S0[j] = fma2(nsa, bv[j], ma[j]); S1[j] = fma2(nsb, bv[j], mb[j]); }
          f32x2 ya2 = fma2(S0[1], rv[1], S0[0] * rv[0]) + fma2(S0[3], rv[3], S0[2] * rv[2]);
          f32x2 yb2 = fma2(S1[1], rv[1], S1[0] * rv[0]) + fma2(S1[3], rv[3], S1[2] * rv[2]);
          const float ya = sum8(ya2.x + ya2.y), ybv = sum8(yb2.x + yb2.y);
          yk0[q] = (e == kq) ? ya : yk0[q];
          yk1[q] = (e == kq) ? ybv : yk1[q];
        }
      }
#pragma unroll
      for (int q = 0; q < 4; ++q) { Y[(q * 8 + kq) * 64 + rp] = yk0[q]; Y[(q * 8 + kq) * 64 + rp + 32] = yk1[q]; }
      lds_barrier();
    }
    float* so = p.out + (sample ? O_WKVS : O_WKVP) + (((size_t)(layer * (sample ? 16 : 32) + b) * 4 + hd) * 64 + rp) * 64 + kq * 8;
    *(float4*)so = make_float4(S0[0].x, S0[0].y, S0[1].x, S0[1].y);
    *(float4*)(so + 4) = make_float4(S0[2].x, S0[2].y, S0[3].x, S0[3].y);
    *(float4*)(so + 2048) = make_float4(S1[0].x, S1[0].y, S1[1].x, S1[1].y);
    *(float4*)(so + 2052) = make_float4(S1[2].x, S1[2].y, S1[3].x, S1[3].y);
  } else {
    const int pw = wv - 4, r_ = lane & 31, h_ = lane >> 5;
    const int cg_ = hd * 64 + lane;
    bf16_t* LORAb = (bf16_t*)(PW + pw * 5248);
    float* DSA = (float*)(PW + pw * 5248 + 1152);
    bf16x8 lb[2][2][2];
#pragma unroll
    for (int ll = 0; ll < 2; ++ll)
#pragma unroll
      for (int nn = 0; nn < 2; ++nn) {
        const float* srcw = (ll ? p.a2 : p.w2) + (size_t)layer * 32 * 256 + hd * 64 + 32 * nn + r_;
#pragma unroll
        for (int s = 0; s < 2; ++s) {
          float t[8];
#pragma unroll
          for (int j = 0; j < 8; ++j) t[j] = srcw[(size_t)(16 * s + 8 * h_ + j) * 256];
          u32x4 u; u.x = pk2(t[0], t[1]); u.y = pk2(t[2], t[3]); u.z = pk2(t[4], t[5]); u.w = pk2(t[6], t[7]);
          lb[ll][nn][s] = __builtin_bit_cast(bf16x8, u);
        }
      }
    const float w0c = p.w0[layer * 256 + cg_], a0c = p.a0[layer * 256 + cg_], kkc = p.k_k[layer * 256 + cg_], kac = p.k_a[layer * 256 + cg_];
    const float ubc = p.u_bonus[layer * 256 + cg_], lnw = p.ln_w[layer * 256 + cg_], lnb = p.ln_b[layer * 256 + cg_];
    const float* mu = p.mu + layer * 832;
    const float mu_r = mu[cg_], mu_k = mu[256 + cg_], mu_v = mu[512 + cg_], mu_l = mu[768 + lane];
    const float* shp = p.st_shift + (size_t)(layer * 16 + b) * 832;
    auto pre = [&](int c, float (&xvk)[8], float (&bonk)[8], float (&gtk)[8]) {
      float* R = SET0 + (c & 1) * SETF; float* W = R + 2048; float* KT = W + 2048; float* KH = KT + 2048; float* BB = KH + 2048; float* V = BB + 2048;
      const bf16_t* base = p.P + (size_t)(tok0 + c * 32 + 8 * pw) * D_IN + OFF_C;
      bf16_t cr[8], ck[8], cv[8], cl[8], cgt[8];
#pragma unroll
      for (int i = 0; i < 8; ++i) {
        const bf16_t* cp = base + (size_t)i * D_IN;
        cr[i] = cp[cg_]; ck[i] = cp[256 + cg_]; cv[i] = cp[512 + cg_]; cl[i] = cp[768 + lane]; cgt[i] = cp[OFF_GC - OFF_C + cg_];
      }
      float pr, pk, pv, pl;
      if (c * 32 + 8 * pw == 0) {
        if (sample) { pr = shp[cg_]; pk = shp[256 + cg_]; pv = shp[512 + cg_]; pl = shp[768 + lane]; }
        else { pr = 0.f; pk = 0.f; pv = 0.f; pl = 0.f; }
      } else {
        const bf16_t* pp = base - D_IN;
        pr = bf2f(pp[cg_]); pk = bf2f(pp[256 + cg_]); pv = bf2f(pp[512 + cg_]); pl = bf2f(pp[768 + lane]);
      }
      float xr_[8], xk_[8];
#pragma unroll
      for (int i = 0; i < 8; ++i) {
        const float c_r = bf2f(cr[i]), c_k = bf2f(ck[i]), c_v = bf2f(cv[i]), c_l = bf2f(cl[i]);
        xr_[i] = c_r + mu_r * (pr - c_r); xk_[i] = c_k + mu_k * (pk - c_k); xvk[i] = c_v + mu_v * (pv - c_v);
        const float xl = c_l + mu_l * (pl - c_l);
        pr = c_r; pk = c_k; pv = c_v; pl = c_l;
        gtk[i] = bf2f(cgt[i]);
        LORAb[i * 72 + lane] = (bf16_t)f2bf(lane < 32 ? fast_tanh(xl) : xl);
      }
      __builtin_amdgcn_wave_barrier();
#pragma unroll
      for (int ll = 0; ll < 2; ++ll) {
        const bf16x8 af0 = *(const bf16x8*)((const char*)LORAb + (r_ & 7) * 144 + ll * 64 + h_ * 16);
        const bf16x8 af1 = *(const bf16x8*)((const char*)LORAb + (r_ & 7) * 144 + ll * 64 + 32 + h_ * 16);
#pragma unroll
        for (int nn = 0; nn < 2; ++nn) {
          f32x16 dacc;
#pragma unroll
          for (int i = 0; i < 16; ++i) dacc[i] = 0.f;
          dacc = MFMA(af0, lb[ll][nn][0], dacc);
          dacc = MFMA(af1, lb[ll][nn][1], dacc);
#pragma unroll
          for (int i = 0; i < 4; ++i) DSA[ll * 512 + (i + 4 * h_) * 64 + 32 * nn + r_] = dacc[i];
        }
      }
      __builtin_amdgcn_wave_barrier();
#pragma unroll
      for (int i = 0; i < 8; ++i) {
        const int tl = 8 * pw + i;
        const float dsum = w0c + DSA[i * 64 + lane], asum = a0c + DSA[512 + i * 64 + lane];
        const float dec = __expf(-0.6065306597f * sigmoidf_(dsum));
        const float a = sigmoidf_(asum);
        const float kk = xk_[i] * kkc;
        const float ss = wave_sum(kk * kk);
        const float kh = kk * rsqrtf(ss + 1e-12f);
        const float kt = xk_[i] * (1.f + (a - 1.f) * kac);
        bonk[i] = wave_sum(xr_[i] * kt * ubc);
        R[tl * 64 + lane] = xr_[i]; W[tl * 64 + lane] = dec; KT[tl * 64 + lane] = kt; KH[tl * 64 + lane] = kh; BB[tl * 64 + lane] = a * kh; V[tl * 64 + lane] = xvk[i];
      }
      __builtin_amdgcn_wave_barrier();
    };
    auto post = [&](int c, const float (&xvk)[8], const float (&bonk)[8], const float (&gtk)[8]) {
      const float* Y = YB + (c & 1) * 2048;
#pragma unroll
      for (int i = 0; i < 8; ++i) {
        const int tl = 8 * pw + i;
        const float y = Y[tl * 64 + lane];
        const float mean = wave_sum(y) * (1.f / 64.f);
        const float msq = wave_sum(y * y) * (1.f / 64.f);
        const float var = fmaxf(msq - mean * mean, 0.f);
        float yn = (y - mean) * rsqrtf(var + 64e-5f) * lnw + lnb;
        yn += bonk[i] * xvk[i];
        p.mix[(size_t)(tok0 + c * 32 + tl) * 1024 + 768 + cg_] = (bf16_t)f2bf(yn * siluf_(gtk[i]));
      }
    };
    float xvA[8], bonA[8], gtA[8], xvB[8], bonB[8], gtB[8];
#pragma unroll
    for (int i = 0; i < 8; ++i) { xvB[i] = 0.f; bonB[i] = 0.f; gtB[i] = 0.f; }
    pre(0, xvA, bonA, gtA);
    lds_barrier();
    for (int c = 0; c < nch; c += 2) {
      if (c >= 1) post(c - 1, xvB, bonB, gtB);
      if (c + 1 < nch) pre(c + 1, xvB, bonB, gtB);
      lds_barrier();
      if (c + 1 < nch) {
        post(c, xvA, bonA, gtA);
        if (c + 2 < nch) pre(c + 2, xvA, bonA, gtA);
        lds_barrier();
      }
    }
    if ((nch - 1) & 1) post(nch - 1, xvB, bonB, gtB); else post(nch - 1, xvA, bonA, gtA);
  }
  lds_barrier();
}

constexpr int ATT_LDS0 = 6 * S5_LDS;
DI void phase_mixers(const Params& p, int layer, char* smem, int cofs) {
  const int G = GDIM, bid = BID, half = G / 2;
  const int tid = TID, wv = tid >> 6, lane = tid & 63;
  if (bid < half) {
    for (int item = bid; item < 128; item += half) rwkv_item(p, layer, item, smem);
  } else {
    const int j = bid - half, nb2 = G - half;
    for (int item = 128 + j; item < 192; item += nb2) rwkv_item(p, layer, item, smem);
    if (wv < 6) { for (int it = j * 6 + wv; it < 768; it += nb2 * 6) s5_item(p, layer, it, smem + wv * S5_LDS); }
  }
  unsigned* ctr = p.counters + layer + cofs;
  bf16_t* vl = (bf16_t*)(smem + ATT_LDS0) + wv * (32 * VS);
  while (true) {
    int it = 0;
    if (lane == 0) it = (int)atomicAdd(ctr, 1u);
    it = __builtin_amdgcn_readfirstlane(it);
    if (it >= 16512) break;
    attn_item(p, layer, it, vl);
  }
}

__global__ void __launch_bounds__(NT) mega(Params p) {
  __shared__ __attribute__((aligned(16))) char smem[SMEM_BYTES];
  cg::grid_group grid = cg::this_grid();
  phase_weights(p, smem);
  phase_norm(p, 0);
  grid.sync();
  for (int layer = 0; layer < 2; ++layer) {
    gemm_phase<0>(p, layer, smem);
    grid.sync();
#if PROBE_GEMM0
    gemm_phase<0>(p, layer, smem);
    grid.sync();
#endif
    phase_mixers(p, layer, smem, 0);
    grid.sync();
#if PROBE_MIX
    phase_mixers(p, layer, smem, 2);
    grid.sync();
#endif
    gemm_phase<1>(p, layer, smem);
    grid.sync();
    gemm_phase<2>(p, layer, smem);
    if (layer == 0) grid.sync();
  }
}

#if MULTI_LAUNCH
template <int PH>
__global__ void __launch_bounds__(NT) phase_kernel(Params p, int layer) {
  __shared__ __attribute__((aligned(16))) char smem[SMEM_BYTES];
  if (PH == 0) { phase_weights(p, smem); }
  else if (PH == 1) phase_norm(p, layer);
  else if (PH == 2) gemm_phase<0>(p, layer, smem);
  else if (PH == 3) phase_mixers(p, layer, smem, 0);
  else if (PH == 4) gemm_phase<1>(p, layer, smem);
  else gemm_phase<2>(p, layer, smem);
}
#endif

extern "C" void kernel_launch(void* const* d_in, const int* in_sizes, int n_in, void* d_out, int out_size, void* d_ws, size_t ws_size, hipStream_t stream) {
  Params p{};
  const float** f = (const float**)&p;
  for (int i = 0; i < 33; ++i) f[i] = (const float*)d_in[i];
  p.out = (float*)d_out;
  char* ws = (char*)d_ws;
  size_t off = 0;
  auto take = [&](size_t bytes) { char* q = ws + off; off += (bytes + 255) & ~(size_t)255; return q; };
  p.WinT = (bf16_t*)take((size_t)2 * 3648 * 1024 * 2);
  p.WoutT = (bf16_t*)take((size_t)2 * 1024 * 1024 * 2);
  p.WgluT = (bf16_t*)take((size_t)2 * 512 * 256 * 2);
  p.hbf = (bf16_t*)take((size_t)NTOK * 1024 * 2);
  p.P = (bf16_t*)take((size_t)NTOK * D_IN * 2);
  p.mix = (bf16_t*)take((size_t)NTOK * 1024 * 2);
  p.yb = (bf16_t*)take((size_t)NTOK * 256 * 2);
  p.counters = (unsigned*)take(256);
  p.ssq = (float*)take((size_t)NTOK * 4);
  if (off > ws_size || (size_t)out_size != O_END || n_in != 33) fprintf(stderr, "kernel_launch: unexpected sizes ws=%zu need=%zu out=%d n_in=%d\n", ws_size, off, out_size, n_in);
#if MULTI_LAUNCH
  const int G = 256;
  phase_kernel<0><<<G, NT, 0, stream>>>(p, 0);
  for (int layer = 0; layer < 2; ++layer) {
    phase_kernel<1><<<G, NT, 0, stream>>>(p, layer);
    phase_kernel<2><<<G, NT, 0, stream>>>(p, layer);
    phase_kernel<3><<<G, NT, 0, stream>>>(p, layer);
    phase_kernel<4><<<G, NT, 0, stream>>>(p, layer);
    phase_kernel<5><<<G, NT, 0, stream>>>(p, layer);
  }
#else
  static int grid_blocks = 0;
  if (!grid_blocks) {
    int dev = 0, cus = 0, per_cu = 0;
    hipGetDevice(&dev);
    hipDeviceGetAttribute(&cus, hipDeviceAttributeMultiprocessorCount, dev);
    hipOccupancyMaxActiveBlocksPerMultiprocessor(&per_cu, mega, NT, 0);
    if (per_cu < 1) per_cu = 1;
    grid_blocks = cus * per_cu;
  }
  void* args[] = {&p};
  hipError_t e = hipLaunchCooperativeKernel((void*)mega, dim3(grid_blocks), dim3(NT), args, 0, stream);
  if (e != hipSuccess) fprintf(stderr, "cooperative launch failed: %s (grid %d)\n", hipGetErrorString(e), grid_blocks);
#endif
}
```

```cpp
#include <hip/hip_runtime.h>
#include <hip/hip_cooperative_groups.h>
#include <cstdio>
namespace cg = cooperative_groups;

#define PROBE_GEMM0 0
#define PROBE_MIX 0
#ifndef MULTI_LAUNCH
#define MULTI_LAUNCH 0
#endif

#define DI __device__ __forceinline__
typedef unsigned short bf16_t;
typedef short bf16x8 __attribute__((ext_vector_type(8)));
typedef float f32x16 __attribute__((ext_vector_type(16)));
typedef unsigned u32x4 __attribute__((ext_vector_type(4)));
typedef unsigned u32x2 __attribute__((ext_vector_type(2)));
#define MFMA(a, b, c) __builtin_amdgcn_mfma_f32_32x32x16_bf16((a), (b), (c), 0, 0, 0)

constexpr int NT = 512;
constexpr int NTOK_P = 65536, NTOK = 66048, D_IN = 3648;
constexpr int OFF_Q = 0, OFF_K = 512, OFF_V = 1024, OFF_GA = 1536, OFF_U = 2048, OFF_GB = 2304, OFF_C = 2560, OFF_GC = 3392;
constexpr size_t O_Y = 0, O_KP = 67633152, O_VP = 134742016, O_SREP = 201850880, O_SIMP = 201916416, O_WKVP = 201981952,
                 O_SHP = 203030528, O_KS = 203083776, O_VS = 203608064, O_SRES = 204132352, O_SIMS = 204165120,
                 O_WKVS = 204197888, O_SHS = 204722176, O_END = 204748800;
constexpr int SMEM_BYTES = 2 * 55296 + 8 * 4608;
constexpr int LDS_ROW = 144;
constexpr int STAGE = (256 + 128) * LDS_ROW;

struct Params {
  const float *x_prompt, *x_sample, *cache_k, *cache_v, *st_re, *st_im, *st_wkv, *st_shift;
  const float *norm_w, *w_in, *q_norm_w, *k_norm_w, *lam_re, *lam_im, *log_dt, *b_re, *b_im, *c_re, *c_im, *ssm_d, *w_glu, *b_glu;
  const float *mu, *w0, *w2, *a0, *a2, *k_k, *k_a, *u_bonus, *ln_w, *ln_b, *w_out;
  float* out;
  bf16_t *WinT, *WoutT, *WgluT, *hbf, *P, *mix, *yb;
  unsigned* counters;
  float* ssq;
};

DI int opq_v(int x) { asm volatile("" : "+v"(x)); return x; }
DI int opq_s(int x) { asm volatile("" : "+s"(x)); return x; }
#define TID opq_v((int)threadIdx.x)
#define BID opq_s((int)blockIdx.x)
#define GDIM opq_s((int)gridDim.x)
DI unsigned f2bf(float x) { unsigned u = __float_as_uint(x); u += 0x7fffu + ((u >> 16) & 1u); return u >> 16; }
DI unsigned pk2(float a, float b) { return f2bf(a) | (f2bf(b) << 16); }
DI float bf2f(unsigned v) { return __uint_as_float(v << 16); }
DI float bflo(unsigned w) { return __uint_as_float(w << 16); }
DI float bfhi(unsigned w) { return __uint_as_float(w & 0xffff0000u); }
DI float sigmoidf_(float x) { return 1.f / (1.f + __expf(-x)); }
DI float siluf_(float x) { return x / (1.f + __expf(-x)); }
typedef float f32x2 __attribute__((ext_vector_type(2)));
DI f32x2 fma2(f32x2 a, f32x2 b, f32x2 c) { return __builtin_elementwise_fma(a, b, c); }
template <int CTRL> DI float dpp_mov(float x) { return __int_as_float(__builtin_amdgcn_update_dpp(0, __float_as_int(x), CTRL, 0xF, 0xF, true)); }
DI float sum8(float x) { x += dpp_mov<0xB1>(x); x += dpp_mov<0x4E>(x); x += dpp_mov<0x141>(x); return x; }
DI float fast_tanh(float x) { return 1.f - 2.f / (1.f + __expf(2.f * x)); }
DI void lds_barrier() { asm volatile("s_waitcnt lgkmcnt(0)\n\ts_barrier" ::: "memory"); }
DI float wave_sum(float v) {
  v += dpp_mov<0xB1>(v); v += dpp_mov<0x4E>(v); v += dpp_mov<0x141>(v); v += dpp_mov<0x140>(v);
  v += __int_as_float(__builtin_amdgcn_update_dpp(0, __float_as_int(v), 0x142, 0xA, 0xF, false));
  v += __int_as_float(__builtin_amdgcn_update_dpp(0, __float_as_int(v), 0x143, 0xC, 0xF, false));
  return __int_as_float(__builtin_amdgcn_readlane(__float_as_int(v), 63));
}
DI const float* xrow(const Params& p, int layer, int row) {
  if (layer == 0) return row < NTOK_P ? p.x_prompt + (size_t)row * 1024 : p.x_sample + (size_t)(row - NTOK_P) * 1024;
  return p.out + (size_t)row * 1024;
}

DI void transpose_tile(const float* __restrict__ src, int K, int N, bf16_t* __restrict__ dst, int k0, int n0, float* tile) {
  const int tid = TID;
#pragma unroll
  for (int i = 0; i < 8; ++i) { int idx = tid + NT * i; int kk = idx >> 6, nn = idx & 63; tile[kk * 65 + nn] = src[(size_t)(k0 + kk) * N + n0 + nn]; }
  __syncthreads();
#pragma unroll
  for (int i = 0; i < 8; ++i) { int idx = tid + NT * i; int nn = idx >> 6, kk = idx & 63; dst[(size_t)(n0 + nn) * K + k0 + kk] = (bf16_t)f2bf(tile[kk * 65 + nn]); }
  __syncthreads();
}
DI void phase_weights(const Params& p, char* smem) {
  float* tile = (float*)smem;
  const int bid = BID, gdim = GDIM;
  for (int t = bid; t < 2400; t += gdim) {
    int layer = t / 1200, j = t % 1200;
    if (j < 912) { int kt = j / 57, nt = j % 57; transpose_tile(p.w_in + (size_t)layer * 1024 * 3648, 1024, 3648, p.WinT + (size_t)layer * 3648 * 1024, kt * 64, nt * 64, tile); }
    else if (j < 1168) { j -= 912; int kt = j / 16, nt = j % 16; transpose_tile(p.w_out + (size_t)layer * 1024 * 1024, 1024, 1024, p.WoutT + (size_t)layer * 1024 * 1024, kt * 64, nt * 64, tile); }
    else { j -= 1168; int kt = j / 8, nt = j % 8; transpose_tile(p.w_glu + (size_t)layer * 256 * 512, 256, 512, p.WgluT + (size_t)layer * 512 * 256, kt * 64, nt * 64, tile); }
  }
  { const int tid = TID; if (bid == 0 && tid < 64) p.counters[tid] = 0;
    for (int i = bid * NT + tid; i < NTOK; i += gdim * NT) p.ssq[i] = 0.f; }
}

DI void phase_norm(const Params& p, int layer) {
  const int tid = TID, lane = tid & 63, w = tid >> 6;
  const int bid = BID, gdim = GDIM;
  const float* nw = p.norm_w + layer * 1024;
  const int stride = gdim * 8;
  for (int row0 = bid * 8 + w; row0 < NTOK; row0 += 2 * stride) {
    const int row1 = row0 + stride;
    const bool has1 = row1 < NTOK;
    const float* x0 = xrow(p, layer, row0);
    const float* x1 = xrow(p, layer, has1 ? row1 : row0);
    float4 v0[4], v1[4]; float s0 = 0.f, s1 = 0.f;
#pragma unroll
    for (int i = 0; i < 4; ++i) { v0[i] = *(const float4*)(x0 + i * 256 + lane * 4); v1[i] = *(const float4*)(x1 + i * 256 + lane * 4); }
#pragma unroll
    for (int i = 0; i < 4; ++i) {
      s0 += v0[i].x * v0[i].x + v0[i].y * v0[i].y + v0[i].z * v0[i].z + v0[i].w * v0[i].w;
      s1 += v1[i].x * v1[i].x + v1[i].y * v1[i].y + v1[i].z * v1[i].z + v1[i].w * v1[i].w;
    }
    s0 = wave_sum(s0); s1 = wave_sum(s1);
    const float c0 = rsqrtf(s0 * (1.f / 1024.f) + 1e-6f), c1 = rsqrtf(s1 * (1.f / 1024.f) + 1e-6f);
#pragma unroll
    for (int i = 0; i < 4; ++i) {
      float4 wv = *(const float4*)(nw + i * 256 + lane * 4);
      u32x2 o; o.x = pk2(v0[i].x * c0 * wv.x, v0[i].y * c0 * wv.y); o.y = pk2(v0[i].z * c0 * wv.z, v0[i].w * c0 * wv.w);
      *(u32x2*)(p.hbf + (size_t)row0 * 1024 + i * 256 + lane * 4) = o;
      if (has1) {
        u32x2 o1; o1.x = pk2(v1[i].x * c1 * wv.x, v1[i].y * c1 * wv.y); o1.y = pk2(v1[i].z * c1 * wv.z, v1[i].w * c1 * wv.w);
        *(u32x2*)(p.hbf + (size_t)row1 * 1024 + i * 256 + lane * 4) = o1;
      }
    }
  }
}

template <int MODE>
DI void gemm_phase(const Params& p, int layer, char* smem) {
  constexpr int K = (MODE == 1) ? 256 : 1024;
  constexpr int NTN = (MODE == 0) ? 29 : (MODE == 1 ? 4 : 8);
  constexpr int KT = K / 64;
  const bf16_t* __restrict__ A = MODE == 0 ? p.hbf : (MODE == 1 ? p.yb : p.mix);
  const bf16_t* __restrict__ Bt = MODE == 0 ? p.WinT + (size_t)layer * 3648 * 1024 : (MODE == 1 ? p.WgluT + (size_t)layer * 512 * 256 : p.WoutT + (size_t)layer * 1024 * 1024);
  const int tid = TID, lane = tid & 63, wv = tid >> 6, r = lane & 31, h = lane >> 5;
  const int wm = wv >> 1, wn = wv & 1;
  const int bid = BID, gdim = GDIM;
  const int xcd = bid & 7, jb = bid >> 3, nbx = (gdim - xcd + 7) >> 3;

  const int total_x = ((258 - xcd + 7) >> 3) * NTN;
  const int nmine = jb < total_x ? (total_x - jb + nbx - 1) / nbx : 0;
  if (nmine == 0) return;
  const int lrow = tid >> 3, kc = tid & 7;
  const int ntm_x = (258 - xcd + 7) >> 3;
  auto decode = [&](int idx, int& tmi_o, int& tn_o) {
    constexpr int QW = 4 * NTN;
    const int nfull = ntm_x >> 2, remw = ntm_x & 3;
    const int quad = idx / QW;
    if (quad < nfull) { const int rem = idx - quad * QW; tn_o = rem >> 2; tmi_o = quad * 4 + (rem & 3); }
    else { const int rem = idx - nfull * QW; tn_o = rem / remw; tmi_o = nfull * 4 + rem % remw; }
  };
  auto set_ptrs = [&](int idx, const bf16_t* (&ap)[4], const bf16_t* (&bp)[2]) {
    int tmi_, tn_; decode(idx, tmi_, tn_);
    const int m0_ = (xcd + 8 * tmi_) * 256, n0_ = tn_ * 128;
#pragma unroll
    for (int i = 0; i < 4; ++i) ap[i] = A + (size_t)(m0_ + lrow + 64 * i) * K + kc * 8;
#pragma unroll
    for (int i = 0; i < 2; ++i) {
      int row = lrow + 64 * i, brow;
      if (MODE == 0) { brow = n0_ + row; brow = brow < 3648 ? brow : 3647; }
      else if (MODE == 2) brow = n0_ + row;
      else { int wn_ = row >> 6, nt_ = (row >> 5) & 1, c_ = row & 31; brow = nt_ * 256 + tn_ * 64 + wn_ * 32 + c_; }
      bp[i] = Bt + (size_t)brow * K + kc * 8;
    }
  };
  f32x16 acc[2][2];
  auto zero_acc = [&]() {
#pragma unroll
    for (int a = 0; a < 2; ++a)
#pragma unroll
      for (int b = 0; b < 2; ++b)
#pragma unroll
        for (int i = 0; i < 16; ++i) acc[a][b][i] = 0.f;
  };
  auto compute = [&](const char* buf, char* nbuf, const u32x4 (&pa)[4], const u32x4 (&pb)[2]) {
    const char* As = buf; const char* Bs = buf + 256 * LDS_ROW;
    char* An = nbuf; char* Bn = nbuf + 256 * LDS_ROW;
    __builtin_amdgcn_iglp_opt(0);
#pragma unroll
    for (int s = 0; s < 4; ++s) {
      bf16x8 af[2], bfr[2];
#pragma unroll
      for (int mt = 0; mt < 2; ++mt) af[mt] = *(const bf16x8*)(As + (wm * 64 + mt * 32 + r) * LDS_ROW + s * 32 + h * 16);
#pragma unroll
      for (int nt = 0; nt < 2; ++nt) bfr[nt] = *(const bf16x8*)(Bs + (wn * 64 + nt * 32 + r) * LDS_ROW + s * 32 + h * 16);
#pragma unroll
      for (int mt = 0; mt < 2; ++mt)
#pragma unroll
        for (int nt = 0; nt < 2; ++nt) acc[mt][nt] = MFMA(bfr[nt], af[mt], acc[mt][nt]);
      if (s < 2) {
        *(u32x4*)(An + (lrow + 64 * (2 * s)) * LDS_ROW + kc * 16) = pa[2 * s];
        *(u32x4*)(An + (lrow + 64 * (2 * s + 1)) * LDS_ROW + kc * 16) = pa[2 * s + 1];
      } else {
        *(u32x4*)(Bn + (lrow + 64 * (s - 2)) * LDS_ROW + kc * 16) = pb[s - 2];
      }
    }
  };
  u32x4 sa[4][4], sb[4][2];
  const bf16_t* cap[4]; const bf16_t* cbp[2]; const bf16_t* nap[4]; const bf16_t* nbp[2];
  set_ptrs(jb, cap, cbp);
#pragma unroll
  for (int j = 0; j < 4; ++j) {
#pragma unroll
    for (int i = 0; i < 4; ++i) sa[j][i] = *(const u32x4*)(cap[i] + j * 64);
#pragma unroll
    for (int i = 0; i < 2; ++i) sb[j][i] = *(const u32x4*)(cbp[i] + j * 64);
  }
  {
    char* As = smem; char* Bs = smem + 256 * LDS_ROW;
#pragma unroll
    for (int i = 0; i < 4; ++i) *(u32x4*)(As + (lrow + 64 * i) * LDS_ROW + kc * 16) = sa[0][i];
#pragma unroll
    for (int i = 0; i < 2; ++i) *(u32x4*)(Bs + (lrow + 64 * i) * LDS_ROW + kc * 16) = sb[0][i];
  }
  lds_barrier();
  zero_acc();
  int c_idx = jb;
  for (int ti = 0; ti < nmine; ++ti) {
    set_ptrs(ti + 1 < nmine ? c_idx + nbx : c_idx, nap, nbp);
    for (int q = 0; q < KT / 4; ++q) {
      const bool lastq = (q == KT / 4 - 1);
      const int koff = lastq ? 0 : (4 * (q + 1)) * 64;
      const bf16_t* lap[4]; const bf16_t* lbp[2];
#pragma unroll
      for (int i = 0; i < 4; ++i) lap[i] = (lastq ? nap[i] : cap[i]) + koff;
#pragma unroll
      for (int i = 0; i < 2; ++i) lbp[i] = (lastq ? nbp[i] : cbp[i]) + koff;
#pragma unroll
      for (int j = 0; j < 4; ++j) {
#pragma unroll
        for (int i = 0; i < 4; ++i) sa[j][i] = *(const u32x4*)(lap[i] + j * 64);
#pragma unroll
        for (int i = 0; i < 2; ++i) sb[j][i] = *(const u32x4*)(lbp[i] + j * 64);
        compute(smem + (j & 1) * STAGE, smem + ((j + 1) & 1) * STAGE, sa[(j + 1) & 3], sb[(j + 1) & 3]);
        lds_barrier();
      }
    }
#pragma unroll
    for (int i = 0; i < 4; ++i) cap[i] = nap[i];
#pragma unroll
    for (int i = 0; i < 2; ++i) cbp[i] = nbp[i];
    const int idx = c_idx; c_idx += nbx;
    int tmi, tn; decode(idx, tmi, tn);
    const int tm = xcd + 8 * tmi;
    const int m0 = tm * 256, n0 = tn * 128;
    char* eps = smem + 2 * STAGE + wv * 4608;
    if (MODE == 0) {
      const int nb = n0 + wn * 64;
      if (nb < 3648) {
        if (layer == 1) {
#pragma unroll
          for (int mt = 0; mt < 2; ++mt) {
            const float rs = rsqrtf(p.ssq[m0 + wm * 64 + mt * 32 + r] * (1.f / 1024.f) + 1e-6f);
#pragma unroll
            for (int nt = 0; nt < 2; ++nt)
#pragma unroll
              for (int i = 0; i < 16; ++i) acc[mt][nt][i] *= rs;
          }
        }
        float scale[2] = {1.f, 1.f};
        if (nb < 1024) {
#pragma unroll
          for (int mt = 0; mt < 2; ++mt) {
            float ss = 0.f;
#pragma unroll
            for (int nt = 0; nt < 2; ++nt)
#pragma unroll
              for (int i = 0; i < 16; ++i) ss += acc[mt][nt][i] * acc[mt][nt][i];
            ss += __shfl_xor(ss, 32);
            scale[mt] = rsqrtf(ss * (1.f / 64.f) + 1e-6f);
          }
        }
        const float* nw = (nb < 512 ? p.q_norm_w : p.k_norm_w) + layer * 64;
#pragma unroll
        for (int mt = 0; mt < 2; ++mt) {
          const int mb = m0 + wm * 64 + mt * 32;
          const int m = mb + r;
          const bool is_p = m < NTOK_P;
#pragma unroll
          for (int nt = 0; nt < 2; ++nt) {
#pragma unroll
            for (int g = 0; g < 4; ++g) {
              const int ncol = nb + nt * 32 + 8 * g + 4 * h;
              float v0 = acc[mt][nt][4 * g], v1 = acc[mt][nt][4 * g + 1], v2 = acc[mt][nt][4 * g + 2], v3 = acc[mt][nt][4 * g + 3];
              if (nb < 1024) {
                float4 w4 = *(const float4*)(nw + (ncol - nb));
                v0 *= scale[mt] * w4.x; v1 *= scale[mt] * w4.y; v2 *= scale[mt] * w4.z; v3 *= scale[mt] * w4.w;
              }
              *(float4*)(eps + r * 144 + (8 * g + 4 * h) * 4) = make_float4(v0, v1, v2, v3);
              if (nb >= OFF_C && nb < OFF_GC) {
                const bool last = is_p ? ((m & 2047) == 2047) : (((m - NTOK_P) & 31) == 31);
                if (last) {
                  float* dst = p.out + (is_p ? O_SHP + ((size_t)layer * 32 + (m >> 11)) * 832 : O_SHS + ((size_t)layer * 16 + ((m - NTOK_P) >> 5)) * 832) + (ncol - OFF_C);
                  *(float4*)dst = make_float4(v0, v1, v2, v3);
                }
              }
            }
            __builtin_amdgcn_wave_barrier();
#pragma unroll
            for (int it = 0; it < 2; ++it) {
              const int row = (lane >> 2) + 16 * it, ch = lane & 3;
              const float4 a = *(const float4*)(eps + row * 144 + ch * 32), c = *(const float4*)(eps + row * 144 + ch * 32 + 16);
              u32x4 o; o.x = pk2(a.x, a.y); o.y = pk2(a.z, a.w); o.z = pk2(c.x, c.y); o.w = pk2(c.z, c.w);
              *(u32x4*)(p.P + (size_t)(mb + row) * D_IN + nb + nt * 32 + ch * 8) = o;
            }
            if (nb >= 512 && nb < 1536) {
#pragma unroll
              for (int it = 0; it < 4; ++it) {
                const int row = it * 8 + (lane >> 3), ch = lane & 7;
                const float4 a = *(const float4*)(eps + row * 144 + ch * 16);
                const int mm = mb + row;
                const bool pp = mm < NTOK_P;
                float* dst;
                if (nb < 1024) dst = p.out + (pp ? O_KP + ((size_t)layer * 65536 + mm) * 512 : O_KS + ((size_t)layer * 512 + (mm - NTOK_P)) * 512) + (nb - 512);
                else dst = p.out + (pp ? O_VP + ((size_t)layer * 65536 + mm) * 512 : O_VS + ((size_t)layer * 512 + (mm - NTOK_P)) * 512) + (nb - 1024);
                *(float4*)(dst + nt * 32 + ch * 4) = a;
              }
            }
            __builtin_amdgcn_wave_barrier();
          }
        }
      }
    } else if (MODE == 1) {
      const float* bg = p.b_glu + layer * 512;
#pragma unroll
      for (int mt = 0; mt < 2; ++mt) {
        const int m = m0 + wm * 64 + mt * 32 + r;
#pragma unroll
        for (int g = 0; g < 4; ++g) {
          const int col = tn * 64 + wn * 32 + 8 * g + 4 * h;
          float4 bv = *(const float4*)(bg + col), bgt = *(const float4*)(bg + 256 + col);
          u32x2 gb = *(const u32x2*)(p.P + (size_t)m * D_IN + OFF_GB + col);
          float o0 = (acc[mt][0][4 * g] + bv.x) * sigmoidf_(acc[mt][1][4 * g] + bgt.x) * siluf_(bflo(gb.x));
          float o1 = (acc[mt][0][4 * g + 1] + bv.y) * sigmoidf_(acc[mt][1][4 * g + 1] + bgt.y) * siluf_(bfhi(gb.x));
          float o2 = (acc[mt][0][4 * g + 2] + bv.z) * sigmoidf_(acc[mt][1][4 * g + 2] + bgt.z) * siluf_(bflo(gb.y));
          float o3 = (acc[mt][0][4 * g + 3] + bv.w) * sigmoidf_(acc[mt][1][4 * g + 3] + bgt.w) * siluf_(bfhi(gb.y));
          u32x2 o; o.x = pk2(o0, o1); o.y = pk2(o2, o3);
          *(u32x2*)(p.mix + (size_t)m * 1024 + 512 + col) = o;
        }
      }
    } else {
      const float* nw1 = p.norm_w + 1024;
#pragma unroll
      for (int mt = 0; mt < 2; ++mt) {
        const int mb = m0 + wm * 64 + mt * 32;
        float sq[4] = {0.f, 0.f, 0.f, 0.f};
#pragma unroll
        for (int nt = 0; nt < 2; ++nt) {
#pragma unroll
          for (int g = 0; g < 4; ++g)
            *(float4*)(eps + r * 144 + (8 * g + 4 * h) * 4) = make_float4(acc[mt][nt][4 * g], acc[mt][nt][4 * g + 1], acc[mt][nt][4 * g + 2], acc[mt][nt][4 * g + 3]);
          __builtin_amdgcn_wave_barrier();
#pragma unroll
          for (int it = 0; it < 4; ++it) {
            const int row = it * 8 + (lane >> 3), ch = lane & 7;
            const float4 a = *(const float4*)(eps + row * 144 + ch * 16);
            const int mm = mb + row, ncol = n0 + wn * 64 + nt * 32 + ch * 4;
            float4 xv = *(const float4*)(xrow(p, layer, mm) + ncol);
            xv.x += a.x; xv.y += a.y; xv.z += a.z; xv.w += a.w;
            *(float4*)(p.out + (size_t)mm * 1024 + ncol) = xv;
            if (layer == 0) {
              sq[it] += xv.x * xv.x + xv.y * xv.y + xv.z * xv.z + xv.w * xv.w;
              const float4 w4 = *(const float4*)(nw1 + ncol);
              u32x2 o; o.x = pk2(xv.x * w4.x, xv.y * w4.y); o.y = pk2(xv.z * w4.z, xv.w * w4.w);
              *(u32x2*)(p.hbf + (size_t)mm * 1024 + ncol) = o;
            }
          }
          __builtin_amdgcn_wave_barrier();
        }
        if (layer == 0) {
#pragma unroll
          for (int it = 0; it < 4; ++it) {
            const float s = sum8(sq[it]);
            if ((lane & 7) == 0) atomicAdd(p.ssq + mb + it * 8 + (lane >> 3), s);
          }
        }
      }
    }
    zero_acc();
  }
}

constexpr int VS = 66;
DI void attn_item(const Params& p, int layer, int wi, bf16_t* vl) {
  const int lane = TID & 63, r = lane & 31, h = lane >> 5;
  const bool sample = wi >= 16384;
  int b, hd, qt, tok0, qabs0;
  if (!sample) { b = wi >> 9; hd = (wi >> 6) & 7; qt = wi & 63; tok0 = b * 2048; qabs0 = qt * 32; }
  else { int j = wi - 16384; b = j >> 3; hd = j & 7; qt = 0; tok0 = NTOK_P + b * 32; qabs0 = 4096; }
  const int tq0 = tok0 + qt * 32;
  bf16x8 qf[4];
  {
    const bf16_t* qp = p.P + (size_t)(tq0 + r) * D_IN + OFF_Q + hd * 64 + h * 8;
#pragma unroll
    for (int ks = 0; ks < 4; ++ks) qf[ks] = *(const bf16x8*)(qp + ks * 16);
  }
  f32x16 o[2];
#pragma unroll
  for (int d = 0; d < 2; ++d)
#pragma unroll
    for (int i = 0; i < 16; ++i) o[d][i] = 0.f;
  float run = 0.f;
  const int nblk = qabs0 / 32 + 1;
  const int pir = 16 * ((r >> 2) & 1) + 4 * (r >> 3) + (r & 3);
  const float* ck = p.cache_k + ((size_t)(layer * 16 + b) * 4096) * 512 + hd * 64;
  const float* cv = p.cache_v + ((size_t)(layer * 16 + b) * 4096) * 512 + hd * 64;

  for (int kb = nblk - 1; kb >= 0; --kb) {
    const int kp0 = kb * 32;
    const bool fromP = (!sample) || (kb == 128);
    bf16x8 kf[4];
    if (fromP) {
      const int tk = sample ? (tok0 + (kp0 + pir - 4096)) : (tok0 + kp0 + pir);
      const bf16_t* kp = p.P + (size_t)tk * D_IN + OFF_K + hd * 64 + h * 8;
#pragma unroll
      for (int ks = 0; ks < 4; ++ks) kf[ks] = *(const bf16x8*)(kp + ks * 16);
#pragma unroll
      for (int i = 0; i < 4; ++i) {
        const int key = i * 8 + (lane >> 3), dc = lane & 7;
        const int tv = sample ? (tok0 + (kp0 + key - 4096)) : (tok0 + kp0 + key);
        u32x4 v = *(const u32x4*)(p.P + (size_t)tv * D_IN + OFF_V + hd * 64 + dc * 8);
        unsigned* dst = (unsigned*)(vl + key * VS + dc * 8);
        dst[0] = v.x; dst[1] = v.y; dst[2] = v.z; dst[3] = v.w;
      }
    } else {
      const float* kp = ck + (size_t)(kp0 + pir) * 512 + h * 8;
#pragma unroll
      for (int ks = 0; ks < 4; ++ks) {
        float4 a = *(const float4*)(kp + ks * 16), c = *(const float4*)(kp + ks * 16 + 4);
        u32x4 t; t.x = pk2(a.x, a.y); t.y = pk2(a.z, a.w); t.z = pk2(c.x, c.y); t.w = pk2(c.z, c.w);
        kf[ks] = __builtin_bit_cast(bf16x8, t);
      }
#pragma unroll
      for (int i = 0; i < 4; ++i) {
        const int key = i * 8 + (lane >> 3), dc = lane & 7;
        const float* vp = cv + (size_t)(kp0 + key) * 512 + dc * 8;
        float4 a = *(const float4*)vp, c = *(const float4*)(vp + 4);
        unsigned* dst = (unsigned*)(vl + key * VS + dc * 8);
        dst[0] = pk2(a.x, a.y); dst[1] = pk2(a.z, a.w); dst[2] = pk2(c.x, c.y); dst[3] = pk2(c.z, c.w);
      }
    }
    f32x16 st;
#pragma unroll
    for (int i = 0; i < 16; ++i) st[i] = 0.f;
#pragma unroll
    for (int ks = 0; ks < 4; ++ks) st = MFMA(kf[ks], qf[ks], st);
    const bool diag = (kb == nblk - 1);
    float z[16], lk[16], lat[16];
#pragma unroll
    for (int i = 0; i < 16; ++i) {
      z[i] = st[i] * 0.125f;
      const bool msk = (!diag) || (16 * h + i < r);
      const float e = __expf(-fabsf(z[i]));
      const float sp = fmaxf(z[i], 0.f) + __logf(1.f + e);
      lk[i] = msk ? -sp : 0.f;
    }
    float suf = 0.f;
#pragma unroll
    for (int i = 15; i >= 0; --i) { lat[i] = suf; suf += lk[i]; }
    const float other = __shfl_xor(suf, 32);
    const float base = run + (h == 0 ? other : 0.f);
    float a[16];
#pragma unroll
    for (int i = 0; i < 16; ++i) {
      const bool msk = (!diag) || (16 * h + i < r);
      a[i] = msk ? __expf(z[i] + lk[i] + base + lat[i]) : 0.f;
    }
    run += suf + other;
    __builtin_amdgcn_wave_barrier();
#pragma unroll
    for (int s2 = 0; s2 < 2; ++s2) {
      u32x4 t; t.x = pk2(a[8 * s2], a[8 * s2 + 1]); t.y = pk2(a[8 * s2 + 2], a[8 * s2 + 3]); t.z = pk2(a[8 * s2 + 4], a[8 * s2 + 5]); t.w = pk2(a[8 * s2 + 6], a[8 * s2 + 7]);
      const bf16x8 pf = __builtin_bit_cast(bf16x8, t);
#pragma unroll
      for (int dt = 0; dt < 2; ++dt) {
        const bf16_t* vp = vl + (16 * h + 8 * s2) * VS + 32 * dt + r;
        bf16x8 vf;
#pragma unroll
        for (int j = 0; j < 8; ++j) vf[j] = (short)vp[j * VS];
        o[dt] = MFMA(vf, pf, o[dt]);
      }
    }
    __builtin_amdgcn_wave_barrier();
    if (__all(run < -104.f)) break;
  }
  const int tok = tq0 + r;
#pragma unroll
  for (int dt = 0; dt < 2; ++dt)
#pragma unroll
    for (int g = 0; g < 4; ++g) {
      const int d0 = 32 * dt + 8 * g + 4 * h;
      u32x2 ga = *(const u32x2*)(p.P + (size_t)tok * D_IN + OFF_GA + hd * 64 + d0);
      u32x2 ov;
      ov.x = pk2(o[dt][4 * g] * siluf_(bflo(ga.x)), o[dt][4 * g + 1] * siluf_(bfhi(ga.x)));
      ov.y = pk2(o[dt][4 * g + 2] * siluf_(bflo(ga.y)), o[dt][4 * g + 3] * siluf_(bfhi(ga.y)));
      *(u32x2*)(p.mix + (size_t)tok * 1024 + hd * 64 + d0) = ov;
    }
}

constexpr int S5_BU = 8192;
constexpr int S5_LDS = S5_BU + 8704 + 1024;
DI void s5_disc(const Params& p, int lg, int pi, float dt, float& ar, float& ai, float& fr, float& fi) {
  const float lr = fminf(p.lam_re[lg * 64 + pi], -1e-4f), li = p.lam_im[lg * 64 + pi];
  const float er = expf(lr * dt);
  ar = er * cosf(li * dt); ai = er * sinf(li * dt);
  const float den = lr * lr + li * li;
  fr = ((ar - 1.f) * lr + ai * li) / den; fi = (ai * lr - (ar - 1.f) * li) / den;
}
DI void s5_item(const Params& p, int layer, int item, char* lds) {
  float* BU = (float*)lds;
  char* Himg = lds + S5_BU;
  bf16_t* Ub = (bf16_t*)(lds + S5_BU + 8704);
  const int lane = TID & 63, r = lane & 31, h = lane >> 5;
  const int seq = item >> 4, g = item & 15;
  const bool sample = seq >= 32;
  const int b = sample ? seq - 32 : seq, L = sample ? 32 : 2048, tok0 = sample ? NTOK_P + b * 32 : b * 2048;
  const int lg = layer * 16 + g;
  const float dt = expf(p.log_dt[lg]);
  float ar, ai, fr_, fi_;
  s5_disc(p, lg, lane, dt, ar, ai, fr_, fi_);
  bf16x8 bbf[4];
#pragma unroll
  for (int half = 0; half < 2; ++half) {
    const int pi = 32 * half + r;
    float a_r, a_i, f_r, f_i;
    s5_disc(p, lg, pi, dt, a_r, a_i, f_r, f_i);
    const float* brp = p.b_re + ((size_t)lg * 64 + pi) * 16 + 8 * h;
    const float* bip = p.b_im + ((size_t)lg * 64 + pi) * 16 + 8 * h;
    float re[8], im[8];
#pragma unroll
    for (int j = 0; j < 8; ++j) { const float br = brp[j], bi = bip[j]; re[j] = f_r * br - f_i * bi; im[j] = f_r * bi + f_i * br; }
    u32x4 t0, t1;
    t0.x = pk2(re[0], re[1]); t0.y = pk2(re[2], re[3]); t0.z = pk2(re[4], re[5]); t0.w = pk2(re[6], re[7]);
    t1.x = pk2(im[0], im[1]); t1.y = pk2(im[2], im[3]); t1.z = pk2(im[4], im[5]); t1.w = pk2(im[6], im[7]);
    bbf[half] = __builtin_bit_cast(bf16x8, t0);
    bbf[2 + half] = __builtin_bit_cast(bf16x8, t1);
  }
  bf16x8 cf[8];
#pragma unroll
  for (int s = 0; s < 8; ++s) {
    u32x4 t; t.x = 0; t.y = 0; t.z = 0; t.w = 0;
    if (r < 16) {
      const int k0 = 16 * s + 8 * h;
      const float* src = (s < 4 ? p.c_re : p.c_im) + ((size_t)lg * 16 + r) * 64 + (k0 & 63);
      const float sg = s < 4 ? 1.f : -1.f;
      const float4 c0 = *(const float4*)src, c1 = *(const float4*)(src + 4);
      t.x = pk2(sg * c0.x, sg * c0.y); t.y = pk2(sg * c0.z, sg * c0.w); t.z = pk2(sg * c1.x, sg * c1.y); t.w = pk2(sg * c1.z, sg * c1.w);
    }
    cf[s] = __builtin_bit_cast(bf16x8, t);
  }
  const float dl = p.ssm_d[lg * 16 + (r & 15)];
  float hr = 0.f, hi = 0.f;
  if (sample) { hr = p.st_re[((size_t)(layer * 16 + b) * 16 + g) * 64 + lane]; hi = p.st_im[((size_t)(layer * 16 + b) * 16 + g) * 64 + lane]; }
  f32x16 zero;
#pragma unroll
  for (int i = 0; i < 16; ++i) zero[i] = 0.f;
  const bf16_t* upb = p.P + (size_t)(tok0 + r) * D_IN + OFF_U + g * 16 + 8 * h;
  bf16x8 uf = *(const bf16x8*)upb;
  for (int t0 = 0; t0 < L; t0 += 32) {
    const bf16x8 ucur = uf;
    if (t0 + 32 < L) uf = *(const bf16x8*)(upb + (size_t)(t0 + 32) * D_IN);
    *(bf16x8*)(Ub + r * 16 + 8 * h) = ucur;
    f32x16 d[4];
#pragma unroll
    for (int tile = 0; tile < 4; ++tile) d[tile] = MFMA(ucur, bbf[tile], zero);
#pragma unroll
    for (int hf = 0; hf < 2; ++hf) {
#pragma unroll
      for (int tile = 0; tile < 4; ++tile)
#pragma unroll
        for (int i = 0; i < 8; ++i) BU[((i & 3) + 8 * (i >> 2) + 4 * h) * 128 + 32 * tile + r] = d[tile][8 * hf + i];
      __builtin_amdgcn_wave_barrier();
#pragma unroll
      for (int tt = 0; tt < 16; ++tt) {
        const int t = 16 * hf + tt;
        const float bur = BU[tt * 128 + lane], bui = BU[tt * 128 + 64 + lane];
        const float nhr = ar * hr - ai * hi + bur, nhi = ar * hi + ai * hr + bui;
        hr = nhr; hi = nhi;
        *(bf16_t*)(Himg + t * 272 + lane * 2) = (bf16_t)f2bf(hr);
        *(bf16_t*)(Himg + t * 272 + 128 + lane * 2) = (bf16_t)f2bf(hi);
      }
      __builtin_amdgcn_wave_barrier();
    }
    f32x16 yacc = zero;
#pragma unroll
    for (int s = 0; s < 8; ++s) {
      const bf16x8 af = *(const bf16x8*)(Himg + r * 272 + s * 32 + h * 16);
      yacc = MFMA(af, cf[s], yacc);
    }
    if (r < 16) {
#pragma unroll
      for (int i = 0; i < 16; ++i) {
        const int t = (i & 3) + 8 * (i >> 2) + 4 * h;
        const float yv = yacc[i] + dl * bf2f(Ub[t * 16 + r]);
        const float gl = yv / (1.f + __expf(-1.5957691216f * (yv + 0.044715f * yv * yv * yv)));
        p.yb[(size_t)(tok0 + t0 + t) * 256 + g * 16 + r] = (bf16_t)f2bf(gl);
      }
    }
    __builtin_amdgcn_wave_barrier();
  }
  float* ore = p.out + (sample ? O_SRES : O_SREP) + ((size_t)(layer * (sample ? 16 : 32) + b) * 16 + g) * 64 + lane;
  float* oim = p.out + (sample ? O_SIMS : O_SIMP) + ((size_t)(layer * (sample ? 16 : 32) + b) * 16 + g) * 64 + lane;
  *ore = hr; *oim = hi;
}

DI void rwkv_item(const Params& p, int layer, int item, char* smem) {
  constexpr int SETF = 6 * 2048;
  float* SET0 = (float*)smem;
  float* YB = SET0 + 2 * SETF;
  char* PW = (char*)(YB + 2 * 2048);
  const int tid = TID, lane = tid & 63, wv = tid >> 6;
  const int seq = item >> 2, hd = item & 3;
  const bool sample = seq >= 32;
  const int b = sample ? seq - 32 : seq, L = sample ? 32 : 2048, tok0 = sample ? NTOK_P + b * 32 : b * 2048;
  const int nch = L >> 5;
  if (wv < 4) {
    const int rp = tid >> 3, kq = tid & 7;
    f32x2 S0[4], S1[4];
    if (sample) {
      const float* sp = p.st_wkv + (((size_t)(layer * 16 + b) * 4 + hd) * 64 + rp) * 64 + kq * 8;
#pragma unroll
      for (int j = 0; j < 4; ++j) { S0[j].x = sp[2 * j]; S0[j].y = sp[2 * j + 1]; S1[j].x = sp[2048 + 2 * j]; S1[j].y = sp[2048 + 2 * j + 1]; }
    } else {
#pragma unroll
      for (int j = 0; j < 4; ++j) { S0[j].x = 0.f; S0[j].y = 0.f; S1[j].x = 0.f; S1[j].y = 0.f; }
    }
    lds_barrier();
    for (int c = 0; c < nch; ++c) {
      const float* R = SET0 + (c & 1) * SETF; const float* W = R + 2048; const float* KT = W + 2048; const float* KH = KT + 2048;
      const float* BB = KH + 2048; const float* V = BB + 2048;
      float* Y = YB + (c & 1) * 2048;
      float yk0[4], yk1[4];
      float4 nkh0, nkh1, nw0, nw1, nb0, nb1, nk0, nk1, nr0, nr1; float nv0, nv1;
      {
        const int o = kq * 8;
        nkh0 = *(const float4*)(KH + o); nkh1 = *(const float4*)(KH + o + 4); nw0 = *(const float4*)(W + o); nw1 = *(const float4*)(W + o + 4);
        nb0 = *(const float4*)(BB + o); nb1 = *(const float4*)(BB + o + 4); nk0 = *(const float4*)(KT + o); nk1 = *(const float4*)(KT + o + 4);
        nr0 = *(const float4*)(R + o); nr1 = *(const float4*)(R + o + 4); nv0 = V[rp]; nv1 = V[rp + 32];
      }
#pragma unroll
      for (int q = 0; q < 4; ++q) {
        yk0[q] = 0.f; yk1[q] = 0.f;
#pragma unroll
        for (int e = 0; e < 8; ++e) {
          const int tl = q * 8 + e;
          const float4 kh0 = nkh0, kh1 = nkh1, w0_ = nw0, w1_ = nw1, b0 = nb0, b1 = nb1, k0 = nk0, k1 = nk1, r0 = nr0, r1 = nr1;
          const float va = nv0, vb = nv1;
          if (tl < 31) {
            const int o = (tl + 1) * 64 + kq * 8;
            nkh0 = *(const float4*)(KH + o); nkh1 = *(const float4*)(KH + o + 4); nw0 = *(const float4*)(W + o); nw1 = *(const float4*)(W + o + 4);
            nb0 = *(const float4*)(BB + o); nb1 = *(const float4*)(BB + o + 4); nk0 = *(const float4*)(KT + o); nk1 = *(const float4*)(KT + o + 4);
            nr0 = *(const float4*)(R + o); nr1 = *(const float4*)(R + o + 4); nv0 = V[(tl + 1) * 64 + rp]; nv1 = V[(tl + 1) * 64 + rp + 32];
          }
          const f32x2 khv[4] = {{kh0.x, kh0.y}, {kh0.z, kh0.w}, {kh1.x, kh1.y}, {kh1.z, kh1.w}};
          const f32x2 wvv[4] = {{w0_.x, w0_.y}, {w0_.z, w0_.w}, {w1_.x, w1_.y}, {w1_.z, w1_.w}};
          const f32x2 bv[4] = {{b0.x, b0.y}, {b0.z, b0.w}, {b1.x, b1.y}, {b1.z, b1.w}};
          const f32x2 kv[4] = {{k0.x, k0.y}, {k0.z, k0.w}, {k1.x, k1.y}, {k1.z, k1.w}};
          const f32x2 rv[4] = {{r0.x, r0.y}, {r0.z, r0.w}, {r1.x, r1.y}, {r1.z, r1.w}};
          const f32x2 va2 = {va, va}, vb2 = {vb, vb};
          f32x2 ma[4], mb[4];
#pragma unroll
          for (int j = 0; j < 4; ++j) { ma[j] = fma2(S0[j], wvv[j], va2 * kv[j]); mb[j] = fma2(S1[j], wvv[j], vb2 * kv[j]); }
          f32x2 sa2 = fma2(S0[1], khv[1], S0[0] * khv[0]) + fma2(S0[3], khv[3], S0[2] * khv[2]);
          f32x2 sb2 = fma2(S1[1], khv[1], S1[0] * khv[0]) + fma2(S1[3], khv[3], S1[2] * khv[2]);
          const float sa = sum8(sa2.x + sa2.y), sb = sum8(sb2.x + sb2.y);
          const f32x2 nsa = {-sa, -sa}, nsb = {-sb, -sb};
#pragma unroll
          for (int j = 0; j < 4; ++j) { S0[j] = fma2(nsa, bv[j], ma[j]); S1[j] = fma2(nsb, bv[j], mb[j]); }
          f32x2 ya2 = fma2(S0[1], rv[1], S0[0] * rv[0]) + fma2(S0[3], rv[3], S0[2] * rv[2]);
          f32x2 yb2 = fma2(S1[1], rv[1], S1[0] * rv[0]) + fma2(S1[3], rv[3], S1[2] * rv[2]);
          const float ya = sum8(ya2.x + ya2.y), ybv = sum8(yb2.x + yb2.y);
          yk0[q] = (e == kq) ? ya : yk0[q];
          yk1[q] = (e == kq) ? ybv : yk1[q];
        }
      }
#pragma unroll
      for (int q = 0; q < 4; ++q) { Y[(q * 8 + kq) * 64 + rp] = yk0[q]; Y[(q * 8 + kq) * 64 + rp + 32] = yk1[q]; }
      lds_barrier();
    }
    float* so = p.out + (sample ? O_WKVS : O_WKVP) + (((size_t)(layer * (sample ? 16 : 32) + b) * 4 + hd) * 64 + rp) * 64 + kq * 8;
    *(float4*)so = make_float4(S0[0].x, S0[0].y, S0[1].x, S0[1].y);
    *(float4*)(so + 4) = make_float4(S0[2].x, S0[2].y, S0[3].x, S0[3].y);
    *(float4*)(so + 2048) = make_float4(S1[0].x, S1[0].y, S1[1].x, S1[1].y);
    *(float4*)(so + 2052) = make_float4(S1[2].x, S1[2].y, S1[3].x, S1[3].y);
  } else {
    const int pw = wv - 4, r_ = lane & 31, h_ = lane >> 5;
    const int cg_ = hd * 64 + lane;
    bf16_t* LORAb = (bf16_t*)(PW + pw * 5248);
    float* DSA = (float*)(PW + pw * 5248 + 1152);
    bf16x8 lb[2][2][2];
#pragma unroll
    for (int ll = 0; ll < 2; ++ll)
#pragma unroll
      for (int nn = 0; nn < 2; ++nn) {
        const float* srcw = (ll ? p.a2 : p.w2) + (size_t)layer * 32 * 256 + hd * 64 + 32 * nn + r_;
#pragma unroll
        for (int s = 0; s < 2; ++s) {
          float t[8];
#pragma unroll
          for (int j = 0; j < 8; ++j) t[j] = srcw[(size_t)(16 * s + 8 * h_ + j) * 256];
          u32x4 u; u.x = pk2(t[0], t[1]); u.y = pk2(t[2], t[3]); u.z = pk2(t[4], t[5]); u.w = pk2(t[6], t[7]);
          lb[ll][nn][s] = __builtin_bit_cast(bf16x8, u);
        }
      }
    const float w0c = p.w0[layer * 256 + cg_], a0c = p.a0[layer * 256 + cg_], kkc = p.k_k[layer * 256 + cg_], kac = p.k_a[layer * 256 + cg_];
    const float ubc = p.u_bonus[layer * 256 + cg_], lnw = p.ln_w[layer * 256 + cg_], lnb = p.ln_b[layer * 256 + cg_];
    const float* mu = p.mu + layer * 832;
    const float mu_r = mu[cg_], mu_k = mu[256 + cg_], mu_v = mu[512 + cg_], mu_l = mu[768 + lane];
    const float* shp = p.st_shift + (size_t)(layer * 16 + b) * 832;
    auto pre = [&](int c, float (&xvk)[8], float (&bonk)[8], float (&gtk)[8]) {
      float* R = SET0 + (c & 1) * SETF; float* W = R + 2048; float* KT = W + 2048; float* KH = KT + 2048; float* BB = KH + 2048; float* V = BB + 2048;
      const bf16_t* base = p.P + (size_t)(tok0 + c * 32 + 8 * pw) * D_IN + OFF_C;
      bf16_t cr[8], ck[8], cv[8], cl[8], cgt[8];
#pragma unroll
      for (int i = 0; i < 8; ++i) {
        const bf16_t* cp = base + (size_t)i * D_IN;
        cr[i] = cp[cg_]; ck[i] = cp[256 + cg_]; cv[i] = cp[512 + cg_]; cl[i] = cp[768 + lane]; cgt[i] = cp[OFF_GC - OFF_C + cg_];
      }
      float pr, pk, pv, pl;
      if (c * 32 + 8 * pw == 0) {
        if (sample) { pr = shp[cg_]; pk = shp[256 + cg_]; pv = shp[512 + cg_]; pl = shp[768 + lane]; }
        else { pr = 0.f; pk = 0.f; pv = 0.f; pl = 0.f; }
      } else {
        const bf16_t* pp = base - D_IN;
        pr = bf2f(pp[cg_]); pk = bf2f(pp[256 + cg_]); pv = bf2f(pp[512 + cg_]); pl = bf2f(pp[768 + lane]);
      }
      float xr_[8], xk_[8];
#pragma unroll
      for (int i = 0; i < 8; ++i) {
        const float c_r = bf2f(cr[i]), c_k = bf2f(ck[i]), c_v = bf2f(cv[i]), c_l = bf2f(cl[i]);
        xr_[i] = c_r + mu_r * (pr - c_r); xk_[i] = c_k + mu_k * (pk - c_k); xvk[i] = c_v + mu_v * (pv - c_v);
        const float xl = c_l + mu_l * (pl - c_l);
        pr = c_r; pk = c_k; pv = c_v; pl = c_l;
        gtk[i] = bf2f(cgt[i]);
        LORAb[i * 72 + lane] = (bf16_t)f2bf(lane < 32 ? fast_tanh(xl) : xl);
      }
      __builtin_amdgcn_wave_barrier();
#pragma unroll
      for (int ll = 0; ll < 2; ++ll) {
        const bf16x8 af0 = *(const bf16x8*)((const char*)LORAb + (r_ & 7) * 144 + ll * 64 + h_ * 16);
        const bf16x8 af1 = *(const bf16x8*)((const char*)LORAb + (r_ & 7) * 144 + ll * 64 + 32 + h_ * 16);
#pragma unroll
        for (int nn = 0; nn < 2; ++nn) {
          f32x16 dacc;
#pragma unroll
          for (int i = 0; i < 16; ++i) dacc[i] = 0.f;
          dacc = MFMA(af0, lb[ll][nn][0], dacc);
          dacc = MFMA(af1, lb[ll][nn][1], dacc);
#pragma unroll
          for (int i = 0; i < 4; ++i) DSA[ll * 512 + (i + 4 * h_) * 64 + 32 * nn + r_] = dacc[i];
        }
      }
      __builtin_amdgcn_wave_barrier();
#pragma unroll
      for (int i = 0; i < 8; ++i) {
        const int tl = 8 * pw + i;
        const float dsum = w0c + DSA[i * 64 + lane], asum = a0c + DSA[512 + i * 64 + lane];
        const float dec = __expf(-0.6065306597f * sigmoidf_(dsum));
        const float a = sigmoidf_(asum);
        const float kk = xk_[i] * kkc;
        const float ss = wave_sum(kk * kk);
        const float kh = kk * rsqrtf(ss + 1e-12f);
        const float kt = xk_[i] * (1.f + (a - 1.f) * kac);
        bonk[i] = wave_sum(xr_[i] * kt * ubc);
        R[tl * 64 + lane] = xr_[i]; W[tl * 64 + lane] = dec; KT[tl * 64 + lane] = kt; KH[tl * 64 + lane] = kh; BB[tl * 64 + lane] = a * kh; V[tl * 64 + lane] = xvk[i];
      }
      __builtin_amdgcn_wave_barrier();
    };
    auto post = [&](int c, const float (&xvk)[8], const float (&bonk)[8], const float (&gtk)[8]) {
      const float* Y = YB + (c & 1) * 2048;
#pragma unroll
      for (int i = 0; i < 8; ++i) {
        const int tl = 8 * pw + i;
        const float y = Y[tl * 64 + lane];
        const float mean = wave_sum(y) * (1.f / 64.f);
        const float msq = wave_sum(y * y) * (1.f / 64.f);
        const float var = fmaxf(msq - mean * mean, 0.f);
        float yn = (y - mean) * rsqrtf(var + 64e-5f) * lnw + lnb;
        yn += bonk[i] * xvk[i];
        p.mix[(size_t)(tok0 + c * 32 + tl) * 1024 + 768 + cg_] = (bf16_t)f2bf(yn * siluf_(gtk[i]));
      }
    };
    float xvA[8], bonA[8], gtA[8], xvB[8], bonB[8], gtB[8];
#pragma unroll
    for (int i = 0; i < 8; ++i) { xvB[i] = 0.f; bonB[i] = 0.f; gtB[i] = 0.f; }
    pre(0, xvA, bonA, gtA);
    lds_barrier();
    for (int c = 0; c < nch; c += 2) {
      if (c >= 1) post(c - 1, xvB, bonB, gtB);
      if (c + 1 < nch) pre(c + 1, xvB, bonB, gtB);
      lds_barrier();
      if (c + 1 < nch) {
        post(c, xvA, bonA, gtA);
        if (c + 2 < nch) pre(c + 2, xvA, bonA, gtA);
        lds_barrier();
      }
    }
    if ((nch - 1) & 1) post(nch - 1, xvB, bonB, gtB); else post(nch - 1, xvA, bonA, gtA);
  }
  lds_barrier();
}

constexpr int ATT_LDS0 = 6 * S5_LDS;
DI void phase_mixers(const Params& p, int layer, char* smem, int cofs) {
  const int G = GDIM, bid = BID, half = G / 2;
  const int tid = TID, wv = tid >> 6, lane = tid & 63;
  if (bid < half) {
    for (int item = bid; item < 128; item += half) rwkv_item(p, layer, item, smem);
  } else {
    const int j = bid - half, nb2 = G - half;
    for (int item = 128 + j; item < 192; item += nb2) rwkv_item(p, layer, item, smem);
    if (wv < 6) { for (int it = j * 6 + wv; it < 768; it += nb2 * 6) s5_item(p, layer, it, smem + wv * S5_LDS); }
  }
  unsigned* ctr = p.counters + layer + cofs;
  bf16_t* vl = (bf16_t*)(smem + ATT_LDS0) + wv * (32 * VS);
  while (true) {
    int it = 0;
    if (lane == 0) it = (int)atomicAdd(ctr, 1u);
    it = __builtin_amdgcn_readfirstlane(it);
    if (it >= 16512) break;
    attn_item(p, layer, it, vl);
  }
}

__global__ void __launch_bounds__(NT) mega(Params p) {
  __shared__ __attribute__((aligned(16))) char smem[SMEM_BYTES];
  cg::grid_group grid = cg::this_grid();
  phase_weights(p, smem);
  phase_norm(p, 0);
  grid.sync();
  for (int layer = 0; layer < 2; ++layer) {
    gemm_phase<0>(p, layer, smem);
    grid.sync();
#if PROBE_GEMM0
    gemm_phase<0>(p, layer, smem);
    grid.sync();
#endif
    phase_mixers(p, layer, smem, 0);
    grid.sync();
#if PROBE_MIX
    phase_mixers(p, layer, smem, 2);
    grid.sync();
#endif
    gemm_phase<1>(p, layer, smem);
    grid.sync();
    gemm_phase<2>(p, layer, smem);
    if (layer == 0) grid.sync();
  }
}

#if MULTI_LAUNCH
template <int PH>
__global__ void __launch_bounds__(NT) phase_kernel(Params p, int layer) {
  __shared__ __attribute__((aligned(16))) char smem[SMEM_BYTES];
  if (PH == 0) { phase_weights(p, smem); }
  else if (PH == 1) phase_norm(p, layer);
  else if (PH == 2) gemm_phase<0>(p, layer, smem);
  else if (PH == 3) phase_mixers(p, layer, smem, 0);
  else if (PH == 4) gemm_phase<1>(p, layer, smem);
  else gemm_phase<2>(p, layer, smem);
}
#endif

extern "C" void kernel_launch(void* const* d_in, const int* in_sizes, int n_in, void* d_out, int out_size, void* d_ws, size_t ws_size, hipStream_t stream) {
  Params p{};
  const float** f = (const float**)&p;
  for (int i = 0; i < 33; ++i) f[i] = (const float*)d_in[i];
  p.out = (float*)d_out;
  char* ws = (char*)d_ws;
  size_t off = 0;
  auto take = [&](size_t bytes) { char* q = ws + off; off += (bytes + 255) & ~(size_t)255; return q; };
  p.WinT = (bf16_t*)take((size_t)2 * 3648 * 1024 * 2);
  p.WoutT = (bf16_t*)take((size_t)2 * 1024 * 1024 * 2);
  p.WgluT = (bf16_t*)take((size_t)2 * 512 * 256 * 2);
  p.hbf = (bf16_t*)take((size_t)NTOK * 1024 * 2);
  p.P = (bf16_t*)take((size_t)NTOK * D_IN * 2);
  p.mix = (bf16_t*)take((size_t)NTOK * 1024 * 2);
  p.yb = (bf16_t*)take((size_t)NTOK * 256 * 2);
  p.counters = (unsigned*)take(256);
  p.ssq = (float*)take((size_t)NTOK * 4);
  if (off > ws_size || (size_t)out_size != O_END || n_in != 33) fprintf(stderr, "kernel_launch: unexpected sizes ws=%zu need=%zu out=%d n_in=%d\n", ws_size, off, out_size, n_in);
#if MULTI_LAUNCH
  const int G = 256;
  phase_kernel<0><<<G, NT, 0, stream>>>(p, 0);
  for (int layer = 0; layer < 2; ++layer) {
    phase_kernel<1><<<G, NT, 0, stream>>>(p, layer);
    phase_kernel<2><<<G, NT, 0, stream>>>(p, layer);
    phase_kernel<3><<<G, NT, 0, stream>>>(p, layer);
    phase_kernel<4><<<G, NT, 0, stream>>>(p, layer);
    phase_kernel<5><<<G, NT, 0, stream>>>(p, layer);
  }
#else
  static int grid_blocks = 0;
  if (!grid_blocks) {
    int dev = 0, cus = 0, per_cu = 0;
    hipGetDevice(&dev);
    hipDeviceGetAttribute(&cus, hipDeviceAttributeMultiprocessorCount, dev);
    hipOccupancyMaxActiveBlocksPerMultiprocessor(&per_cu, mega, NT, 0);
    if (per_cu < 1) per_cu = 1;
    grid_blocks = cus * per_cu;
  }
  void* args[] = {&p};
  hipError_t e = hipLaunchCooperativeKernel((void*)mega, dim3(grid_blocks), dim3(NT), args, 0, stream);
  if (e != hipSuccess) fprintf(stderr, "cooperative launch failed: %s (grid %d)\n", hipGetErrorString(e), grid_blocks);
#endif
}
```

```cpp
#include <hip/hip_runtime.h>
#include <hip/hip_cooperative_groups.h>
#include <cstdio>
namespace cg = cooperative_groups;

#define PROBE_GEMM0 0
#define PROBE_MIX 0
#ifndef MULTI_LAUNCH
#define MULTI_LAUNCH 0
#endif

#define DI __device__ __forceinline__
typedef unsigned short bf16_t;
typedef short bf16x8 __attribute__((ext_vector_type(8)));
typedef float f32x16 __attribute__((ext_vector_type(16)));
typedef unsigned u32x4 __attribute__((ext_vector_type(4)));
typedef unsigned u32x2 __attribute__((ext_vector_type(2)));
#define MFMA(a, b, c) __builtin_amdgcn_mfma_f32_32x32x16_bf16((a), (b), (c), 0, 0, 0)

constexpr int NT = 512;
constexpr int NTOK_P = 65536, NTOK = 66048, D_IN = 3648;
constexpr int OFF_Q = 0, OFF_K = 512, OFF_V = 1024, OFF_GA = 1536, OFF_U = 2048, OFF_GB = 2304, OFF_C = 2560, OFF_GC = 3392;
constexpr size_t O_Y = 0, O_KP = 67633152, O_VP = 134742016, O_SREP = 201850880, O_SIMP = 201916416, O_WKVP = 201981952,
                 O_SHP = 203030528, O_KS = 203083776, O_VS = 203608064, O_SRES = 204132352, O_SIMS = 204165120,
                 O_WKVS = 204197888, O_SHS = 204722176, O_END = 204748800;
constexpr int SMEM_BYTES = 2 * 55296 + 8 * 4608;
constexpr int LDS_ROW = 144;
constexpr int STAGE = (256 + 128) * LDS_ROW;

struct Params {
  const float *x_prompt, *x_sample, *cache_k, *cache_v, *st_re, *st_im, *st_wkv, *st_shift;
  const float *norm_w, *w_in, *q_norm_w, *k_norm_w, *lam_re, *lam_im, *log_dt, *b_re, *b_im, *c_re, *c_im, *ssm_d, *w_glu, *b_glu;
  const float *mu, *w0, *w2, *a0, *a2, *k_k, *k_a, *u_bonus, *ln_w, *ln_b, *w_out;
  float* out;
  bf16_t *WinT, *WoutT, *WgluT, *hbf, *P, *mix, *yb;
  unsigned* counters;
  float* ssq;
};

DI int opq_v(int x) { asm volatile("" : "+v"(x)); return x; }
DI int opq_s(int x) { asm volatile("" : "+s"(x)); return x; }
#define TID opq_v((int)threadIdx.x)
#define BID opq_s((int)blockIdx.x)
#define GDIM opq_s((int)gridDim.x)
DI unsigned f2bf(float x) { unsigned u = __float_as_uint(x); u += 0x7fffu + ((u >> 16) & 1u); return u >> 16; }
DI unsigned pk2(float a, float b) { return f2bf(a) | (f2bf(b) << 16); }
DI float bf2f(unsigned v) { return __uint_as_float(v << 16); }
DI float bflo(unsigned w) { return __uint_as_float(w << 16); }
DI float bfhi(unsigned w) { return __uint_as_float(w & 0xffff0000u); }
DI float sigmoidf_(float x) { return __builtin_amdgcn_rcpf(1.f + __expf(-x)); }
DI float siluf_(float x) { return x * __builtin_amdgcn_rcpf(1.f + __expf(-x)); }
typedef float f32x2 __attribute__((ext_vector_type(2)));
DI f32x2 fma2(f32x2 a, f32x2 b, f32x2 c) { return __builtin_elementwise_fma(a, b, c); }
template <int CTRL> DI float dpp_mov(float x) { return __int_as_float(__builtin_amdgcn_update_dpp(0, __float_as_int(x), CTRL, 0xF, 0xF, true)); }
DI float sum8(float x) { x += dpp_mov<0xB1>(x); x += dpp_mov<0x4E>(x); x += dpp_mov<0x141>(x); return x; }
DI float fast_tanh(float x) { return 1.f - 2.f * __builtin_amdgcn_rcpf(1.f + __expf(2.f * x)); }
DI void lds_barrier() { asm volatile("s_waitcnt lgkmcnt(0)\n\ts_barrier" ::: "memory"); }
DI float wave_sum(float v) {
  v += dpp_mov<0xB1>(v); v += dpp_mov<0x4E>(v); v += dpp_mov<0x141>(v); v += dpp_mov<0x140>(v);
  v += __int_as_float(__builtin_amdgcn_update_dpp(0, __float_as_int(v), 0x142, 0xA, 0xF, false));
  v += __int_as_float(__builtin_amdgcn_update_dpp(0, __float_as_int(v), 0x143, 0xC, 0xF, false));
  return __int_as_float(__builtin_amdgcn_readlane(__float_as_int(v), 63));
}
DI const float* xrow(const Params& p, int layer, int row) {
  if (layer == 0) return row < NTOK_P ? p.x_prompt + (size_t)row * 1024 : p.x_sample + (size_t)(row - NTOK_P) * 1024;
  return p.out + (size_t)row * 1024;
}

DI void transpose_tile(const float* __restrict__ src, int K, int N, bf16_t* __restrict__ dst, int k0, int n0, float* tile) {
  const int tid = TID;
#pragma unroll
  for (int i = 0; i < 8; ++i) { int idx = tid + NT * i; int kk = idx >> 6, nn = idx & 63; tile[kk * 65 + nn] = src[(size_t)(k0 + kk) * N + n0 + nn]; }
  __syncthreads();
#pragma unroll
  for (int i = 0; i < 8; ++i) { int idx = tid + NT * i; int nn = idx >> 6, kk = idx & 63; dst[(size_t)(n0 + nn) * K + k0 + kk] = (bf16_t)f2bf(tile[kk * 65 + nn]); }
  __syncthreads();
}
DI void phase_weights(const Params& p, char* smem) {
  float* tile = (float*)smem;
  const int bid = BID, gdim = GDIM;
  for (int t = bid; t < 2400; t += gdim) {
    int layer = t / 1200, j = t % 1200;
    if (j < 912) { int kt = j / 57, nt = j % 57; transpose_tile(p.w_in + (size_t)layer * 1024 * 3648, 1024, 3648, p.WinT + (size_t)layer * 3648 * 1024, kt * 64, nt * 64, tile); }
    else if (j < 1168) { j -= 912; int kt = j / 16, nt = j % 16; transpose_tile(p.w_out + (size_t)layer * 1024 * 1024, 1024, 1024, p.WoutT + (size_t)layer * 1024 * 1024, kt * 64, nt * 64, tile); }
    else { j -= 1168; int kt = j / 8, nt = j % 8; transpose_tile(p.w_glu + (size_t)layer * 256 * 512, 256, 512, p.WgluT + (size_t)layer * 512 * 256, kt * 64, nt * 64, tile); }
  }
  { const int tid = TID; if (bid == 0 && tid < 64) p.counters[tid] = 0;
    for (int i = bid * NT + tid; i < NTOK; i += gdim * NT) p.ssq[i] = 0.f; }
}

DI void phase_norm(const Params& p, int layer) {
  const int tid = TID, lane = tid & 63, w = tid >> 6;
  const int bid = BID, gdim = GDIM;
  const float* nw = p.norm_w + layer * 1024;
  const int stride = gdim * 8;
  for (int row0 = bid * 8 + w; row0 < NTOK; row0 += 2 * stride) {
    const int row1 = row0 + stride;
    const bool has1 = row1 < NTOK;
    const float* x0 = xrow(p, layer, row0);
    const float* x1 = xrow(p, layer, has1 ? row1 : row0);
    float4 v0[4], v1[4]; float s0 = 0.f, s1 = 0.f;
#pragma unroll
    for (int i = 0; i < 4; ++i) { v0[i] = *(const float4*)(x0 + i * 256 + lane * 4); v1[i] = *(const float4*)(x1 + i * 256 + lane * 4); }
#pragma unroll
    for (int i = 0; i < 4; ++i) {
      s0 += v0[i].x * v0[i].x + v0[i].y * v0[i].y + v0[i].z * v0[i].z + v0[i].w * v0[i].w;
      s1 += v1[i].x * v1[i].x + v1[i].y * v1[i].y + v1[i].z * v1[i].z + v1[i].w * v1[i].w;
    }
    s0 = wave_sum(s0); s1 = wave_sum(s1);
    const float c0 = rsqrtf(s0 * (1.f / 1024.f) + 1e-6f), c1 = rsqrtf(s1 * (1.f / 1024.f) + 1e-6f);
#pragma unroll
    for (int i = 0; i < 4; ++i) {
      float4 wv = *(const float4*)(nw + i * 256 + lane * 4);
      u32x2 o; o.x = pk2(v0[i].x * c0 * wv.x, v0[i].y * c0 * wv.y); o.y = pk2(v0[i].z * c0 * wv.z, v0[i].w * c0 * wv.w);
      *(u32x2*)(p.hbf + (size_t)row0 * 1024 + i * 256 + lane * 4) = o;
      if (has1) {
        u32x2 o1; o1.x = pk2(v1[i].x * c1 * wv.x, v1[i].y * c1 * wv.y); o1.y = pk2(v1[i].z * c1 * wv.z, v1[i].w * c1 * wv.w);
        *(u32x2*)(p.hbf + (size_t)row1 * 1024 + i * 256 + lane * 4) = o1;
      }
    }
  }
}

template <int MODE>
DI void gemm_phase(const Params& p, int layer, char* smem) {
  constexpr int K = (MODE == 1) ? 256 : 1024;
  constexpr int NTN = (MODE == 0) ? 29 : (MODE == 1 ? 4 : 8);
  constexpr int KT = K / 64;
  const bf16_t* __restrict__ A = MODE == 0 ? p.hbf : (MODE == 1 ? p.yb : p.mix);
  const bf16_t* __restrict__ Bt = MODE == 0 ? p.WinT + (size_t)layer * 3648 * 1024 : (MODE == 1 ? p.WgluT + (size_t)layer * 512 * 256 : p.WoutT + (size_t)layer * 1024 * 1024);
  const int tid = TID, lane = tid & 63, wv = tid >> 6, r = lane & 31, h = lane >> 5;
  const int wm = wv >> 1, wn = wv & 1;
  const int bid = BID, gdim = GDIM;
  const int xcd = bid & 7, jb = bid >> 3, nbx = (gdim - xcd + 7) >> 3;

  const int total_x = ((258 - xcd + 7) >> 3) * NTN;
  const int nmine = jb < total_x ? (total_x - jb + nbx - 1) / nbx : 0;
  if (nmine == 0) return;
  const int lrow = tid >> 3, kc = tid & 7;
  const int ntm_x = (258 - xcd + 7) >> 3;
  auto decode = [&](int idx, int& tmi_o, int& tn_o) {
    constexpr int QW = 4 * NTN;
    const int nfull = ntm_x >> 2, remw = ntm_x & 3;
    const int quad = idx / QW;
    if (quad < nfull) { const int rem = idx - quad * QW; tn_o = rem >> 2; tmi_o = quad * 4 + (rem & 3); }
    else { const int rem = idx - nfull * QW; tn_o = rem / remw; tmi_o = nfull * 4 + rem % remw; }
  };
  auto set_ptrs = [&](int idx, const bf16_t* (&ap)[4], const bf16_t* (&bp)[2]) {
    int tmi_, tn_; decode(idx, tmi_, tn_);
    const int m0_ = (xcd + 8 * tmi_) * 256, n0_ = tn_ * 128;
#pragma unroll
    for (int i = 0; i < 4; ++i) ap[i] = A + (size_t)(m0_ + lrow + 64 * i) * K + kc * 8;
#pragma unroll
    for (int i = 0; i < 2; ++i) {
      int row = lrow + 64 * i, brow;
      if (MODE == 0) { brow = n0_ + row; brow = brow < 3648 ? brow : 3647; }
      else if (MODE == 2) brow = n0_ + row;
      else { int wn_ = row >> 6, nt_ = (row >> 5) & 1, c_ = row & 31; brow = nt_ * 256 + tn_ * 64 + wn_ * 32 + c_; }
      bp[i] = Bt + (size_t)brow * K + kc * 8;
    }
  };
  f32x16 acc[2][2];
  auto zero_acc = [&]() {
#pragma unroll
    for (int a = 0; a < 2; ++a)
#pragma unroll
      for (int b = 0; b < 2; ++b)
#pragma unroll
        for (int i = 0; i < 16; ++i) acc[a][b][i] = 0.f;
  };
  auto compute = [&](const char* buf, char* nbuf, const u32x4 (&pa)[4], const u32x4 (&pb)[2]) {
    const char* As = buf; const char* Bs = buf + 256 * LDS_ROW;
    char* An = nbuf; char* Bn = nbuf + 256 * LDS_ROW;
    __builtin_amdgcn_iglp_opt(0);
#pragma unroll
    for (int s = 0; s < 4; ++s) {
      bf16x8 af[2], bfr[2];
#pragma unroll
      for (int mt = 0; mt < 2; ++mt) af[mt] = *(const bf16x8*)(As + (wm * 64 + mt * 32 + r) * LDS_ROW + s * 32 + h * 16);
#pragma unroll
      for (int nt = 0; nt < 2; ++nt) bfr[nt] = *(const bf16x8*)(Bs + (wn * 64 + nt * 32 + r) * LDS_ROW + s * 32 + h * 16);
#pragma unroll
      for (int mt = 0; mt < 2; ++mt)
#pragma unroll
        for (int nt = 0; nt < 2; ++nt) acc[mt][nt] = MFMA(bfr[nt], af[mt], acc[mt][nt]);
      if (s < 2) {
        *(u32x4*)(An + (lrow + 64 * (2 * s)) * LDS_ROW + kc * 16) = pa[2 * s];
        *(u32x4*)(An + (lrow + 64 * (2 * s + 1)) * LDS_ROW + kc * 16) = pa[2 * s + 1];
      } else {
        *(u32x4*)(Bn + (lrow + 64 * (s - 2)) * LDS_ROW + kc * 16) = pb[s - 2];
      }
    }
  };
  u32x4 sa[4][4], sb[4][2];
  const bf16_t* cap[4]; const bf16_t* cbp[2]; const bf16_t* nap[4]; const bf16_t* nbp[2];
  set_ptrs(jb, cap, cbp);
#pragma unroll
  for (int j = 0; j < 4; ++j) {
#pragma unroll
    for (int i = 0; i < 4; ++i) sa[j][i] = *(const u32x4*)(cap[i] + j * 64);
#pragma unroll
    for (int i = 0; i < 2; ++i) sb[j][i] = *(const u32x4*)(cbp[i] + j * 64);
  }
  {
    char* As = smem; char* Bs = smem + 256 * LDS_ROW;
#pragma unroll
    for (int i = 0; i < 4; ++i) *(u32x4*)(As + (lrow + 64 * i) * LDS_ROW + kc * 16) = sa[0][i];
#pragma unroll
    for (int i = 0; i < 2; ++i) *(u32x4*)(Bs + (lrow + 64 * i) * LDS_ROW + kc * 16) = sb[0][i];
  }
  lds_barrier();
  zero_acc();
  int c_idx = jb;
  for (int ti = 0; ti < nmine; ++ti) {
    set_ptrs(ti + 1 < nmine ? c_idx + nbx : c_idx, nap, nbp);
    for (int q = 0; q < KT / 4; ++q) {
      const bool lastq = (q == KT / 4 - 1);
      const int koff = lastq ? 0 : (4 * (q + 1)) * 64;
      const bf16_t* lap[4]; const bf16_t* lbp[2];
#pragma unroll
      for (int i = 0; i < 4; ++i) lap[i] = (lastq ? nap[i] : cap[i]) + koff;
#pragma unroll
      for (int i = 0; i < 2; ++i) lbp[i] = (lastq ? nbp[i] : cbp[i]) + koff;
#pragma unroll
      for (int j = 0; j < 4; ++j) {
#pragma unroll
        for (int i = 0; i < 4; ++i) sa[j][i] = *(const u32x4*)(lap[i] + j * 64);
#pragma unroll
        for (int i = 0; i < 2; ++i) sb[j][i] = *(const u32x4*)(lbp[i] + j * 64);
        compute(smem + (j & 1) * STAGE, smem + ((j + 1) & 1) * STAGE, sa[(j + 1) & 3], sb[(j + 1) & 3]);
        lds_barrier();
      }
    }
#pragma unroll
    for (int i = 0; i < 4; ++i) cap[i] = nap[i];
#pragma unroll
    for (int i = 0; i < 2; ++i) cbp[i] = nbp[i];
    const int idx = c_idx; c_idx += nbx;
    int tmi, tn; decode(idx, tmi, tn);
    const int tm = xcd + 8 * tmi;
    const int m0 = tm * 256, n0 = tn * 128;
    char* eps = smem + 2 * STAGE + wv * 4608;
    if (MODE == 0) {
      const int nb = n0 + wn * 64;
      if (nb < 3648) {
        if (layer == 1) {
#pragma unroll
          for (int mt = 0; mt < 2; ++mt) {
            const float rs = rsqrtf(p.ssq[m0 + wm * 64 + mt * 32 + r] * (1.f / 1024.f) + 1e-6f);
#pragma unroll
            for (int nt = 0; nt < 2; ++nt)
#pragma unroll
              for (int i = 0; i < 16; ++i) acc[mt][nt][i] *= rs;
          }
        }
        float scale[2] = {1.f, 1.f};
        if (nb < 1024) {
#pragma unroll
          for (int mt = 0; mt < 2; ++mt) {
            float ss = 0.f;
#pragma unroll
            for (int nt = 0; nt < 2; ++nt)
#pragma unroll
              for (int i = 0; i < 16; ++i) ss += acc[mt][nt][i] * acc[mt][nt][i];
            ss += __shfl_xor(ss, 32);
            scale[mt] = rsqrtf(ss * (1.f / 64.f) + 1e-6f);
          }
        }
        const float* nw = (nb < 512 ? p.q_norm_w : p.k_norm_w) + layer * 64;
#pragma unroll
        for (int mt = 0; mt < 2; ++mt) {
          const int mb = m0 + wm * 64 + mt * 32;
          const int m = mb + r;
          const bool is_p = m < NTOK_P;
#pragma unroll
          for (int nt = 0; nt < 2; ++nt) {
#pragma unroll
            for (int g = 0; g < 4; ++g) {
              const int ncol = nb + nt * 32 + 8 * g + 4 * h;
              float v0 = acc[mt][nt][4 * g], v1 = acc[mt][nt][4 * g + 1], v2 = acc[mt][nt][4 * g + 2], v3 = acc[mt][nt][4 * g + 3];
              if (nb < 1024) {
                float4 w4 = *(const float4*)(nw + (ncol - nb));
                v0 *= scale[mt] * w4.x; v1 *= scale[mt] * w4.y; v2 *= scale[mt] * w4.z; v3 *= scale[mt] * w4.w;
              }
              *(float4*)(eps + r * 144 + (8 * g + 4 * h) * 4) = make_float4(v0, v1, v2, v3);
              if (nb >= OFF_C && nb < OFF_GC) {
                const bool last = is_p ? ((m & 2047) == 2047) : (((m - NTOK_P) & 31) == 31);
                if (last) {
                  float* dst = p.out + (is_p ? O_SHP + ((size_t)layer * 32 + (m >> 11)) * 832 : O_SHS + ((size_t)layer * 16 + ((m - NTOK_P) >> 5)) * 832) + (ncol - OFF_C);
                  *(float4*)dst = make_float4(v0, v1, v2, v3);
                }
              }
            }
            __builtin_amdgcn_wave_barrier();
#pragma unroll
            for (int it = 0; it < 2; ++it) {
              const int row = (lane >> 2) + 16 * it, ch = lane & 3;
              const float4 a = *(const float4*)(eps + row * 144 + ch * 32), c = *(const float4*)(eps + row * 144 + ch * 32 + 16);
              u32x4 o; o.x = pk2(a.x, a.y); o.y = pk2(a.z, a.w); o.z = pk2(c.x, c.y); o.w = pk2(c.z, c.w);
              *(u32x4*)(p.P + (size_t)(mb + row) * D_IN + nb + nt * 32 + ch * 8) = o;
            }
            if (nb >= 512 && nb < 1536) {
#pragma unroll
              for (int it = 0; it < 4; ++it) {
                const int row = it * 8 + (lane >> 3), ch = lane & 7;
                const float4 a = *(const float4*)(eps + row * 144 + ch * 16);
                const int mm = mb + row;
                const bool pp = mm < NTOK_P;
                float* dst;
                if (nb < 1024) dst = p.out + (pp ? O_KP + ((size_t)layer * 65536 + mm) * 512 : O_KS + ((size_t)layer * 512 + (mm - NTOK_P)) * 512) + (nb - 512);
                else dst = p.out + (pp ? O_VP + ((size_t)layer * 65536 + mm) * 512 : O_VS + ((size_t)layer * 512 + (mm - NTOK_P)) * 512) + (nb - 1024);
                *(float4*)(dst + nt * 32 + ch * 4) = a;
              }
            }
            __builtin_amdgcn_wave_barrier();
          }
        }
      }
    } else if (MODE == 1) {
      const float* bg = p.b_glu + layer * 512;
#pragma unroll
      for (int mt = 0; mt < 2; ++mt) {
        const int m = m0 + wm * 64 + mt * 32 + r;
#pragma unroll
        for (int g = 0; g < 4; ++g) {
          const int col = tn * 64 + wn * 32 + 8 * g + 4 * h;
          float4 bv = *(const float4*)(bg + col), bgt = *(const float4*)(bg + 256 + col);
          u32x2 gb = *(const u32x2*)(p.P + (size_t)m * D_IN + OFF_GB + col);
          float o0 = (acc[mt][0][4 * g] + bv.x) * sigmoidf_(acc[mt][1][4 * g] + bgt.x) * siluf_(bflo(gb.x));
          float o1 = (acc[mt][0][4 * g + 1] + bv.y) * sigmoidf_(acc[mt][1][4 * g + 1] + bgt.y) * siluf_(bfhi(gb.x));
          float o2 = (acc[mt][0][4 * g + 2] + bv.z) * sigmoidf_(acc[mt][1][4 * g + 2] + bgt.z) * siluf_(bflo(gb.y));
          float o3 = (acc[mt][0][4 * g + 3] + bv.w) * sigmoidf_(acc[mt][1][4 * g + 3] + bgt.w) * siluf_(bfhi(gb.y));
          u32x2 o; o.x = pk2(o0, o1); o.y = pk2(o2, o3);
          *(u32x2*)(p.mix + (size_t)m * 1024 + 512 + col) = o;
        }
      }
    } else {
      const float* nw1 = p.norm_w + 1024;
#pragma unroll
      for (int mt = 0; mt < 2; ++mt) {
        const int mb = m0 + wm * 64 + mt * 32;
        float sq[4] = {0.f, 0.f, 0.f, 0.f};
#pragma unroll
        for (int nt = 0; nt < 2; ++nt) {
#pragma unroll
          for (int g = 0; g < 4; ++g)
            *(float4*)(eps + r * 144 + (8 * g + 4 * h) * 4) = make_float4(acc[mt][nt][4 * g], acc[mt][nt][4 * g + 1], acc[mt][nt][4 * g + 2], acc[mt][nt][4 * g + 3]);
          __builtin_amdgcn_wave_barrier();
#pragma unroll
          for (int it = 0; it < 4; ++it) {
            const int row = it * 8 + (lane >> 3), ch = lane & 7;
            const float4 a = *(const float4*)(eps + row * 144 + ch * 16);
            const int mm = mb + row, ncol = n0 + wn * 64 + nt * 32 + ch * 4;
            float4 xv = *(const float4*)(xrow(p, layer, mm) + ncol);
            xv.x += a.x; xv.y += a.y; xv.z += a.z; xv.w += a.w;
            *(float4*)(p.out + (size_t)mm * 1024 + ncol) = xv;
            if (layer == 0) {
              sq[it] += xv.x * xv.x + xv.y * xv.y + xv.z * xv.z + xv.w * xv.w;
              const float4 w4 = *(const float4*)(nw1 + ncol);
              u32x2 o; o.x = pk2(xv.x * w4.x, xv.y * w4.y); o.y = pk2(xv.z * w4.z, xv.w * w4.w);
              *(u32x2*)(p.hbf + (size_t)mm * 1024 + ncol) = o;
            }
          }
          __builtin_amdgcn_wave_barrier();
        }
        if (layer == 0) {
#pragma unroll
          for (int it = 0; it < 4; ++it) {
            const float s = sum8(sq[it]);
            if ((lane & 7) == 0) atomicAdd(p.ssq + mb + it * 8 + (lane >> 3), s);
          }
        }
      }
    }
    zero_acc();
  }
}

constexpr int VS = 66;
DI void attn_item(const Params& p, int layer, int wi, bf16_t* vl) {
  const int lane = TID & 63, r = lane & 31, h = lane >> 5;
  const bool sample = wi >= 16384;
  int b, hd, qt, tok0, qabs0;
  if (!sample) { b = wi >> 9; hd = (wi >> 6) & 7; qt = wi & 63; tok0 = b * 2048; qabs0 = qt * 32; }
  else { int j = wi - 16384; b = j >> 3; hd = j & 7; qt = 0; tok0 = NTOK_P + b * 32; qabs0 = 4096; }
  const int tq0 = tok0 + qt * 32;
  bf16x8 qf[4];
  {
    const bf16_t* qp = p.P + (size_t)(tq0 + r) * D_IN + OFF_Q + hd * 64 + h * 8;
#pragma unroll
    for (int ks = 0; ks < 4; ++ks) qf[ks] = *(const bf16x8*)(qp + ks * 16);
  }
  f32x16 o[2];
#pragma unroll
  for (int d = 0; d < 2; ++d)
#pragma unroll
    for (int i = 0; i < 16; ++i) o[d][i] = 0.f;
  float run = 0.f;
  const int nblk = qabs0 / 32 + 1;
  const int pir = 16 * ((r >> 2) & 1) + 4 * (r >> 3) + (r & 3);
  const float* ck = p.cache_k + ((size_t)(layer * 16 + b) * 4096) * 512 + hd * 64;
  const float* cv = p.cache_v + ((size_t)(layer * 16 + b) * 4096) * 512 + hd * 64;

  for (int kb = nblk - 1; kb >= 0; --kb) {
    const int kp0 = kb * 32;
    const bool fromP = (!sample) || (kb == 128);
    bf16x8 kf[4];
    if (fromP) {
      const int tk = sample ? (tok0 + (kp0 + pir - 4096)) : (tok0 + kp0 + pir);
      const bf16_t* kp = p.P + (size_t)tk * D_IN + OFF_K + hd * 64 + h * 8;
#pragma unroll
      for (int ks = 0; ks < 4; ++ks) kf[ks] = *(const bf16x8*)(kp + ks * 16);
#pragma unroll
      for (int i = 0; i < 4; ++i) {
        const int key = i * 8 + (lane >> 3), dc = lane & 7;
        const int tv = sample ? (tok0 + (kp0 + key - 4096)) : (tok0 + kp0 + key);
        u32x4 v = *(const u32x4*)(p.P + (size_t)tv * D_IN + OFF_V + hd * 64 + dc * 8);
        unsigned* dst = (unsigned*)(vl + key * VS + dc * 8);
        dst[0] = v.x; dst[1] = v.y; dst[2] = v.z; dst[3] = v.w;
      }
    } else {
      const float* kp = ck + (size_t)(kp0 + pir) * 512 + h * 8;
#pragma unroll
      for (int ks = 0; ks < 4; ++ks) {
        float4 a = *(const float4*)(kp + ks * 16), c = *(const float4*)(kp + ks * 16 + 4);
        u32x4 t; t.x = pk2(a.x, a.y); t.y = pk2(a.z, a.w); t.z = pk2(c.x, c.y); t.w = pk2(c.z, c.w);
        kf[ks] = __builtin_bit_cast(bf16x8, t);
      }
#pragma unroll
      for (int i = 0; i < 4; ++i) {
        const int key = i * 8 + (lane >> 3), dc = lane & 7;
        const float* vp = cv + (size_t)(kp0 + key) * 512 + dc * 8;
        float4 a = *(const float4*)vp, c = *(const float4*)(vp + 4);
        unsigned* dst = (unsigned*)(vl + key * VS + dc * 8);
        dst[0] = pk2(a.x, a.y); dst[1] = pk2(a.z, a.w); dst[2] = pk2(c.x, c.y); dst[3] = pk2(c.z, c.w);
      }
    }
    f32x16 st;
#pragma unroll
    for (int i = 0; i < 16; ++i) st[i] = 0.f;
#pragma unroll
    for (int ks = 0; ks < 4; ++ks) st = MFMA(kf[ks], qf[ks], st);
    const bool diag = (kb == nblk - 1);
    float z[16], lk[16], lat[16];
#pragma unroll
    for (int i = 0; i < 16; ++i) {
      z[i] = st[i] * 0.125f;
      const bool msk = (!diag) || (16 * h + i < r);
      const float e = __expf(-fabsf(z[i]));
      const float sp = fmaxf(z[i], 0.f) + __logf(1.f + e);
      lk[i] = msk ? -sp : 0.f;
    }
    float suf = 0.f;
#pragma unroll
    for (int i = 15; i >= 0; --i) { lat[i] = suf; suf += lk[i]; }
    const float other = __shfl_xor(suf, 32);
    const float base = run + (h == 0 ? other : 0.f);
    float a[16];
#pragma unroll
    for (int i = 0; i < 16; ++i) {
      const bool msk = (!diag) || (16 * h + i < r);
      a[i] = msk ? __expf(z[i] + lk[i] + base + lat[i]) : 0.f;
    }
    run += suf + other;
    __builtin_amdgcn_wave_barrier();
#pragma unroll
    for (int s2 = 0; s2 < 2; ++s2) {
      u32x4 t; t.x = pk2(a[8 * s2], a[8 * s2 + 1]); t.y = pk2(a[8 * s2 + 2], a[8 * s2 + 3]); t.z = pk2(a[8 * s2 + 4], a[8 * s2 + 5]); t.w = pk2(a[8 * s2 + 6], a[8 * s2 + 7]);
      const bf16x8 pf = __builtin_bit_cast(bf16x8, t);
#pragma unroll
      for (int dt = 0; dt < 2; ++dt) {
        const bf16_t* vp = vl + (16 * h + 8 * s2) * VS + 32 * dt + r;
        bf16x8 vf;
#pragma unroll
        for (int j = 0; j < 8; ++j) vf[j] = (short)vp[j * VS];
        o[dt] = MFMA(vf, pf, o[dt]);
      }
    }
    __builtin_amdgcn_wave_barrier();
    if (__all(run < -104.f)) break;
  }
  const int tok = tq0 + r;
#pragma unroll
  for (int dt = 0; dt < 2; ++dt)
#pragma unroll
    for (int g = 0; g < 4; ++g) {
      const int d0 = 32 * dt + 8 * g + 4 * h;
      u32x2 ga = *(const u32x2*)(p.P + (size_t)tok * D_IN + OFF_GA + hd * 64 + d0);
      u32x2 ov;
      ov.x = pk2(o[dt][4 * g] * siluf_(bflo(ga.x)), o[dt][4 * g + 1] * siluf_(bfhi(ga.x)));
      ov.y = pk2(o[dt][4 * g + 2] * siluf_(bflo(ga.y)), o[dt][4 * g + 3] * siluf_(bfhi(ga.y)));
      *(u32x2*)(p.mix + (size_t)tok * 1024 + hd * 64 + d0) = ov;
    }
}

constexpr int S5_BU = 8192;
constexpr int S5_LDS = S5_BU + 8704 + 1024;
DI void s5_disc(const Params& p, int lg, int pi, float dt, float& ar, float& ai, float& fr, float& fi) {
  const float lr = fminf(p.lam_re[lg * 64 + pi], -1e-4f), li = p.lam_im[lg * 64 + pi];
  const float er = expf(lr * dt);
  ar = er * cosf(li * dt); ai = er * sinf(li * dt);
  const float den = lr * lr + li * li;
  fr = ((ar - 1.f) * lr + ai * li) / den; fi = (ai * lr - (ar - 1.f) * li) / den;
}
DI void s5_item(const Params& p, int layer, int item, char* lds) {
  float* BU = (float*)lds;
  char* Himg = lds + S5_BU;
  bf16_t* Ub = (bf16_t*)(lds + S5_BU + 8704);
  const int lane = TID & 63, r = lane & 31, h = lane >> 5;
  const int seq = item >> 4, g = item & 15;
  const bool sample = seq >= 32;
  const int b = sample ? seq - 32 : seq, L = sample ? 32 : 2048, tok0 = sample ? NTOK_P + b * 32 : b * 2048;
  const int lg = layer * 16 + g;
  const float dt = expf(p.log_dt[lg]);
  float ar, ai, fr_, fi_;
  s5_disc(p, lg, lane, dt, ar, ai, fr_, fi_);
  bf16x8 bbf[4];
#pragma unroll
  for (int half = 0; half < 2; ++half) {
    const int pi = 32 * half + r;
    float a_r, a_i, f_r, f_i;
    s5_disc(p, lg, pi, dt, a_r, a_i, f_r, f_i);
    const float* brp = p.b_re + ((size_t)lg * 64 + pi) * 16 + 8 * h;
    const float* bip = p.b_im + ((size_t)lg * 64 + pi) * 16 + 8 * h;
    float re[8], im[8];
#pragma unroll
    for (int j = 0; j < 8; ++j) { const float br = brp[j], bi = bip[j]; re[j] = f_r * br - f_i * bi; im[j] = f_r * bi + f_i * br; }
    u32x4 t0, t1;
    t0.x = pk2(re[0], re[1]); t0.y = pk2(re[2], re[3]); t0.z = pk2(re[4], re[5]); t0.w = pk2(re[6], re[7]);
    t1.x = pk2(im[0], im[1]); t1.y = pk2(im[2], im[3]); t1.z = pk2(im[4], im[5]); t1.w = pk2(im[6], im[7]);
    bbf[half] = __builtin_bit_cast(bf16x8, t0);
    bbf[2 + half] = __builtin_bit_cast(bf16x8, t1);
  }
  bf16x8 cf[8];
#pragma unroll
  for (int s = 0; s < 8; ++s) {
    u32x4 t; t.x = 0; t.y = 0; t.z = 0; t.w = 0;
    if (r < 16) {
      const int k0 = 16 * s + 8 * h;
      const float* src = (s < 4 ? p.c_re : p.c_im) + ((size_t)lg * 16 + r) * 64 + (k0 & 63);
      const float sg = s < 4 ? 1.f : -1.f;
      const float4 c0 = *(const float4*)src, c1 = *(const float4*)(src + 4);
      t.x = pk2(sg * c0.x, sg * c0.y); t.y = pk2(sg * c0.z, sg * c0.w); t.z = pk2(sg * c1.x, sg * c1.y); t.w = pk2(sg * c1.z, sg * c1.w);
    }
    cf[s] = __builtin_bit_cast(bf16x8, t);
  }
  const float dl = p.ssm_d[lg * 16 + (r & 15)];
  float hr = 0.f, hi = 0.f;
  if (sample) { hr = p.st_re[((size_t)(layer * 16 + b) * 16 + g) * 64 + lane]; hi = p.st_im[((size_t)(layer * 16 + b) * 16 + g) * 64 + lane]; }
  f32x16 zero;
#pragma unroll
  for (int i = 0; i < 16; ++i) zero[i] = 0.f;
  const bf16_t* upb = p.P + (size_t)(tok0 + r) * D_IN + OFF_U + g * 16 + 8 * h;
  bf16x8 uf = *(const bf16x8*)upb;
  for (int t0 = 0; t0 < L; t0 += 32) {
    const bf16x8 ucur = uf;
    if (t0 + 32 < L) uf = *(const bf16x8*)(upb + (size_t)(t0 + 32) * D_IN);
    *(bf16x8*)(Ub + r * 16 + 8 * h) = ucur;
    f32x16 d[4];
#pragma unroll
    for (int tile = 0; tile < 4; ++tile) d[tile] = MFMA(ucur, bbf[tile], zero);
#pragma unroll
    for (int hf = 0; hf < 2; ++hf) {
#pragma unroll
      for (int tile = 0; tile < 4; ++tile)
#pragma unroll
        for (int i = 0; i < 8; ++i) BU[((i & 3) + 8 * (i >> 2) + 4 * h) * 128 + 32 * tile + r] = d[tile][8 * hf + i];
      __builtin_amdgcn_wave_barrier();
#pragma unroll
      for (int tt = 0; tt < 16; ++tt) {
        const int t = 16 * hf + tt;
        const float bur = BU[tt * 128 + lane], bui = BU[tt * 128 + 64 + lane];
        const float nhr = ar * hr - ai * hi + bur, nhi = ar * hi + ai * hr + bui;
        hr = nhr; hi = nhi;
        *(bf16_t*)(Himg + t * 272 + lane * 2) = (bf16_t)f2bf(hr);
        *(bf16_t*)(Himg + t * 272 + 128 + lane * 2) = (bf16_t)f2bf(hi);
      }
      __builtin_amdgcn_wave_barrier();
    }
    f32x16 yacc = zero;
#pragma unroll
    for (int s = 0; s < 8; ++s) {
      const bf16x8 af = *(const bf16x8*)(Himg + r * 272 + s * 32 + h * 16);
      yacc = MFMA(af, cf[s], yacc);
    }
    if (r < 16) {
#pragma unroll
      for (int i = 0; i < 16; ++i) {
        const int t = (i & 3) + 8 * (i >> 2) + 4 * h;
        const float yv = yacc[i] + dl * bf2f(Ub[t * 16 + r]);
        const float gl = yv * __builtin_amdgcn_rcpf(1.f + __expf(-1.5957691216f * (yv + 0.044715f * yv * yv * yv)));
        p.yb[(size_t)(tok0 + t0 + t) * 256 + g * 16 + r] = (bf16_t)f2bf(gl);
      }
    }
    __builtin_amdgcn_wave_barrier();
  }
  float* ore = p.out + (sample ? O_SRES : O_SREP) + ((size_t)(layer * (sample ? 16 : 32) + b) * 16 + g) * 64 + lane;
  float* oim = p.out + (sample ? O_SIMS : O_SIMP) + ((size_t)(layer * (sample ? 16 : 32) + b) * 16 + g) * 64 + lane;
  *ore = hr; *oim = hi;
}

DI void rwkv_item(const Params& p, int layer, int item, char* smem) {
  constexpr int SETF = 6 * 2048;
  float* SET0 = (float*)smem;
  float* YB = SET0 + 2 * SETF;
  char* PW = (char*)(YB + 2 * 2048);
  const int tid = TID, lane = tid & 63, wv = tid >> 6;
  const int seq = item >> 2, hd = item & 3;
  const bool sample = seq >= 32;
  const int b = sample ? seq - 32 : seq, L = sample ? 32 : 2048, tok0 = sample ? NTOK_P + b * 32 : b * 2048;
  const int nch = L >> 5;
  if (wv < 4) {
    const int rp = tid >> 3, kq = tid & 7;
    f32x2 S0[4], S1[4];
    if (sample) {
      const float* sp = p.st_wkv + (((size_t)(layer * 16 + b) * 4 + hd) * 64 + rp) * 64 + kq * 8;
#pragma unroll
      for (int j = 0; j < 4; ++j) { S0[j].x = sp[2 * j]; S0[j].y = sp[2 * j + 1]; S1[j].x = sp[2048 + 2 * j]; S1[j].y = sp[2048 + 2 * j + 1]; }
    } else {
#pragma unroll
      for (int j = 0; j < 4; ++j) { S0[j].x = 0.f; S0[j].y = 0.f; S1[j].x = 0.f; S1[j].y = 0.f; }
    }
    lds_barrier();
    for (int c = 0; c < nch; ++c) {
      const float* R = SET0 + (c & 1) * SETF; const float* W = R + 2048; const float* KT = W + 2048; const float* KH = KT + 2048;
      const float* BB = KH + 2048; const float* V = BB + 2048;
      float* Y = YB + (c & 1) * 2048;
      float yk0[4], yk1[4];
      float4 nkh0, nkh1, nw0, nw1, nb0, nb1, nk0, nk1, nr0, nr1; float nv0, nv1;
      {
        const int o = kq * 8;
        nkh0 = *(const float4*)(KH + o); nkh1 = *(const float4*)(KH + o + 4); nw0 = *(const float4*)(W + o); nw1 = *(const float4*)(W + o + 4);
        nb0 = *(const float4*)(BB + o); nb1 = *(const float4*)(BB + o + 4); nk0 = *(const float4*)(KT + o); nk1 = *(const float4*)(KT + o + 4);
        nr0 = *(const float4*)(R + o); nr1 = *(const float4*)(R + o + 4); nv0 = V[rp]; nv1 = V[rp + 32];
      }
#pragma unroll
      for (int q = 0; q < 4; ++q) {
        yk0[q] = 0.f; yk1[q] = 0.f;
#pragma unroll
        for (int e = 0; e < 8; ++e) {
          const int tl = q * 8 + e;
          const float4 kh0 = nkh0, kh1 = nkh1, w0_ = nw0, w1_ = nw1, b0 = nb0, b1 = nb1, k0 = nk0, k1 = nk1, r0 = nr0, r1 = nr1;
          const float va = nv0, vb = nv1;
          if (tl < 31) {
            const int o = (tl + 1) * 64 + kq * 8;
            nkh0 = *(const float4*)(KH + o); nkh1 = *(const float4*)(KH + o + 4); nw0 = *(const float4*)(W + o); nw1 = *(const float4*)(W + o + 4);
            nb0 = *(const float4*)(BB + o); nb1 = *(const float4*)(BB + o + 4); nk0 = *(const float4*)(KT + o); nk1 = *(const float4*)(KT + o + 4);
            nr0 = *(const float4*)(R + o); nr1 = *(const float4*)(R + o + 4); nv0 = V[(tl + 1) * 64 + rp]; nv1 = V[(tl + 1) * 64 + rp + 32];
          }
          const f32x2 khv[4] = {{kh0.x, kh0.y}, {kh0.z, kh0.w}, {kh1.x, kh1.y}, {kh1.z, kh1.w}};
          const f32x2 wvv[4] = {{w0_.x, w0_.y}, {w0_.z, w0_.w}, {w1_.x, w1_.y}, {w1_.z, w1_.w}};
          const f32x2 bv[4] = {{b0.x, b0.y}, {b0.z, b0.w}, {b1.x, b1.y}, {b1.z, b1.w}};
          const f32x2 kv[4] = {{k0.x, k0.y}, {k0.z, k0.w}, {k1.x, k1.y}, {k1.z, k1.w}};
          const f32x2 rv[4] = {{r0.x, r0.y}, {r0.z, r0.w}, {r1.x, r1.y}, {r1.z, r1.w}};
          const f32x2 va2 = {va, va}, vb2 = {vb, vb};
          f32x2 ma[4], mb[4];
#pragma unroll
          for (int j = 0; j < 4; ++j) { ma[j] = fma2(S0[j], wvv[j], va2 * kv[j]); mb[j] = fma2(S1[j], wvv[j], vb2 * kv[j]); }
          f32x2 sa2 = fma2(S0[1], khv[1], S0[0] * khv[0]) + fma2(S0[3], khv[3], S0[2] * khv[2]);
          f32x2 sb2 = fma2(S1[1], khv[1], S1[0] * khv[0]) + fma2(S1[3], khv[3], S1[2] * khv[2]);
          const float sa = sum8(sa2.x + sa2.y), sb = sum8(sb2.x + sb2.y);
          const f32x2 nsa = {-sa, -sa}, nsb = {-sb, -sb};
#pragma unroll
          for (int j = 0; j < 4; ++j) { S0[j] = fma2(nsa, bv[j], ma[j]); S1[j] = fma2(nsb, bv[j], mb[j]); }
          f32x2 ya2 = fma2(S0[1], rv[1], S0[0] * rv[0]) + fma2(S0[3], rv[3], S0[2] * rv[2]);
          f32x2 yb2 = fma2(S1[1], rv[1], S1[0] * rv[0]) + fma2(S1[3], rv[3], S1[2] * rv[2]);
          const float ya = sum8(ya2.x + ya2.y), ybv = sum8(yb2.x + yb2.y);
          yk0[q] = (e == kq) ? ya : yk0[q];
          yk1[q] = (e == kq) ? ybv : yk1[q];
        }
      }
#pragma unroll
      for (int q = 0; q < 4; ++q) { Y[(q * 8 + kq) * 64 + rp] = yk0[q]; Y[(q * 8 + kq) * 64 + rp + 32] = yk1[q]; }
      lds_barrier();
    }
    float* so = p.out + (sample ? O_WKVS : O_WKVP) + (((size_t)(layer * (sample ? 16 : 32) + b) * 4 + hd) * 64 + rp) * 64 + kq * 8;
    *(float4*)so = make_float4(S0[0].x, S0[0].y, S0[1].x, S0[1].y);
    *(float4*)(so + 4) = make_float4(S0[2].x, S0[2].y, S0[3].x, S0[3].y);
    *(float4*)(so + 2048) = make_float4(S1[0].x, S1[0].y, S1[1].x, S1[1].y);
    *(float4*)(so + 2052) = make_float4(S1[2].x, S1[2].y, S1[3].x, S1[3].y);
  } else {
    const int pw = wv - 4, r_ = lane & 31, h_ = lane >> 5;
    const int cg_ = hd * 64 + lane;
    bf16_t* LORAb = (bf16_t*)(PW + pw * 5248);
    float* DSA = (float*)(PW + pw * 5248 + 1152);
    bf16x8 lb[2][2][2];
#pragma unroll
    for (int ll = 0; ll < 2; ++ll)
#pragma unroll
      for (int nn = 0; nn < 2; ++nn) {
        const float* srcw = (ll ? p.a2 : p.w2) + (size_t)layer * 32 * 256 + hd * 64 + 32 * nn + r_;
#pragma unroll
        for (int s = 0; s < 2; ++s) {
          float t[8];
#pragma unroll
          for (int j = 0; j < 8; ++j) t[j] = srcw[(size_t)(16 * s + 8 * h_ + j) * 256];
          u32x4 u; u.x = pk2(t[0], t[1]); u.y = pk2(t[2], t[3]); u.z = pk2(t[4], t[5]); u.w = pk2(t[6], t[7]);
          lb[ll][nn][s] = __builtin_bit_cast(bf16x8, u);
        }
      }
    const float w0c = p.w0[layer * 256 + cg_], a0c = p.a0[layer * 256 + cg_], kkc = p.k_k[layer * 256 + cg_], kac = p.k_a[layer * 256 + cg_];
    const float ubc = p.u_bonus[layer * 256 + cg_], lnw = p.ln_w[layer * 256 + cg_], lnb = p.ln_b[layer * 256 + cg_];
    const float* mu = p.mu + layer * 832;
    const float mu_r = mu[cg_], mu_k = mu[256 + cg_], mu_v = mu[512 + cg_], mu_l = mu[768 + lane];
    const float* shp = p.st_shift + (size_t)(layer * 16 + b) * 832;
    auto pre = [&](int c, float (&xvk)[8], float (&bonk)[8], float (&gtk)[8]) {
      float* R = SET0 + (c & 1) * SETF; float* W = R + 2048; float* KT = W + 2048; float* KH = KT + 2048; float* BB = KH + 2048; float* V = BB + 2048;
      const bf16_t* base = p.P + (size_t)(tok0 + c * 32 + 8 * pw) * D_IN + OFF_C;
      bf16_t cr[8], ck[8], cv[8], cl[8], cgt[8];
#pragma unroll
      for (int i = 0; i < 8; ++i) {
        const bf16_t* cp = base + (size_t)i * D_IN;
        cr[i] = cp[cg_]; ck[i] = cp[256 + cg_]; cv[i] = cp[512 + cg_]; cl[i] = cp[768 + lane]; cgt[i] = cp[OFF_GC - OFF_C + cg_];
      }
      float pr, pk, pv, pl;
      if (c * 32 + 8 * pw == 0) {
        if (sample) { pr = shp[cg_]; pk = shp[256 + cg_]; pv = shp[512 + cg_]; pl = shp[768 + lane]; }
        else { pr = 0.f; pk = 0.f; pv = 0.f; pl = 0.f; }
      } else {
        const bf16_t* pp = base - D_IN;
        pr = bf2f(pp[cg_]); pk = bf2f(pp[256 + cg_]); pv = bf2f(pp[512 + cg_]); pl = bf2f(pp[768 + lane]);
      }
      float xr_[8], xk_[8];
#pragma unroll
      for (int i = 0; i < 8; ++i) {
        const float c_r = bf2f(cr[i]), c_k = bf2f(ck[i]), c_v = bf2f(cv[i]), c_l = bf2f(cl[i]);
        xr_[i] = c_r + mu_r * (pr - c_r); xk_[i] = c_k + mu_k * (pk - c_k); xvk[i] = c_v + mu_v * (pv - c_v);
        const float xl = c_l + mu_l * (pl - c_l);
        pr = c_r; pk = c_k; pv = c_v; pl = c_l;
        gtk[i] = bf2f(cgt[i]);
        LORAb[i * 72 + lane] = (bf16_t)f2bf(lane < 32 ? fast_tanh(xl) : xl);
      }
      __builtin_amdgcn_wave_barrier();
#pragma unroll
      for (int ll = 0; ll < 2; ++ll) {
        const bf16x8 af0 = *(const bf16x8*)((const char*)LORAb + (r_ & 7) * 144 + ll * 64 + h_ * 16);
        const bf16x8 af1 = *(const bf16x8*)((const char*)LORAb + (r_ & 7) * 144 + ll * 64 + 32 + h_ * 16);
#pragma unroll
        for (int nn = 0; nn < 2; ++nn) {
          f32x16 dacc;
#pragma unroll
          for (int i = 0; i < 16; ++i) dacc[i] = 0.f;
          dacc = MFMA(af0, lb[ll][nn][0], dacc);
          dacc = MFMA(af1, lb[ll][nn][1], dacc);
#pragma unroll
          for (int i = 0; i < 4; ++i) DSA[ll * 512 + (i + 4 * h_) * 64 + 32 * nn + r_] = dacc[i];
        }
      }
      __builtin_amdgcn_wave_barrier();
#pragma unroll
      for (int i = 0; i < 8; ++i) {
        const int tl = 8 * pw + i;
        const float dsum = w0c + DSA[i * 64 + lane], asum = a0c + DSA[512 + i * 64 + lane];
        const float dec = __expf(-0.6065306597f * sigmoidf_(dsum));
        const float a = sigmoidf_(asum);
        const float kk = xk_[i] * kkc;
        const float ss = wave_sum(kk * kk);
        const float kh = kk * __builtin_amdgcn_rsqf(ss + 1e-12f);
        const float kt = xk_[i] * (1.f + (a - 1.f) * kac);
        bonk[i] = wave_sum(xr_[i] * kt * ubc);
        R[tl * 64 + lane] = xr_[i]; W[tl * 64 + lane] = dec; KT[tl * 64 + lane] = kt; KH[tl * 64 + lane] = kh; BB[tl * 64 + lane] = a * kh; V[tl * 64 + lane] = xvk[i];
      }
      __builtin_amdgcn_wave_barrier();
    };
    auto post = [&](int c, const float (&xvk)[8], const float (&bonk)[8], const float (&gtk)[8]) {
      const float* Y = YB + (c & 1) * 2048;
#pragma unroll
      for (int i = 0; i < 8; ++i) {
        const int tl = 8 * pw + i;
        const float y = Y[tl * 64 + lane];
        const float mean = wave_sum(y) * (1.f / 64.f);
        const float msq = wave_sum(y * y) * (1.f / 64.f);
        const float var = fmaxf(msq - mean * mean, 0.f);
        float yn = (y - mean) * __builtin_amdgcn_rsqf(var + 64e-5f) * lnw + lnb;
        yn += bonk[i] * xvk[i];
        p.mix[(size_t)(tok0 + c * 32 + tl) * 1024 + 768 + cg_] = (bf16_t)f2bf(yn * siluf_(gtk[i]));
      }
    };
    float xvA[8], bonA[8], gtA[8], xvB[8], bonB[8], gtB[8];
#pragma unroll
    for (int i = 0; i < 8; ++i) { xvB[i] = 0.f; bonB[i] = 0.f; gtB[i] = 0.f; }
    pre(0, xvA, bonA, gtA);
    lds_barrier();
    for (int c = 0; c < nch; c += 2) {
      if (c >= 1) post(c - 1, xvB, bonB, gtB);
      if (c + 1 < nch) pre(c + 1, xvB, bonB, gtB);
      lds_barrier();
      if (c + 1 < nch) {
        post(c, xvA, bonA, gtA);
        if (c + 2 < nch) pre(c + 2, xvA, bonA, gtA);
        lds_barrier();
      }
    }
    if ((nch - 1) & 1) post(nch - 1, xvB, bonB, gtB); else post(nch - 1, xvA, bonA, gtA);
  }
  lds_barrier();
}

constexpr int ATT_LDS0 = 6 * S5_LDS;
DI void phase_mixers(const Params& p, int layer, char* smem, int cofs) {
  const int G = GDIM, bid = BID, half = G / 2;
  const int tid = TID, wv = tid >> 6, lane = tid & 63;
  if (bid < half) {
    for (int item = bid; item < 128; item += half) rwkv_item(p, layer, item, smem);
  } else {
    const int j = bid - half, nb2 = G - half;
    for (int item = 128 + j; item < 192; item += nb2) rwkv_item(p, layer, item, smem);
    if (wv < 6) { for (int it = j * 6 + wv; it < 768; it += nb2 * 6) s5_item(p, layer, it, smem + wv * S5_LDS); }
  }
  unsigned* ctr = p.counters + layer + cofs;
  bf16_t* vl = (bf16_t*)(smem + ATT_LDS0) + wv * (32 * VS);
  while (true) {
    int it = 0;
    if (lane == 0) it = (int)atomicAdd(ctr, 1u);
    it = __builtin_amdgcn_readfirstlane(it);
    if (it >= 16512) break;
    attn_item(p, layer, it, vl);
  }
}

__global__ void __launch_bounds__(NT) mega(Params p) {
  __shared__ __attribute__((aligned(16))) char smem[SMEM_BYTES];
  cg::grid_group grid = cg::this_grid();
  phase_weights(p, smem);
  phase_norm(p, 0);
  grid.sync();
  for (int layer = 0; layer < 2; ++layer) {
    gemm_phase<0>(p, layer, smem);
    grid.sync();
#if PROBE_GEMM0
    gemm_phase<0>(p, layer, smem);
    grid.sync();
#endif
    phase_mixers(p, layer, smem, 0);
    grid.sync();
#if PROBE_MIX
    phase_mixers(p, layer, smem, 2);
    grid.sync();
#endif
    gemm_phase<1>(p, layer, smem);
    grid.sync();
    gemm_phase<2>(p, layer, smem);
    if (layer == 0) grid.sync();
  }
}

#if MULTI_LAUNCH
template <int PH>
__global__ void __launch_bounds__(NT) phase_kernel(Params p, int layer) {
  __shared__ __attribute__((aligned(16))) char smem[SMEM_BYTES];
  if (PH == 0) { phase_weights(p, smem); }
  else if (PH == 1) phase_norm(p, layer);
  else if (PH == 2) gemm_phase<0>(p, layer, smem);
  else if (PH == 3) phase_mixers(p, layer, smem, 0);
  else if (PH == 4) gemm_phase<1>(p, layer, smem);
  else gemm_phase<2>(p, layer, smem);
}
#endif

extern "C" void kernel_launch(void* const* d_in, const int* in_sizes, int n_in, void* d_out, int out_size, void* d_ws, size_t ws_size, hipStream_t stream) {
  Params p{};
  const float** f = (const float**)&p;
  for (int i = 0; i < 33; ++i) f[i] = (const float*)d_in[i];
  p.out = (float*)d_out;
  char* ws = (char*)d_ws;
  size_t off = 0;
  auto take = [&](size_t bytes) { char* q = ws + off; off += (bytes + 255) & ~(size_t)255; return q; };
  p.WinT = (bf16_t*)take((size_t)2 * 3648 * 1024 * 2);
  p.WoutT = (bf16_t*)take((size_t)2 * 1024 * 1024 * 2);
  p.WgluT = (bf16_t*)take((size_t)2 * 512 * 256 * 2);
  p.hbf = (bf16_t*)take((size_t)NTOK * 1024 * 2);
  p.P = (bf16_t*)take((size_t)NTOK * D_IN * 2);
  p.mix = (bf16_t*)take((size_t)NTOK * 1024 * 2);
  p.yb = (bf16_t*)take((size_t)NTOK * 256 * 2);
  p.counters = (unsigned*)take(256);
  p.ssq = (float*)take((size_t)NTOK * 4);
  if (off > ws_size || (size_t)out_size != O_END || n_in != 33) fprintf(stderr, "kernel_launch: unexpected sizes ws=%zu need=%zu out=%d n_in=%d\n", ws_size, off, out_size, n_in);
#if MULTI_LAUNCH
  const int G = 256;
  phase_kernel<0><<<G, NT, 0, stream>>>(p, 0);
  for (int layer = 0; layer < 2; ++layer) {
    phase_kernel<1><<<G, NT, 0, stream>>>(p, layer);
    phase_kernel<2><<<G, NT, 0, stream>>>(p, layer);
    phase_kernel<3><<<G, NT, 0, stream>>>(p, layer);
    phase_kernel<4><<<G, NT, 0, stream>>>(p, layer);
    phase_kernel<5><<<G, NT, 0, stream>>>(p, layer);
  }
#else
  static int grid_blocks = 0;
  if (!grid_blocks) {
    int dev = 0, cus = 0, per_cu = 0;
    hipGetDevice(&dev);
    hipDeviceGetAttribute(&cus, hipDeviceAttributeMultiprocessorCount, dev);
    hipOccupancyMaxActiveBlocksPerMultiprocessor(&per_cu, mega, NT, 0);
    if (per_cu < 1) per_cu = 1;
    grid_blocks = cus * per_cu;
  }
  void* args[] = {&p};
  hipError_t e = hipLaunchCooperativeKernel((void*)mega, dim3(grid_blocks), dim3(NT), args, 0, stream);
  if (e != hipSuccess) fprintf(stderr, "cooperative launch failed: %s (grid %d)\n", hipGetErrorString(e), grid_blocks);
#endif
}
```

```cpp
#include <hip/hip_runtime.h>
#include <hip/hip_cooperative_groups.h>
#include <cstdio>
namespace cg = cooperative_groups;

#define PROBE_GEMM0 0
#define PROBE_MIX 0
#ifndef MULTI_LAUNCH
#define MULTI_LAUNCH 0
#endif

#define DI __device__ __forceinline__
typedef unsigned short bf16_t;
typedef short bf16x8 __attribute__((ext_vector_type(8)));
typedef float f32x16 __attribute__((ext_vector_type(16)));
typedef unsigned u32x4 __attribute__((ext_vector_type(4)));
typedef unsigned u32x2 __attribute__((ext_vector_type(2)));
#define MFMA(a, b, c) __builtin_amdgcn_mfma_f32_32x32x16_bf16((a), (b), (c), 0, 0, 0)

constexpr int NT = 512;
constexpr int NTOK_P = 65536, NTOK = 66048, D_IN = 3648;
constexpr int OFF_Q = 0, OFF_K = 512, OFF_V = 1024, OFF_GA = 1536, OFF_U = 2048, OFF_GB = 2304, OFF_C = 2560, OFF_GC = 3392;
constexpr size_t O_Y = 0, O_KP = 67633152, O_VP = 134742016, O_SREP = 201850880, O_SIMP = 201916416, O_WKVP = 201981952,
                 O_SHP = 203030528, O_KS = 203083776, O_VS = 203608064, O_SRES = 204132352, O_SIMS = 204165120,
                 O_WKVS = 204197888, O_SHS = 204722176, O_END = 204748800;
constexpr int SMEM_BYTES = 2 * 55296 + 8 * 4608;
constexpr int LDS_ROW = 144;
constexpr int STAGE = (256 + 128) * LDS_ROW;

struct Params {
  const float *x_prompt, *x_sample, *cache_k, *cache_v, *st_re, *st_im, *st_wkv, *st_shift;
  const float *norm_w, *w_in, *q_norm_w, *k_norm_w, *lam_re, *lam_im, *log_dt, *b_re, *b_im, *c_re, *c_im, *ssm_d, *w_glu, *b_glu;
  const float *mu, *w0, *w2, *a0, *a2, *k_k, *k_a, *u_bonus, *ln_w, *ln_b, *w_out;
  float* out;
  bf16_t *WinT, *WoutT, *WgluT, *hbf, *P, *mix, *yb;
  unsigned* counters;
  float* ssq;
};

DI int opq_v(int x) { asm volatile("" : "+v"(x)); return x; }
DI int opq_s(int x) { asm volatile("" : "+s"(x)); return x; }
#define TID opq_v((int)threadIdx.x)
#define BID opq_s((int)blockIdx.x)
#define GDIM opq_s((int)gridDim.x)
typedef float f32x4v __attribute__((ext_vector_type(4)));
DI void nt_store16(void* p, u32x4 v) { __builtin_nontemporal_store(v, (u32x4*)p); }
DI void nt_store16f(void* p, float4 v) { f32x4v t = {v.x, v.y, v.z, v.w}; __builtin_nontemporal_store(t, (f32x4v*)p); }
DI unsigned f2bf(float x) { unsigned u = __float_as_uint(x); u += 0x7fffu + ((u >> 16) & 1u); return u >> 16; }
DI unsigned pk2(float a, float b) { return f2bf(a) | (f2bf(b) << 16); }
DI float bf2f(unsigned v) { return __uint_as_float(v << 16); }
DI float bflo(unsigned w) { return __uint_as_float(w << 16); }
DI float bfhi(unsigned w) { return __uint_as_float(w & 0xffff0000u); }
DI float sigmoidf_(float x) { return __builtin_amdgcn_rcpf(1.f + __expf(-x)); }
DI float siluf_(float x) { return x * __builtin_amdgcn_rcpf(1.f + __expf(-x)); }
typedef float f32x2 __attribute__((ext_vector_type(2)));
DI f32x2 fma2(f32x2 a, f32x2 b, f32x2 c) { return __builtin_elementwise_fma(a, b, c); }
template <int CTRL> DI float dpp_mov(float x) { return __int_as_float(__builtin_amdgcn_update_dpp(0, __float_as_int(x), CTRL, 0xF, 0xF, true)); }
DI float sum8(float x) { x += dpp_mov<0xB1>(x); x += dpp_mov<0x4E>(x); x += dpp_mov<0x141>(x); return x; }
DI float fast_tanh(float x) { return 1.f - 2.f * __builtin_amdgcn_rcpf(1.f + __expf(2.f * x)); }
DI void lds_barrier() { asm volatile("s_waitcnt lgkmcnt(0)\n\ts_barrier" ::: "memory"); }
DI float wave_sum(float v) {
  v += dpp_mov<0xB1>(v); v += dpp_mov<0x4E>(v); v += dpp_mov<0x141>(v); v += dpp_mov<0x140>(v);
  v += __int_as_float(__builtin_amdgcn_update_dpp(0, __float_as_int(v), 0x142, 0xA, 0xF, false));
  v += __int_as_float(__builtin_amdgcn_update_dpp(0, __float_as_int(v), 0x143, 0xC, 0xF, false));
  return __int_as_float(__builtin_amdgcn_readlane(__float_as_int(v), 63));
}
DI const float* xrow(const Params& p, int layer, int row) {
  if (layer == 0) return row < NTOK_P ? p.x_prompt + (size_t)row * 1024 : p.x_sample + (size_t)(row - NTOK_P) * 1024;
  return p.out + (size_t)row * 1024;
}

DI void transpose_tile(const float* __restrict__ src, int K, int N, bf16_t* __restrict__ dst, int k0, int n0, float* tile) {
  const int tid = TID;
#pragma unroll
  for (int i = 0; i < 8; ++i) { int idx = tid + NT * i; int kk = idx >> 6, nn = idx & 63; tile[kk * 65 + nn] = src[(size_t)(k0 + kk) * N + n0 + nn]; }
  __syncthreads();
#pragma unroll
  for (int i = 0; i < 8; ++i) { int idx = tid + NT * i; int nn = idx >> 6, kk = idx & 63; dst[(size_t)(n0 + nn) * K + k0 + kk] = (bf16_t)f2bf(tile[kk * 65 + nn]); }
  __syncthreads();
}
DI void phase_weights(const Params& p, char* smem) {
  float* tile = (float*)smem;
  const int bid = BID, gdim = GDIM;
  for (int t = bid; t < 2400; t += gdim) {
    int layer = t / 1200, j = t % 1200;
    if (j < 912) { int kt = j / 57, nt = j % 57; transpose_tile(p.w_in + (size_t)layer * 1024 * 3648, 1024, 3648, p.WinT + (size_t)layer * 3648 * 1024, kt * 64, nt * 64, tile); }
    else if (j < 1168) { j -= 912; int kt = j / 16, nt = j % 16; transpose_tile(p.w_out + (size_t)layer * 1024 * 1024, 1024, 1024, p.WoutT + (size_t)layer * 1024 * 1024, kt * 64, nt * 64, tile); }
    else { j -= 1168; int kt = j / 8, nt = j % 8; transpose_tile(p.w_glu + (size_t)layer * 256 * 512, 256, 512, p.WgluT + (size_t)layer * 512 * 256, kt * 64, nt * 64, tile); }
  }
  { const int tid = TID; if (bid == 0 && tid < 64) p.counters[tid] = 0;
    for (int i = bid * NT + tid; i < NTOK; i += gdim * NT) p.ssq[i] = 0.f; }
}

DI void phase_norm(const Params& p, int layer) {
  const int tid = TID, lane = tid & 63, w = tid >> 6;
  const int bid = BID, gdim = GDIM;
  const float* nw = p.norm_w + layer * 1024;
  const int stride = gdim * 8;
  for (int row0 = bid * 8 + w; row0 < NTOK; row0 += 2 * stride) {
    const int row1 = row0 + stride;
    const bool has1 = row1 < NTOK;
    const float* x0 = xrow(p, layer, row0);
    const float* x1 = xrow(p, layer, has1 ? row1 : row0);
    float4 v0[4], v1[4]; float s0 = 0.f, s1 = 0.f;
#pragma unroll
    for (int i = 0; i < 4; ++i) { v0[i] = *(const float4*)(x0 + i * 256 + lane * 4); v1[i] = *(const float4*)(x1 + i * 256 + lane * 4); }
#pragma unroll
    for (int i = 0; i < 4; ++i) {
      s0 += v0[i].x * v0[i].x + v0[i].y * v0[i].y + v0[i].z * v0[i].z + v0[i].w * v0[i].w;
      s1 += v1[i].x * v1[i].x + v1[i].y * v1[i].y + v1[i].z * v1[i].z + v1[i].w * v1[i].w;
    }
    s0 = wave_sum(s0); s1 = wave_sum(s1);
    const float c0 = rsqrtf(s0 * (1.f / 1024.f) + 1e-6f), c1 = rsqrtf(s1 * (1.f / 1024.f) + 1e-6f);
#pragma unroll
    for (int i = 0; i < 4; ++i) {
      float4 wv = *(const float4*)(nw + i * 256 + lane * 4);
      u32x2 o; o.x = pk2(v0[i].x * c0 * wv.x, v0[i].y * c0 * wv.y); o.y = pk2(v0[i].z * c0 * wv.z, v0[i].w * c0 * wv.w);
      *(u32x2*)(p.hbf + (size_t)row0 * 1024 + i * 256 + lane * 4) = o;
      if (has1) {
        u32x2 o1; o1.x = pk2(v1[i].x * c1 * wv.x, v1[i].y * c1 * wv.y); o1.y = pk2(v1[i].z * c1 * wv.z, v1[i].w * c1 * wv.w);
        *(u32x2*)(p.hbf + (size_t)row1 * 1024 + i * 256 + lane * 4) = o1;
      }
    }
  }
}

template <int MODE>
DI void gemm_phase(const Params& p, int layer, char* smem) {
  constexpr int K = (MODE == 1) ? 256 : 1024;
  constexpr int NTN = (MODE == 0) ? 29 : (MODE == 1 ? 4 : 8);
  constexpr int KT = K / 64;
  const bf16_t* __restrict__ A = MODE == 0 ? p.hbf : (MODE == 1 ? p.yb : p.mix);
  const bf16_t* __restrict__ Bt = MODE == 0 ? p.WinT + (size_t)layer * 3648 * 1024 : (MODE == 1 ? p.WgluT + (size_t)layer * 512 * 256 : p.WoutT + (size_t)layer * 1024 * 1024);
  const int tid = TID, lane = tid & 63, wv = tid >> 6, r = lane & 31, h = lane >> 5;
  const int wm = wv >> 1, wn = wv & 1;
  const int bid = BID, gdim = GDIM;
  const int xcd = bid & 7, jb = bid >> 3, nbx = (gdim - xcd + 7) >> 3;

  const int total_x = ((258 - xcd + 7) >> 3) * NTN;
  const int nmine = jb < total_x ? (total_x - jb + nbx - 1) / nbx : 0;
  if (nmine == 0) return;
  const int lrow = tid >> 3, kc = tid & 7;
  const int ntm_x = (258 - xcd + 7) >> 3;
  auto decode = [&](int idx, int& tmi_o, int& tn_o) {
    constexpr int QW = 4 * NTN;
    const int nfull = ntm_x >> 2, remw = ntm_x & 3;
    const int quad = idx / QW;
    if (quad < nfull) { const int rem = idx - quad * QW; tn_o = rem >> 2; tmi_o = quad * 4 + (rem & 3); }
    else { const int rem = idx - nfull * QW; tn_o = rem / remw; tmi_o = nfull * 4 + rem % remw; }
  };
  auto set_ptrs = [&](int idx, const bf16_t* (&ap)[4], const bf16_t* (&bp)[2]) {
    int tmi_, tn_; decode(idx, tmi_, tn_);
    const int m0_ = (xcd + 8 * tmi_) * 256, n0_ = tn_ * 128;
#pragma unroll
    for (int i = 0; i < 4; ++i) ap[i] = A + (size_t)(m0_ + lrow + 64 * i) * K + kc * 8;
#pragma unroll
    for (int i = 0; i < 2; ++i) {
      int row = lrow + 64 * i, brow;
      if (MODE == 0) { brow = n0_ + row; brow = brow < 3648 ? brow : 3647; }
      else if (MODE == 2) brow = n0_ + row;
      else { int wn_ = row >> 6, nt_ = (row >> 5) & 1, c_ = row & 31; brow = nt_ * 256 + tn_ * 64 + wn_ * 32 + c_; }
      bp[i] = Bt + (size_t)brow * K + kc * 8;
    }
  };
  f32x16 acc[2][2];
  auto zero_acc = [&]() {
#pragma unroll
    for (int a = 0; a < 2; ++a)
#pragma unroll
      for (int b = 0; b < 2; ++b)
#pragma unroll
        for (int i = 0; i < 16; ++i) acc[a][b][i] = 0.f;
  };
  auto compute = [&](const char* buf, char* nbuf, const u32x4 (&pa)[4], const u32x4 (&pb)[2]) {
    const char* As = buf; const char* Bs = buf + 256 * LDS_ROW;
    char* An = nbuf; char* Bn = nbuf + 256 * LDS_ROW;
    __builtin_amdgcn_iglp_opt(0);
#pragma unroll
    for (int s = 0; s < 4; ++s) {
      bf16x8 af[2], bfr[2];
#pragma unroll
      for (int mt = 0; mt < 2; ++mt) af[mt] = *(const bf16x8*)(As + (wm * 64 + mt * 32 + r) * LDS_ROW + s * 32 + h * 16);
#pragma unroll
      for (int nt = 0; nt < 2; ++nt) bfr[nt] = *(const bf16x8*)(Bs + (wn * 64 + nt * 32 + r) * LDS_ROW + s * 32 + h * 16);
#pragma unroll
      for (int mt = 0; mt < 2; ++mt)
#pragma unroll
        for (int nt = 0; nt < 2; ++nt) acc[mt][nt] = MFMA(bfr[nt], af[mt], acc[mt][nt]);
      if (s < 2) {
        *(u32x4*)(An + (lrow + 64 * (2 * s)) * LDS_ROW + kc * 16) = pa[2 * s];
        *(u32x4*)(An + (lrow + 64 * (2 * s + 1)) * LDS_ROW + kc * 16) = pa[2 * s + 1];
      } else {
        *(u32x4*)(Bn + (lrow + 64 * (s - 2)) * LDS_ROW + kc * 16) = pb[s - 2];
      }
    }
  };
  u32x4 sa[4][4], sb[4][2];
  const bf16_t* cap[4]; const bf16_t* cbp[2]; const bf16_t* nap[4]; const bf16_t* nbp[2];
  set_ptrs(jb, cap, cbp);
#pragma unroll
  for (int j = 0; j < 4; ++j) {
#pragma unroll
    for (int i = 0; i < 4; ++i) sa[j][i] = *(const u32x4*)(cap[i] + j * 64);
#pragma unroll
    for (int i = 0; i < 2; ++i) sb[j][i] = *(const u32x4*)(cbp[i] + j * 64);
  }
  {
    char* As = smem; char* Bs = smem + 256 * LDS_ROW;
#pragma unroll
    for (int i = 0; i < 4; ++i) *(u32x4*)(As + (lrow + 64 * i) * LDS_ROW + kc * 16) = sa[0][i];
#pragma unroll
    for (int i = 0; i < 2; ++i) *(u32x4*)(Bs + (lrow + 64 * i) * LDS_ROW + kc * 16) = sb[0][i];
  }
  lds_barrier();
  zero_acc();
  int c_idx = jb;
  for (int ti = 0; ti < nmine; ++ti) {
    set_ptrs(ti + 1 < nmine ? c_idx + nbx : c_idx, nap, nbp);
    for (int q = 0; q < KT / 4; ++q) {
      const bool lastq = (q == KT / 4 - 1);
      const int koff = lastq ? 0 : (4 * (q + 1)) * 64;
      const bf16_t* lap[4]; const bf16_t* lbp[2];
#pragma unroll
      for (int i = 0; i < 4; ++i) lap[i] = (lastq ? nap[i] : cap[i]) + koff;
#pragma unroll
      for (int i = 0; i < 2; ++i) lbp[i] = (lastq ? nbp[i] : cbp[i]) + koff;
#pragma unroll
      for (int j = 0; j < 4; ++j) {
#pragma unroll
        for (int i = 0; i < 4; ++i) sa[j][i] = *(const u32x4*)(lap[i] + j * 64);
#pragma unroll
        for (int i = 0; i < 2; ++i) sb[j][i] = *(const u32x4*)(lbp[i] + j * 64);
        compute(smem + (j & 1) * STAGE, smem + ((j + 1) & 1) * STAGE, sa[(j + 1) & 3], sb[(j + 1) & 3]);
        lds_barrier();
      }
    }
#pragma unroll
    for (int i = 0; i < 4; ++i) cap[i] = nap[i];
#pragma unroll
    for (int i = 0; i < 2; ++i) cbp[i] = nbp[i];
    const int idx = c_idx; c_idx += nbx;
    int tmi, tn; decode(idx, tmi, tn);
    const int tm = xcd + 8 * tmi;
    const int m0 = tm * 256, n0 = tn * 128;
    char* eps = smem + 2 * STAGE + wv * 4608;
    if (MODE == 0) {
      const int nb = n0 + wn * 64;
      if (nb < 3648) {
        if (layer == 1) {
#pragma unroll
          for (int mt = 0; mt < 2; ++mt) {
            const float rs = rsqrtf(p.ssq[m0 + wm * 64 + mt * 32 + r] * (1.f / 1024.f) + 1e-6f);
#pragma unroll
            for (int nt = 0; nt < 2; ++nt)
#pragma unroll
              for (int i = 0; i < 16; ++i) acc[mt][nt][i] *= rs;
          }
        }
        float scale[2] = {1.f, 1.f};
        if (nb < 1024) {
#pragma unroll
          for (int mt = 0; mt < 2; ++mt) {
            float ss = 0.f;
#pragma unroll
            for (int nt = 0; nt < 2; ++nt)
#pragma unroll
              for (int i = 0; i < 16; ++i) ss += acc[mt][nt][i] * acc[mt][nt][i];
            ss += __shfl_xor(ss, 32);
            scale[mt] = rsqrtf(ss * (1.f / 64.f) + 1e-6f);
          }
        }
        const float* nw = (nb < 512 ? p.q_norm_w : p.k_norm_w) + layer * 64;
#pragma unroll
        for (int mt = 0; mt < 2; ++mt) {
          const int mb = m0 + wm * 64 + mt * 32;
          const int m = mb + r;
          const bool is_p = m < NTOK_P;
#pragma unroll
          for (int nt = 0; nt < 2; ++nt) {
#pragma unroll
            for (int g = 0; g < 4; ++g) {
              const int ncol = nb + nt * 32 + 8 * g + 4 * h;
              float v0 = acc[mt][nt][4 * g], v1 = acc[mt][nt][4 * g + 1], v2 = acc[mt][nt][4 * g + 2], v3 = acc[mt][nt][4 * g + 3];
              if (nb < 1024) {
                float4 w4 = *(const float4*)(nw + (ncol - nb));
                v0 *= scale[mt] * w4.x; v1 *= scale[mt] * w4.y; v2 *= scale[mt] * w4.z; v3 *= scale[mt] * w4.w;
              }
              *(float4*)(eps + r * 144 + (8 * g + 4 * h) * 4) = make_float4(v0, v1, v2, v3);
              if (nb >= OFF_C && nb < OFF_GC) {
                const bool last = is_p ? ((m & 2047) == 2047) : (((m - NTOK_P) & 31) == 31);
                if (last) {
                  float* dst = p.out + (is_p ? O_SHP + ((size_t)layer * 32 + (m >> 11)) * 832 : O_SHS + ((size_t)layer * 16 + ((m - NTOK_P) >> 5)) * 832) + (ncol - OFF_C);
                  *(float4*)dst = make_float4(v0, v1, v2, v3);
                }
              }
            }
            __builtin_amdgcn_wave_barrier();
#pragma unroll
            for (int it = 0; it < 2; ++it) {
              const int row = (lane >> 2) + 16 * it, ch = lane & 3;
              const float4 a = *(const float4*)(eps + row * 144 + ch * 32), c = *(const float4*)(eps + row * 144 + ch * 32 + 16);
              u32x4 o; o.x = pk2(a.x, a.y); o.y = pk2(a.z, a.w); o.z = pk2(c.x, c.y); o.w = pk2(c.z, c.w);
              nt_store16(p.P + (size_t)(mb + row) * D_IN + nb + nt * 32 + ch * 8, o);
            }
            if (nb >= 512 && nb < 1536) {
#pragma unroll
              for (int it = 0; it < 4; ++it) {
                const int row = it * 8 + (lane >> 3), ch = lane & 7;
                const float4 a = *(const float4*)(eps + row * 144 + ch * 16);
                const int mm = mb + row;
                const bool pp = mm < NTOK_P;
                float* dst;
                if (nb < 1024) dst = p.out + (pp ? O_KP + ((size_t)layer * 65536 + mm) * 512 : O_KS + ((size_t)layer * 512 + (mm - NTOK_P)) * 512) + (nb - 512);
                else dst = p.out + (pp ? O_VP + ((size_t)layer * 65536 + mm) * 512 : O_VS + ((size_t)layer * 512 + (mm - NTOK_P)) * 512) + (nb - 1024);
                nt_store16f(dst + nt * 32 + ch * 4, a);
              }
            }
            __builtin_amdgcn_wave_barrier();
          }
        }
      }
    } else if (MODE == 1) {
      const float* bg = p.b_glu + layer * 512;
#pragma unroll
      for (int mt = 0; mt < 2; ++mt) {
        const int m = m0 + wm * 64 + mt * 32 + r;
#pragma unroll
        for (int g = 0; g < 4; ++g) {
          const int col = tn * 64 + wn * 32 + 8 * g + 4 * h;
          float4 bv = *(const float4*)(bg + col), bgt = *(const float4*)(bg + 256 + col);
          u32x2 gb = *(const u32x2*)(p.P + (size_t)m * D_IN + OFF_GB + col);
          float o0 = (acc[mt][0][4 * g] + bv.x) * sigmoidf_(acc[mt][1][4 * g] + bgt.x) * siluf_(bflo(gb.x));
          float o1 = (acc[mt][0][4 * g + 1] + bv.y) * sigmoidf_(acc[mt][1][4 * g + 1] + bgt.y) * siluf_(bfhi(gb.x));
          float o2 = (acc[mt][0][4 * g + 2] + bv.z) * sigmoidf_(acc[mt][1][4 * g + 2] + bgt.z) * siluf_(bflo(gb.y));
          float o3 = (acc[mt][0][4 * g + 3] + bv.w) * sigmoidf_(acc[mt][1][4 * g + 3] + bgt.w) * siluf_(bfhi(gb.y));
          u32x2 o; o.x = pk2(o0, o1); o.y = pk2(o2, o3);
          *(u32x2*)(p.mix + (size_t)m * 1024 + 512 + col) = o;
        }
      }
    } else {
      const float* nw1 = p.norm_w + 1024;
#pragma unroll
      for (int mt = 0; mt < 2; ++mt) {
        const int mb = m0 + wm * 64 + mt * 32;
        float sq[4] = {0.f, 0.f, 0.f, 0.f};
#pragma unroll
        for (int nt = 0; nt < 2; ++nt) {
#pragma unroll
          for (int g = 0; g < 4; ++g)
            *(float4*)(eps + r * 144 + (8 * g + 4 * h) * 4) = make_float4(acc[mt][nt][4 * g], acc[mt][nt][4 * g + 1], acc[mt][nt][4 * g + 2], acc[mt][nt][4 * g + 3]);
          __builtin_amdgcn_wave_barrier();
#pragma unroll
          for (int it = 0; it < 4; ++it) {
            const int row = it * 8 + (lane >> 3), ch = lane & 7;
            const float4 a = *(const float4*)(eps + row * 144 + ch * 16);
            const int mm = mb + row, ncol = n0 + wn * 64 + nt * 32 + ch * 4;
            float4 xv = *(const float4*)(xrow(p, layer, mm) + ncol);
            xv.x += a.x; xv.y += a.y; xv.z += a.z; xv.w += a.w;
            nt_store16f(p.out + (size_t)mm * 1024 + ncol, xv);
            if (layer == 0) {
              sq[it] += xv.x * xv.x + xv.y * xv.y + xv.z * xv.z + xv.w * xv.w;
              const float4 w4 = *(const float4*)(nw1 + ncol);
              u32x2 o; o.x = pk2(xv.x * w4.x, xv.y * w4.y); o.y = pk2(xv.z * w4.z, xv.w * w4.w);
              *(u32x2*)(p.hbf + (size_t)mm * 1024 + ncol) = o;
            }
          }
          __builtin_amdgcn_wave_barrier();
        }
        if (layer == 0) {
#pragma unroll
          for (int it = 0; it < 4; ++it) {
            const float s = sum8(sq[it]);
            if ((lane & 7) == 0) atomicAdd(p.ssq + mb + it * 8 + (lane >> 3), s);
          }
        }
      }
    }
    zero_acc();
  }
}

constexpr int VS = 66;
DI void attn_item(const Params& p, int layer, int wi, bf16_t* vl) {
  const int lane = TID & 63, r = lane & 31, h = lane >> 5;
  const bool sample = wi >= 16384;
  int b, hd, qt, tok0, qabs0;
  if (!sample) { b = wi >> 9; hd = (wi >> 6) & 7; qt = wi & 63; tok0 = b * 2048; qabs0 = qt * 32; }
  else { int j = wi - 16384; b = j >> 3; hd = j & 7; qt = 0; tok0 = NTOK_P + b * 32; qabs0 = 4096; }
  const int tq0 = tok0 + qt * 32;
  bf16x8 qf[4];
  {
    const bf16_t* qp = p.P + (size_t)(tq0 + r) * D_IN + OFF_Q + hd * 64 + h * 8;
#pragma unroll
    for (int ks = 0; ks < 4; ++ks) qf[ks] = *(const bf16x8*)(qp + ks * 16);
  }
  f32x16 o[2];
#pragma unroll
  for (int d = 0; d < 2; ++d)
#pragma unroll
    for (int i = 0; i < 16; ++i) o[d][i] = 0.f;
  float run = 0.f;
  const int nblk = qabs0 / 32 + 1;
  const int pir = 16 * ((r >> 2) & 1) + 4 * (r >> 3) + (r & 3);
  const float* ck = p.cache_k + ((size_t)(layer * 16 + b) * 4096) * 512 + hd * 64;
  const float* cv = p.cache_v + ((size_t)(layer * 16 + b) * 4096) * 512 + hd * 64;

  for (int kb = nblk - 1; kb >= 0; --kb) {
    const int kp0 = kb * 32;
    const bool fromP = (!sample) || (kb == 128);
    bf16x8 kf[4];
    if (fromP) {
      const int tk = sample ? (tok0 + (kp0 + pir - 4096)) : (tok0 + kp0 + pir);
      const bf16_t* kp = p.P + (size_t)tk * D_IN + OFF_K + hd * 64 + h * 8;
#pragma unroll
      for (int ks = 0; ks < 4; ++ks) kf[ks] = *(const bf16x8*)(kp + ks * 16);
#pragma unroll
      for (int i = 0; i < 4; ++i) {
        const int key = i * 8 + (lane >> 3), dc = lane & 7;
        const int tv = sample ? (tok0 + (kp0 + key - 4096)) : (tok0 + kp0 + key);
        u32x4 v = *(const u32x4*)(p.P + (size_t)tv * D_IN + OFF_V + hd * 64 + dc * 8);
        unsigned* dst = (unsigned*)(vl + key * VS + dc * 8);
        dst[0] = v.x; dst[1] = v.y; dst[2] = v.z; dst[3] = v.w;
      }
    } else {
      const float* kp = ck + (size_t)(kp0 + pir) * 512 + h * 8;
#pragma unroll
      for (int ks = 0; ks < 4; ++ks) {
        float4 a = *(const float4*)(kp + ks * 16), c = *(const float4*)(kp + ks * 16 + 4);
        u32x4 t; t.x = pk2(a.x, a.y); t.y = pk2(a.z, a.w); t.z = pk2(c.x, c.y); t.w = pk2(c.z, c.w);
        kf[ks] = __builtin_bit_cast(bf16x8, t);
      }
#pragma unroll
      for (int i = 0; i < 4; ++i) {
        const int key = i * 8 + (lane >> 3), dc = lane & 7;
        const float* vp = cv + (size_t)(kp0 + key) * 512 + dc * 8;
        float4 a = *(const float4*)vp, c = *(const float4*)(vp + 4);
        unsigned* dst = (unsigned*)(vl + key * VS + dc * 8);
        dst[0] = pk2(a.x, a.y); dst[1] = pk2(a.z, a.w); dst[2] = pk2(c.x, c.y); dst[3] = pk2(c.z, c.w);
      }
    }
    f32x16 st;
#pragma unroll
    for (int i = 0; i < 16; ++i) st[i] = 0.f;
#pragma unroll
    for (int ks = 0; ks < 4; ++ks) st = MFMA(kf[ks], qf[ks], st);
    const bool diag = (kb == nblk - 1);
    float z[16], lk[16], lat[16];
#pragma unroll
    for (int i = 0; i < 16; ++i) {
      z[i] = st[i] * 0.125f;
      const bool msk = (!diag) || (16 * h + i < r);
      const float e = __expf(-fabsf(z[i]));
      const float sp = fmaxf(z[i], 0.f) + __logf(1.f + e);
      lk[i] = msk ? -sp : 0.f;
    }
    float suf = 0.f;
#pragma unroll
    for (int i = 15; i >= 0; --i) { lat[i] = suf; suf += lk[i]; }
    const float other = __shfl_xor(suf, 32);
    const float base = run + (h == 0 ? other : 0.f);
    float a[16];
#pragma unroll
    for (int i = 0; i < 16; ++i) {
      const bool msk = (!diag) || (16 * h + i < r);
      a[i] = msk ? __expf(z[i] + lk[i] + base + lat[i]) : 0.f;
    }
    run += suf + other;
    __builtin_amdgcn_wave_barrier();
#pragma unroll
    for (int s2 = 0; s2 < 2; ++s2) {
      u32x4 t; t.x = pk2(a[8 * s2], a[8 * s2 + 1]); t.y = pk2(a[8 * s2 + 2], a[8 * s2 + 3]); t.z = pk2(a[8 * s2 + 4], a[8 * s2 + 5]); t.w = pk2(a[8 * s2 + 6], a[8 * s2 + 7]);
      const bf16x8 pf = __builtin_bit_cast(bf16x8, t);
#pragma unroll
      for (int dt = 0; dt < 2; ++dt) {
        const bf16_t* vp = vl + (16 * h + 8 * s2) * VS + 32 * dt + r;
        bf16x8 vf;
#pragma unroll
        for (int j = 0; j < 8; ++j) vf[j] = (short)vp[j * VS];
        o[dt] = MFMA(vf, pf, o[dt]);
      }
    }
    __builtin_amdgcn_wave_barrier();
    if (__all(run < -104.f)) break;
  }
  const int tok = tq0 + r;
#pragma unroll
  for (int dt = 0; dt < 2; ++dt)
#pragma unroll
    for (int g = 0; g < 4; ++g) {
      const int d0 = 32 * dt + 8 * g + 4 * h;
      u32x2 ga = *(const u32x2*)(p.P + (size_t)tok * D_IN + OFF_GA + hd * 64 + d0);
      u32x2 ov;
      ov.x = pk2(o[dt][4 * g] * siluf_(bflo(ga.x)), o[dt][4 * g + 1] * siluf_(bfhi(ga.x)));
      ov.y = pk2(o[dt][4 * g + 2] * siluf_(bflo(ga.y)), o[dt][4 * g + 3] * siluf_(bfhi(ga.y)));
      *(u32x2*)(p.mix + (size_t)tok * 1024 + hd * 64 + d0) = ov;
    }
}

constexpr int S5_BU = 8192;
constexpr int S5_LDS = S5_BU + 8704 + 1024;
DI void s5_disc(const Params& p, int lg, int pi, float dt, float& ar, float& ai, float& fr, float& fi) {
  const float lr = fminf(p.lam_re[lg * 64 + pi], -1e-4f), li = p.lam_im[lg * 64 + pi];
  const float er = expf(lr * dt);
  ar = er * cosf(li * dt); ai = er * sinf(li * dt);
  const float den = lr * lr + li * li;
  fr = ((ar - 1.f) * lr + ai * li) / den; fi = (ai * lr - (ar - 1.f) * li) / den;
}
DI void s5_item(const Params& p, int layer, int item, char* lds) {
  float* BU = (float*)lds;
  char* Himg = lds + S5_BU;
  bf16_t* Ub = (bf16_t*)(lds + S5_BU + 8704);
  const int lane = TID & 63, r = lane & 31, h = lane >> 5;
  const int seq = item >> 4, g = item & 15;
  const bool sample = seq >= 32;
  const int b = sample ? seq - 32 : seq, L = sample ? 32 : 2048, tok0 = sample ? NTOK_P + b * 32 : b * 2048;
  const int lg = layer * 16 + g;
  const float dt = expf(p.log_dt[lg]);
  float ar, ai, fr_, fi_;
  s5_disc(p, lg, lane, dt, ar, ai, fr_, fi_);
  bf16x8 bbf[4];
#pragma unroll
  for (int half = 0; half < 2; ++half) {
    const int pi = 32 * half + r;
    float a_r, a_i, f_r, f_i;
    s5_disc(p, lg, pi, dt, a_r, a_i, f_r, f_i);
    const float* brp = p.b_re + ((size_t)lg * 64 + pi) * 16 + 8 * h;
    const float* bip = p.b_im + ((size_t)lg * 64 + pi) * 16 + 8 * h;
    float re[8], im[8];
#pragma unroll
    for (int j = 0; j < 8; ++j) { const float br = brp[j], bi = bip[j]; re[j] = f_r * br - f_i * bi; im[j] = f_r * bi + f_i * br; }
    u32x4 t0, t1;
    t0.x = pk2(re[0], re[1]); t0.y = pk2(re[2], re[3]); t0.z = pk2(re[4], re[5]); t0.w = pk2(re[6], re[7]);
    t1.x = pk2(im[0], im[1]); t1.y = pk2(im[2], im[3]); t1.z = pk2(im[4], im[5]); t1.w = pk2(im[6], im[7]);
    bbf[half] = __builtin_bit_cast(bf16x8, t0);
    bbf[2 + half] = __builtin_bit_cast(bf16x8, t1);
  }
  bf16x8 cf[8];
#pragma unroll
  for (int s = 0; s < 8; ++s) {
    u32x4 t; t.x = 0; t.y = 0; t.z = 0; t.w = 0;
    if (r < 16) {
      const int k0 = 16 * s + 8 * h;
      const float* src = (s < 4 ? p.c_re : p.c_im) + ((size_t)lg * 16 + r) * 64 + (k0 & 63);
      const float sg = s < 4 ? 1.f : -1.f;
      const float4 c0 = *(const float4*)src, c1 = *(const float4*)(src + 4);
      t.x = pk2(sg * c0.x, sg * c0.y); t.y = pk2(sg * c0.z, sg * c0.w); t.z = pk2(sg * c1.x, sg * c1.y); t.w = pk2(sg * c1.z, sg * c1.w);
    }
    cf[s] = __builtin_bit_cast(bf16x8, t);
  }
  const float dl = p.ssm_d[lg * 16 + (r & 15)];
  float hr = 0.f, hi = 0.f;
  if (sample) { hr = p.st_re[((size_t)(layer * 16 + b) * 16 + g) * 64 + lane]; hi = p.st_im[((size_t)(layer * 16 + b) * 16 + g) * 64 + lane]; }
  f32x16 zero;
#pragma unroll
  for (int i = 0; i < 16; ++i) zero[i] = 0.f;
  const bf16_t* upb = p.P + (size_t)(tok0 + r) * D_IN + OFF_U + g * 16 + 8 * h;
  bf16x8 uf = *(const bf16x8*)upb;
  for (int t0 = 0; t0 < L; t0 += 32) {
    const bf16x8 ucur = uf;
    if (t0 + 32 < L) uf = *(const bf16x8*)(upb + (size_t)(t0 + 32) * D_IN);
    *(bf16x8*)(Ub + r * 16 + 8 * h) = ucur;
    f32x16 d[4];
#pragma unroll
    for (int tile = 0; tile < 4; ++tile) d[tile] = MFMA(ucur, bbf[tile], zero);
#pragma unroll
    for (int hf = 0; hf < 2; ++hf) {
#pragma unroll
      for (int tile = 0; tile < 4; ++tile)
#pragma unroll
        for (int i = 0; i < 8; ++i) BU[((i & 3) + 8 * (i >> 2) + 4 * h) * 128 + 32 * tile + r] = d[tile][8 * hf + i];
      __builtin_amdgcn_wave_barrier();
#pragma unroll
      for (int tt = 0; tt < 16; ++tt) {
        const int t = 16 * hf + tt;
        const float bur = BU[tt * 128 + lane], bui = BU[tt * 128 + 64 + lane];
        const float nhr = ar * hr - ai * hi + bur, nhi = ar * hi + ai * hr + bui;
        hr = nhr; hi = nhi;
        *(bf16_t*)(Himg + t * 272 + lane * 2) = (bf16_t)f2bf(hr);
        *(bf16_t*)(Himg + t * 272 + 128 + lane * 2) = (bf16_t)f2bf(hi);
      }
      __builtin_amdgcn_wave_barrier();
    }
    f32x16 yacc = zero;
#pragma unroll
    for (int s = 0; s < 8; ++s) {
      const bf16x8 af = *(const bf16x8*)(Himg + r * 272 + s * 32 + h * 16);
      yacc = MFMA(af, cf[s], yacc);
    }
    if (r < 16) {
#pragma unroll
      for (int i = 0; i < 16; ++i) {
        const int t = (i & 3) + 8 * (i >> 2) + 4 * h;
        const float yv = yacc[i] + dl * bf2f(Ub[t * 16 + r]);
        const float gl = yv * __builtin_amdgcn_rcpf(1.f + __expf(-1.5957691216f * (yv + 0.044715f * yv * yv * yv)));
        p.yb[(size_t)(tok0 + t0 + t) * 256 + g * 16 + r] = (bf16_t)f2bf(gl);
      }
    }
    __builtin_amdgcn_wave_barrier();
  }
  float* ore = p.out + (sample ? O_SRES : O_SREP) + ((size_t)(layer * (sample ? 16 : 32) + b) * 16 + g) * 64 + lane;
  float* oim = p.out + (sample ? O_SIMS : O_SIMP) + ((size_t)(layer * (sample ? 16 : 32) + b) * 16 + g) * 64 + lane;
  *ore = hr; *oim = hi;
}

DI void rwkv_item(const Params& p, int layer, int item, char* smem) {
  constexpr int SETF = 6 * 2048;
  float* SET0 = (float*)smem;
  float* YB = SET0 + 2 * SETF;
  char* PW = (char*)(YB + 2 * 2048);
  const int tid = TID, lane = tid & 63, wv = tid >> 6;
  const int seq = item >> 2, hd = item & 3;
  const bool sample = seq >= 32;
  const int b = sample ? seq - 32 : seq, L = sample ? 32 : 2048, tok0 = sample ? NTOK_P + b * 32 : b * 2048;
  const int nch = L >> 5;
  if (wv < 4) {
    const int rp = tid >> 3, kq = tid & 7;
    f32x2 S0[4], S1[4];
    if (sample) {
      const float* sp = p.st_wkv + (((size_t)(layer * 16 + b) * 4 + hd) * 64 + rp) * 64 + kq * 8;
#pragma unroll
      for (int j = 0; j < 4; ++j) { S0[j].x = sp[2 * j]; S0[j].y = sp[2 * j + 1]; S1[j].x = sp[2048 + 2 * j]; S1[j].y = sp[2048 + 2 * j + 1]; }
    } else {
#pragma unroll
      for (int j = 0; j < 4; ++j) { S0[j].x = 0.f; S0[j].y = 0.f; S1[j].x = 0.f; S1[j].y = 0.f; }
    }
    lds_barrier();
    for (int c = 0; c < nch; ++c) {
      const float* R = SET0 + (c & 1) * SETF; const float* W = R + 2048; const float* KT = W + 2048; const float* KH = KT + 2048;
      const float* BB = KH + 2048; const float* V = BB + 2048;
      float* Y = YB + (c & 1) * 2048;
      float yk0[4], yk1[4];
      float4 nkh0, nkh1, nw0, nw1, nb0, nb1, nk0, nk1, nr0, nr1; float nv0, nv1;
      {
        const int o = kq * 8;
        nkh0 = *(const float4*)(KH + o); nkh1 = *(const float4*)(KH + o + 4); nw0 = *(const float4*)(W + o); nw1 = *(const float4*)(W + o + 4);
        nb0 = *(const float4*)(BB + o); nb1 = *(const float4*)(BB + o + 4); nk0 = *(const float4*)(KT + o); nk1 = *(const float4*)(KT + o + 4);
        nr0 = *(const float4*)(R + o); nr1 = *(const float4*)(R + o + 4); nv0 = V[rp]; nv1 = V[rp + 32];
      }
#pragma unroll
      for (int q = 0; q < 4; ++q) {
        yk0[q] = 0.f; yk1[q] = 0.f;
#pragma unroll
        for (int e = 0; e < 8; ++e) {
          const int tl = q * 8 + e;
          const float4 kh0 = nkh0, kh1 = nkh1, w0_ = nw0, w1_ = nw1, b0 = nb0, b1 = nb1, k0 = nk0, k1 = nk1, r0 = nr0, r1 = nr1;
          const float va = nv0, vb = nv1;
          if (tl < 31) {
            const int o = (tl + 1) * 64 + kq * 8;
            nkh0 = *(const float4*)(KH + o); nkh1 = *(const float4*)(KH + o + 4); nw0 = *(const float4*)(W + o); nw1 = *(const float4*)(W + o + 4);
            nb0 = *(const float4*)(BB + o); nb1 = *(const float4*)(BB + o + 4); nk0 = *(const float4*)(KT + o); nk1 = *(const float4*)(KT + o + 4);
            nr0 = *(const float4*)(R + o); nr1 = *(const float4*)(R + o + 4); nv0 = V[(tl + 1) * 64 + rp]; nv1 = V[(tl + 1) * 64 + rp + 32];
          }
          const f32x2 khv[4] = {{kh0.x, kh0.y}, {kh0.z, kh0.w}, {kh1.x, kh1.y}, {kh1.z, kh1.w}};
          const f32x2 wvv[4] = {{w0_.x, w0_.y}, {w0_.z, w0_.w}, {w1_.x, w1_.y}, {w1_.z, w1_.w}};
          const f32x2 bv[4] = {{b0.x, b0.y}, {b0.z, b0.w}, {b1.x, b1.y}, {b1.z, b1.w}};
          const f32x2 kv[4] = {{k0.x, k0.y}, {k0.z, k0.w}, {k1.x, k1.y}, {k1.z, k1.w}};
          const f32x2 rv[4] = {{r0.x, r0.y}, {r0.z, r0.w}, {r1.x, r1.y}, {r1.z, r1.w}};
          const f32x2 va2 = {va, va}, vb2 = {vb, vb};
          f32x2 ma[4], mb[4];
#pragma unroll
          for (int j = 0; j < 4; ++j) { ma[j] = fma2(S0[j], wvv[j], va2 * kv[j]); mb[j] = fma2(S1[j], wvv[j], vb2 * kv[j]); }
          f32x2 sa2 = fma2(S0[1], khv[1], S0[0] * khv[0]) + fma2(S0[3], khv[3], S0[2] * khv[2]);
          f32x2 sb2 = fma2(S1[1], khv[1], S1[0] * khv[0]) + fma2(S1[3], khv[3], S1[2] * khv[2]);
          const float sa = sum8(sa2.x + sa2.y), sb = sum8(sb2.x + sb2.y);
          const f32x2 nsa = {-sa, -sa}, nsb = {-sb, -sb};
#pragma unroll
          for (int j = 0; j < 4; ++j) { S0[j] = fma2(nsa, bv[j], ma[j]); S1[j] = fma2(nsb, bv[j], mb[j]); }
          f32x2 ya2 = fma2(S0[1], rv[1], S0[0] * rv[0]) + fma2(S0[3], rv[3], S0[2] * rv[2]);
          f32x2 yb2 = fma2(S1[1], rv[1], S1[0] * rv[0]) + fma2(S1[3], rv[3], S1[2] * rv[2]);
          const float ya = sum8(ya2.x + ya2.y), ybv = sum8(yb2.x + yb2.y);
          yk0[q] = (e == kq) ? ya : yk0[q];
          yk1[q] = (e == kq) ? ybv : yk1[q];
        }
      }
#pragma unroll
      for (int q = 0; q < 4; ++q) { Y[(q * 8 + kq) * 64 + rp] = yk0[q]; Y[(q * 8 + kq) * 64 + rp + 32] = yk1[q]; }
      lds_barrier();
    }
    float* so = p.out + (sample ? O_WKVS : O_WKVP) + (((size_t)(layer * (sample ? 16 : 32) + b) * 4 + hd) * 64 + rp) * 64 + kq * 8;
    *(float4*)so = make_float4(S0[0].x, S0[0].y, S0[1].x, S0[1].y);
    *(float4*)(so + 4) = make_float4(S0[2].x, S0[2].y, S0[3].x, S0[3].y);
    *(float4*)(so + 2048) = make_float4(S1[0].x, S1[0].y, S1[1].x, S1[1].y);
    *(float4*)(so + 2052) = make_float4(S1[2].x, S1[2].y, S1[3].x, S1[3].y);
  } else {
    const int pw = wv - 4, r_ = lane & 31, h_ = lane >> 5;
    const int cg_ = hd * 64 + lane;
    bf16_t* LORAb = (bf16_t*)(PW + pw * 5248);
    float* DSA = (float*)(PW + pw * 5248 + 1152);
    bf16x8 lb[2][2][2];
#pragma unroll
    for (int ll = 0; ll < 2; ++ll)
#pragma unroll
      for (int nn = 0; nn < 2; ++nn) {
        const float* srcw = (ll ? p.a2 : p.w2) + (size_t)layer * 32 * 256 + hd * 64 + 32 * nn + r_;
#pragma unroll
        for (int s = 0; s < 2; ++s) {
          float t[8];
#pragma unroll
          for (int j = 0; j < 8; ++j) t[j] = srcw[(size_t)(16 * s + 8 * h_ + j) * 256];
          u32x4 u; u.x = pk2(t[0], t[1]); u.y = pk2(t[2], t[3]); u.z = pk2(t[4], t[5]); u.w = pk2(t[6], t[7]);
          lb[ll][nn][s] = __builtin_bit_cast(bf16x8, u);
        }
      }
    const float w0c = p.w0[layer * 256 + cg_], a0c = p.a0[layer * 256 + cg_], kkc = p.k_k[layer * 256 + cg_], kac = p.k_a[layer * 256 + cg_];
    const float ubc = p.u_bonus[layer * 256 + cg_], lnw = p.ln_w[layer * 256 + cg_], lnb = p.ln_b[layer * 256 + cg_];
    const float* mu = p.mu + layer * 832;
    const float mu_r = mu[cg_], mu_k = mu[256 + cg_], mu_v = mu[512 + cg_], mu_l = mu[768 + lane];
    const float* shp = p.st_shift + (size_t)(layer * 16 + b) * 832;
    auto pre = [&](int c, float (&xvk)[8], float (&bonk)[8], float (&gtk)[8]) {
      float* R = SET0 + (c & 1) * SETF; float* W = R + 2048; float* KT = W + 2048; float* KH = KT + 2048; float* BB = KH + 2048; float* V = BB + 2048;
      const bf16_t* base = p.P + (size_t)(tok0 + c * 32 + 8 * pw) * D_IN + OFF_C;
      bf16_t cr[8], ck[8], cv[8], cl[8], cgt[8];
#pragma unroll
      for (int i = 0; i < 8; ++i) {
        const bf16_t* cp = base + (size_t)i * D_IN;
        cr[i] = cp[cg_]; ck[i] = cp[256 + cg_]; cv[i] = cp[512 + cg_]; cl[i] = cp[768 + lane]; cgt[i] = cp[OFF_GC - OFF_C + cg_];
      }
      float pr, pk, pv, pl;
      if (c * 32 + 8 * pw == 0) {
        if (sample) { pr = shp[cg_]; pk = shp[256 + cg_]; pv = shp[512 + cg_]; pl = shp[768 + lane]; }
        else { pr = 0.f; pk = 0.f; pv = 0.f; pl = 0.f; }
      } else {
        const bf16_t* pp = base - D_IN;
        pr = bf2f(pp[cg_]); pk = bf2f(pp[256 + cg_]); pv = bf2f(pp[512 + cg_]); pl = bf2f(pp[768 + lane]);
      }
      float xr_[8], xk_[8];
#pragma unroll
      for (int i = 0; i < 8; ++i) {
        const float c_r = bf2f(cr[i]), c_k = bf2f(ck[i]), c_v = bf2f(cv[i]), c_l = bf2f(cl[i]);
        xr_[i] = c_r + mu_r * (pr - c_r); xk_[i] = c_k + mu_k * (pk - c_k); xvk[i] = c_v + mu_v * (pv - c_v);
        const float xl = c_l + mu_l * (pl - c_l);
        pr = c_r; pk = c_k; pv = c_v; pl = c_l;
        gtk[i] = bf2f(cgt[i]);
        LORAb[i * 72 + lane] = (bf16_t)f2bf(lane < 32 ? fast_tanh(xl) : xl);
      }
      __builtin_amdgcn_wave_barrier();
#pragma unroll
      for (int ll = 0; ll < 2; ++ll) {
        const bf16x8 af0 = *(const bf16x8*)((const char*)LORAb + (r_ & 7) * 144 + ll * 64 + h_ * 16);
        const bf16x8 af1 = *(const bf16x8*)((const char*)LORAb + (r_ & 7) * 144 + ll * 64 + 32 + h_ * 16);
#pragma unroll
        for (int nn = 0; nn < 2; ++nn) {
          f32x16 dacc;
#pragma unroll
          for (int i = 0; i < 16; ++i) dacc[i] = 0.f;
          dacc = MFMA(af0, lb[ll][nn][0], dacc);
          dacc = MFMA(af1, lb[ll][nn][1], dacc);
#pragma unroll
          for (int i = 0; i < 4; ++i) DSA[ll * 512 + (i + 4 * h_) * 64 + 32 * nn + r_] = dacc[i];
        }
      }
      __builtin_amdgcn_wave_barrier();
#pragma unroll
      for (int i = 0; i < 8; ++i) {
        const int tl = 8 * pw + i;
        const float dsum = w0c + DSA[i * 64 + lane], asum = a0c + DSA[512 + i * 64 + lane];
        const float dec = __expf(-0.6065306597f * sigmoidf_(dsum));
        const float a = sigmoidf_(asum);
        const float kk = xk_[i] * kkc;
        const float ss = wave_sum(kk * kk);
        const float kh = kk * __builtin_amdgcn_rsqf(ss + 1e-12f);
        const float kt = xk_[i] * (1.f + (a - 1.f) * kac);
        bonk[i] = wave_sum(xr_[i] * kt * ubc);
        R[tl * 64 + lane] = xr_[i]; W[tl * 64 + lane] = dec; KT[tl * 64 + lane] = kt; KH[tl * 64 + lane] = kh; BB[tl * 64 + lane] = a * kh; V[tl * 64 + lane] = xvk[i];
      }
      __builtin_amdgcn_wave_barrier();
    };
    auto post = [&](int c, const float (&xvk)[8], const float (&bonk)[8], const float (&gtk)[8]) {
      const float* Y = YB + (c & 1) * 2048;
#pragma unroll
      for (int i = 0; i < 8; ++i) {
        const int tl = 8 * pw + i;
        const float y = Y[tl * 64 + lane];
        const float mean = wave_sum(y) * (1.f / 64.f);
        const float msq = wave_sum(y * y) * (1.f / 64.f);
        const float var = fmaxf(msq - mean * mean, 0.f);
        float yn = (y - mean) * __builtin_amdgcn_rsqf(var + 64e-5f) * lnw + lnb;
        yn += bonk[i] * xvk[i];
        p.mix[(size_t)(tok0 + c * 32 + tl) * 1024 + 768 + cg_] = (bf16_t)f2bf(yn * siluf_(gtk[i]));
      }
    };
    float xvA[8], bonA[8], gtA[8], xvB[8], bonB[8], gtB[8];
#pragma unroll
    for (int i = 0; i < 8; ++i) { xvB[i] = 0.f; bonB[i] = 0.f; gtB[i] = 0.f; }
    pre(0, xvA, bonA, gtA);
    lds_barrier();
    for (int c = 0; c < nch; c += 2) {
      if (c >= 1) post(c - 1, xvB, bonB, gtB);
      if (c + 1 < nch) pre(c + 1, xvB, bonB, gtB);
      lds_barrier();
      if (c + 1 < nch) {
        post(c, xvA, bonA, gtA);
        if (c + 2 < nch) pre(c + 2, xvA, bonA, gtA);
        lds_barrier();
      }
    }
    if ((nch - 1) & 1) post(nch - 1, xvB, bonB, gtB); else post(nch - 1, xvA, bonA, gtA);
  }
  lds_barrier();
}

constexpr int ATT_LDS0 = 6 * S5_LDS;
DI void phase_mixers(const Params& p, int layer, char* smem, int cofs) {
  const int G = GDIM, bid = BID, half = G / 2;
  const int tid = TID, wv = tid >> 6, lane = tid & 63;
  if (bid < half) {
    for (int item = bid; item < 128; item += half) rwkv_item(p, layer, item, smem);
  } else {
    const int j = bid - half, nb2 = G - half;
    for (int item = 128 + j; item < 192; item += nb2) rwkv_item(p, layer, item, smem);
    if (wv < 6) { for (int it = j * 6 + wv; it < 768; it += nb2 * 6) s5_item(p, layer, it, smem + wv * S5_LDS); }
  }
  unsigned* ctr = p.counters + layer + cofs;
  bf16_t* vl = (bf16_t*)(smem + ATT_LDS0) + wv * (32 * VS);
  while (true) {
    int it = 0;
    if (lane == 0) it = (int)atomicAdd(ctr, 1u);
    it = __builtin_amdgcn_readfirstlane(it);
    if (it >= 16512) break;
    attn_item(p, layer, it, vl);
  }
}

__global__ void __launch_bounds__(NT) mega(Params p) {
  __shared__ __attribute__((aligned(16))) char smem[SMEM_BYTES];
  cg::grid_group grid = cg::this_grid();
  phase_weights(p, smem);
  phase_norm(p, 0);
  grid.sync();
  for (int layer = 0; layer < 2; ++layer) {
    gemm_phase<0>(p, layer, smem);
    grid.sync();
#if PROBE_GEMM0
    gemm_phase<0>(p, layer, smem);
    grid.sync();
#endif
    phase_mixers(p, layer, smem, 0);
    grid.sync();
#if PROBE_MIX
    phase_mixers(p, layer, smem, 2);
    grid.sync();
#endif
    gemm_phase<1>(p, layer, smem);
    grid.sync();
    gemm_phase<2>(p, layer, smem);
    if (layer == 0) grid.sync();
  }
}

#if MULTI_LAUNCH
template <int PH>
__global__ void __launch_bounds__(NT) phase_kernel(Params p, int layer) {
  __shared__ __attribute__((aligned(16))) char smem[SMEM_BYTES];
  if (PH == 0) { phase_weights(p, smem); }
  else if (PH == 1) phase_norm(p, layer);
  else if (PH == 2) gemm_phase<0>(p, layer, smem);
  else if (PH == 3) phase_mixers(p, layer, smem, 0);
  else if (PH == 4) gemm_phase<1>(p, layer, smem);
  else gemm_phase<2>(p, layer, smem);
}
#endif

extern "C" void kernel_launch(void* const* d_in, const int* in_sizes, int n_in, void* d_out, int out_size, void* d_ws, size_t ws_size, hipStream_t stream) {
  Params p{};
  const float** f = (const float**)&p;
  for (int i = 0; i < 33; ++i) f[i] = (const float*)d_in[i];
  p.out = (float*)d_out;
  char* ws = (char*)d_ws;
  size_t off = 0;
  auto take = [&](size_t bytes) { char* q = ws + off; off += (bytes + 255) & ~(size_t)255; return q; };
  p.WinT = (bf16_t*)take((size_t)2 * 3648 * 1024 * 2);
  p.WoutT = (bf16_t*)take((size_t)2 * 1024 * 1024 * 2);
  p.WgluT = (bf16_t*)take((size_t)2 * 512 * 256 * 2);
  p.hbf = (bf16_t*)take((size_t)NTOK * 1024 * 2);
  p.P = (bf16_t*)take((size_t)NTOK * D_IN * 2);
  p.mix = (bf16_t*)take((size_t)NTOK * 1024 * 2);
  p.yb = (bf16_t*)take((size_t)NTOK * 256 * 2);
  p.counters = (unsigned*)take(256);
  p.ssq = (float*)take((size_t)NTOK * 4);
  if (off > ws_size || (size_t)out_size != O_END || n_in != 33) fprintf(stderr, "kernel_launch: unexpected sizes ws=%zu need=%zu out=%d n_in=%d\n", ws_size, off, out_size, n_in);
#if MULTI_LAUNCH
  const int G = 256;
  phase_kernel<0><<<G, NT, 0, stream>>>(p, 0);
  for (int layer = 0; layer < 2; ++layer) {
    phase_kernel<1><<<G, NT, 0, stream>>>(p, layer);
    phase_kernel<2><<<G, NT, 0, stream>>>(p, layer);
    phase_kernel<3><<<G, NT, 0, stream>>>(p, layer);
    phase_kernel<4><<<G, NT, 0, stream>>>(p, layer);
    phase_kernel<5><<<G, NT, 0, stream>>>(p, layer);
  }
#else
  static int grid_blocks = 0;
  if (!grid_blocks) {
    int dev = 0, cus = 0, per_cu = 0;
    hipGetDevice(&dev);
    hipDeviceGetAttribute(&cus, hipDeviceAttributeMultiprocessorCount, dev);
    hipOccupancyMaxActiveBlocksPerMultiprocessor(&per_cu, mega, NT, 0);
    if (per_cu < 1) per_cu = 1;
    grid_blocks = cus * per_cu;
  }
  void* args[] = {&p};
  hipError_t e = hipLaunchCooperativeKernel((void*)mega, dim3(grid_blocks), dim3(NT), args, 0, stream);
  if (e != hipSuccess) fprintf(stderr, "cooperative launch failed: %s (grid %d)\n", hipGetErrorString(e), grid_blocks);
#endif
}
```

```cpp
#include <hip/hip_runtime.h>
#include <hip/hip_cooperative_groups.h>
#include <cstdio>
namespace cg = cooperative_groups;

#define PROBE_GEMM0 0
#define PROBE_MIX 0
#ifndef MULTI_LAUNCH
#define MULTI_LAUNCH 0
#endif

#define DI __device__ __forceinline__
typedef unsigned short bf16_t;
typedef short bf16x8 __attribute__((ext_vector_type(8)));
typedef float f32x16 __attribute__((ext_vector_type(16)));
typedef unsigned u32x4 __attribute__((ext_vector_type(4)));
typedef unsigned u32x2 __attribute__((ext_vector_type(2)));
#define MFMA(a, b, c) __builtin_amdgcn_mfma_f32_32x32x16_bf16((a), (b), (c), 0, 0, 0)

constexpr int NT = 512;
constexpr int NTOK_P = 65536, NTOK = 66048, D_IN = 3648;
constexpr int OFF_Q = 0, OFF_K = 512, OFF_V = 1024, OFF_GA = 1536, OFF_U = 2048, OFF_GB = 2304, OFF_C = 2560, OFF_GC = 3392;
constexpr size_t O_Y = 0, O_KP = 67633152, O_VP = 134742016, O_SREP = 201850880, O_SIMP = 201916416, O_WKVP = 201981952,
                 O_SHP = 203030528, O_KS = 203083776, O_VS = 203608064, O_SRES = 204132352, O_SIMS = 204165120,
                 O_WKVS = 204197888, O_SHS = 204722176, O_END = 204748800;
constexpr int SMEM_BYTES = 2 * 55296 + 8 * 4608;
constexpr int LDS_ROW = 144;
constexpr int STAGE = (256 + 128) * LDS_ROW;

struct Params {
  const float *x_prompt, *x_sample, *cache_k, *cache_v, *st_re, *st_im, *st_wkv, *st_shift;
  const float *norm_w, *w_in, *q_norm_w, *k_norm_w, *lam_re, *lam_im, *log_dt, *b_re, *b_im, *c_re, *c_im, *ssm_d, *w_glu, *b_glu;
  const float *mu, *w0, *w2, *a0, *a2, *k_k, *k_a, *u_bonus, *ln_w, *ln_b, *w_out;
  float* out;
  bf16_t *WinT, *WoutT, *WgluT, *hbf, *P, *mix, *yb;
  unsigned* counters;
  float* ssq;
};

DI int opq_v(int x) { asm volatile("" : "+v"(x)); return x; }
DI int opq_s(int x) { asm volatile("" : "+s"(x)); return x; }
#define TID opq_v((int)threadIdx.x)
#define BID opq_s((int)blockIdx.x)
#define GDIM opq_s((int)gridDim.x)
typedef float f32x4v __attribute__((ext_vector_type(4)));
DI void nt_store16(void* p, u32x4 v) { __builtin_nontemporal_store(v, (u32x4*)p); }
DI void nt_store16f(void* p, float4 v) { f32x4v t = {v.x, v.y, v.z, v.w}; __builtin_nontemporal_store(t, (f32x4v*)p); }
DI unsigned f2bf(float x) { unsigned u = __float_as_uint(x); u += 0x7fffu + ((u >> 16) & 1u); return u >> 16; }
DI unsigned pk2(float a, float b) { return f2bf(a) | (f2bf(b) << 16); }
DI float bf2f(unsigned v) { return __uint_as_float(v << 16); }
DI float bflo(unsigned w) { return __uint_as_float(w << 16); }
DI float bfhi(unsigned w) { return __uint_as_float(w & 0xffff0000u); }
DI float sigmoidf_(float x) { return __builtin_amdgcn_rcpf(1.f + __expf(-x)); }
DI float siluf_(float x) { return x * __builtin_amdgcn_rcpf(1.f + __expf(-x)); }
typedef float f32x2 __attribute__((ext_vector_type(2)));
DI f32x2 fma2(f32x2 a, f32x2 b, f32x2 c) { return __builtin_elementwise_fma(a, b, c); }
template <int CTRL> DI float dpp_mov(float x) { return __int_as_float(__builtin_amdgcn_update_dpp(0, __float_as_int(x), CTRL, 0xF, 0xF, true)); }
DI float sum8(float x) { x += dpp_mov<0xB1>(x); x += dpp_mov<0x4E>(x); x += dpp_mov<0x141>(x); return x; }
DI float fast_tanh(float x) { return 1.f - 2.f * __builtin_amdgcn_rcpf(1.f + __expf(2.f * x)); }
DI void lds_barrier() { asm volatile("s_waitcnt lgkmcnt(0)\n\ts_barrier" ::: "memory"); }
DI float wave_sum(float v) {
  v += dpp_mov<0xB1>(v); v += dpp_mov<0x4E>(v); v += dpp_mov<0x141>(v); v += dpp_mov<0x140>(v);
  v += __int_as_float(__builtin_amdgcn_update_dpp(0, __float_as_int(v), 0x142, 0xA, 0xF, false));
  v += __int_as_float(__builtin_amdgcn_update_dpp(0, __float_as_int(v), 0x143, 0xC, 0xF, false));
  return __int_as_float(__builtin_amdgcn_readlane(__float_as_int(v), 63));
}
DI const float* xrow(const Params& p, int layer, int row) {
  if (layer == 0) return row < NTOK_P ? p.x_prompt + (size_t)row * 1024 : p.x_sample + (size_t)(row - NTOK_P) * 1024;
  return p.out + (size_t)row * 1024;
}

DI void transpose_tile(const float* __restrict__ src, int K, int N, bf16_t* __restrict__ dst, int k0, int n0, float* tile) {
  const int tid = TID;
#pragma unroll
  for (int i = 0; i < 8; ++i) { int idx = tid + NT * i; int kk = idx >> 6, nn = idx & 63; tile[kk * 65 + nn] = src[(size_t)(k0 + kk) * N + n0 + nn]; }
  __syncthreads();
#pragma unroll
  for (int i = 0; i < 8; ++i) { int idx = tid + NT * i; int nn = idx >> 6, kk = idx & 63; dst[(size_t)(n0 + nn) * K + k0 + kk] = (bf16_t)f2bf(tile[kk * 65 + nn]); }
  __syncthreads();
}
DI void phase_weights(const Params& p, char* smem) {
  float* tile = (float*)smem;
  const int bid = BID, gdim = GDIM;
  for (int t = bid; t < 2400; t += gdim) {
    int layer = t / 1200, j = t % 1200;
    if (j < 912) { int kt = j / 57, nt = j % 57; transpose_tile(p.w_in + (size_t)layer * 1024 * 3648, 1024, 3648, p.WinT + (size_t)layer * 3648 * 1024, kt * 64, nt * 64, tile); }
    else if (j < 1168) { j -= 912; int kt = j / 16, nt = j % 16; transpose_tile(p.w_out + (size_t)layer * 1024 * 1024, 1024, 1024, p.WoutT + (size_t)layer * 1024 * 1024, kt * 64, nt * 64, tile); }
    else { j -= 1168; int kt = j / 8, nt = j % 8; transpose_tile(p.w_glu + (size_t)layer * 256 * 512, 256, 512, p.WgluT + (size_t)layer * 512 * 256, kt * 64, nt * 64, tile); }
  }
  { const int tid = TID; if (bid == 0 && tid < 64) p.counters[tid] = 0;
    for (int i = bid * NT + tid; i < NTOK; i += gdim * NT) p.ssq[i] = 0.f; }
}

DI void phase_norm(const Params& p, int layer) {
  const int tid = TID, lane = tid & 63, w = tid >> 6;
  const int bid = BID, gdim = GDIM;
  const float* nw = p.norm_w + layer * 1024;
  const int stride = gdim * 8;
  for (int row0 = bid * 8 + w; row0 < NTOK; row0 += 2 * stride) {
    const int row1 = row0 + stride;
    const bool has1 = row1 < NTOK;
    const float* x0 = xrow(p, layer, row0);
    const float* x1 = xrow(p, layer, has1 ? row1 : row0);
    float4 v0[4], v1[4]; float s0 = 0.f, s1 = 0.f;
#pragma unroll
    for (int i = 0; i < 4; ++i) { v0[i] = *(const float4*)(x0 + i * 256 + lane * 4); v1[i] = *(const float4*)(x1 + i * 256 + lane * 4); }
#pragma unroll
    for (int i = 0; i < 4; ++i) {
      s0 += v0[i].x * v0[i].x + v0[i].y * v0[i].y + v0[i].z * v0[i].z + v0[i].w * v0[i].w;
      s1 += v1[i].x * v1[i].x + v1[i].y * v1[i].y + v1[i].z * v1[i].z + v1[i].w * v1[i].w;
    }
    s0 = wave_sum(s0); s1 = wave_sum(s1);
    const float c0 = rsqrtf(s0 * (1.f / 1024.f) + 1e-6f), c1 = rsqrtf(s1 * (1.f / 1024.f) + 1e-6f);
#pragma unroll
    for (int i = 0; i < 4; ++i) {
      float4 wv = *(const float4*)(nw + i * 256 + lane * 4);
      u32x2 o; o.x = pk2(v0[i].x * c0 * wv.x, v0[i].y * c0 * wv.y); o.y = pk2(v0[i].z * c0 * wv.z, v0[i].w * c0 * wv.w);
      *(u32x2*)(p.hbf + (size_t)row0 * 1024 + i * 256 + lane * 4) = o;
      if (has1) {
        u32x2 o1; o1.x = pk2(v1[i].x * c1 * wv.x, v1[i].y * c1 * wv.y); o1.y = pk2(v1[i].z * c1 * wv.z, v1[i].w * c1 * wv.w);
        *(u32x2*)(p.hbf + (size_t)row1 * 1024 + i * 256 + lane * 4) = o1;
      }
    }
  }
}

template <int MODE>
DI void gemm_phase(const Params& p, int layer, char* smem) {
  constexpr int K = (MODE == 1) ? 256 : 1024;
  constexpr int NTN = (MODE == 0) ? 29 : (MODE == 1 ? 4 : 8);
  constexpr int KT = K / 64;
  const bf16_t* __restrict__ A = MODE == 0 ? p.hbf : (MODE == 1 ? p.yb : p.mix);
  const bf16_t* __restrict__ Bt = MODE == 0 ? p.WinT + (size_t)layer * 3648 * 1024 : (MODE == 1 ? p.WgluT + (size_t)layer * 512 * 256 : p.WoutT + (size_t)layer * 1024 * 1024);
  const int tid = TID, lane = tid & 63, wv = tid >> 6, r = lane & 31, h = lane >> 5;
  const int wm = wv >> 1, wn = wv & 1;
  const int bid = BID, gdim = GDIM;
  const int xcd = bid & 7, jb = bid >> 3, nbx = (gdim - xcd + 7) >> 3;

  const int total_x = ((258 - xcd + 7) >> 3) * NTN;
  const int nmine = jb < total_x ? (total_x - jb + nbx - 1) / nbx : 0;
  if (nmine == 0) return;
  const int lrow = tid >> 3, kc = tid & 7;
  const int ntm_x = (258 - xcd + 7) >> 3;
  auto decode = [&](int idx, int& tmi_o, int& tn_o) {
    constexpr int QW = 4 * NTN;
    const int nfull = ntm_x >> 2, remw = ntm_x & 3;
    const int quad = idx / QW;
    if (quad < nfull) { const int rem = idx - quad * QW; tn_o = rem >> 2; tmi_o = quad * 4 + (rem & 3); }
    else { const int rem = idx - nfull * QW; tn_o = rem / remw; tmi_o = nfull * 4 + rem % remw; }
  };
  auto set_ptrs = [&](int idx, const bf16_t* (&ap)[4], const bf16_t* (&bp)[2]) {
    int tmi_, tn_; decode(idx, tmi_, tn_);
    const int m0_ = (xcd + 8 * tmi_) * 256, n0_ = tn_ * 128;
#pragma unroll
    for (int i = 0; i < 4; ++i) ap[i] = A + (size_t)(m0_ + lrow + 64 * i) * K + kc * 8;
#pragma unroll
    for (int i = 0; i < 2; ++i) {
      int row = lrow + 64 * i, brow;
      if (MODE == 0) { brow = n0_ + row; brow = brow < 3648 ? brow : 3647; }
      else if (MODE == 2) brow = n0_ + row;
      else { int wn_ = row >> 6, nt_ = (row >> 5) & 1, c_ = row & 31; brow = nt_ * 256 + tn_ * 64 + wn_ * 32 + c_; }
      bp[i] = Bt + (size_t)brow * K + kc * 8;
    }
  };
  f32x16 acc[2][2];
  auto zero_acc = [&]() {
#pragma unroll
    for (int a = 0; a < 2; ++a)
#pragma unroll
      for (int b = 0; b < 2; ++b)
#pragma unroll
        for (int i = 0; i < 16; ++i) acc[a][b][i] = 0.f;
  };
  auto compute = [&](const char* buf, char* nbuf, const u32x4 (&pa)[4], const u32x4 (&pb)[2]) {
    const char* As = buf; const char* Bs = buf + 256 * LDS_ROW;
    char* An = nbuf; char* Bn = nbuf + 256 * LDS_ROW;
    __builtin_amdgcn_iglp_opt(0);
#pragma unroll
    for (int s = 0; s < 4; ++s) {
      bf16x8 af[2], bfr[2];
#pragma unroll
      for (int mt = 0; mt < 2; ++mt) af[mt] = *(const bf16x8*)(As + (wm * 64 + mt * 32 + r) * LDS_ROW + s * 32 + h * 16);
#pragma unroll
      for (int nt = 0; nt < 2; ++nt) bfr[nt] = *(const bf16x8*)(Bs + (wn * 64 + nt * 32 + r) * LDS_ROW + s * 32 + h * 16);
#pragma unroll
      for (int mt = 0; mt < 2; ++mt)
#pragma unroll
        for (int nt = 0; nt < 2; ++nt) acc[mt][nt] = MFMA(bfr[nt], af[mt], acc[mt][nt]);
      if (s < 2) {
        *(u32x4*)(An + (lrow + 64 * (2 * s)) * LDS_ROW + kc * 16) = pa[2 * s];
        *(u32x4*)(An + (lrow + 64 * (2 * s + 1)) * LDS_ROW + kc * 16) = pa[2 * s + 1];
      } else {
        *(u32x4*)(Bn + (lrow + 64 * (s - 2)) * LDS_ROW + kc * 16) = pb[s - 2];
      }
    }
  };
  u32x4 sa[4][4], sb[4][2];
  const bf16_t* cap[4]; const bf16_t* cbp[2]; const bf16_t* nap[4]; const bf16_t* nbp[2];
  set_ptrs(jb, cap, cbp);
#pragma unroll
  for (int j = 0; j < 4; ++j) {
#pragma unroll
    for (int i = 0; i < 4; ++i) sa[j][i] = *(const u32x4*)(cap[i] + j * 64);
#pragma unroll
    for (int i = 0; i < 2; ++i) sb[j][i] = *(const u32x4*)(cbp[i] + j * 64);
  }
  {
    char* As = smem; char* Bs = smem + 256 * LDS_ROW;
#pragma unroll
    for (int i = 0; i < 4; ++i) *(u32x4*)(As + (lrow + 64 * i) * LDS_ROW + kc * 16) = sa[0][i];
#pragma unroll
    for (int i = 0; i < 2; ++i) *(u32x4*)(Bs + (lrow + 64 * i) * LDS_ROW + kc * 16) = sb[0][i];
  }
  lds_barrier();
  zero_acc();
  int c_idx = jb;
  for (int ti = 0; ti < nmine; ++ti) {
    set_ptrs(ti + 1 < nmine ? c_idx + nbx : c_idx, nap, nbp);
    for (int q = 0; q < KT / 4; ++q) {
      const bool lastq = (q == KT / 4 - 1);
      const int koff = lastq ? 0 : (4 * (q + 1)) * 64;
      const bf16_t* lap[4]; const bf16_t* lbp[2];
#pragma unroll
      for (int i = 0; i < 4; ++i) lap[i] = (lastq ? nap[i] : cap[i]) + koff;
#pragma unroll
      for (int i = 0; i < 2; ++i) lbp[i] = (lastq ? nbp[i] : cbp[i]) + koff;
#pragma unroll
      for (int j = 0; j < 4; ++j) {
#pragma unroll
        for (int i = 0; i < 4; ++i) sa[j][i] = *(const u32x4*)(lap[i] + j * 64);
#pragma unroll
        for (int i = 0; i < 2; ++i) sb[j][i] = *(const u32x4*)(lbp[i] + j * 64);
        compute(smem + (j & 1) * STAGE, smem + ((j + 1) & 1) * STAGE, sa[(j + 1) & 3], sb[(j + 1) & 3]);
        lds_barrier();
      }
    }
#pragma unroll
    for (int i = 0; i < 4; ++i) cap[i] = nap[i];
#pragma unroll
    for (int i = 0; i < 2; ++i) cbp[i] = nbp[i];
    const int idx = c_idx; c_idx += nbx;
    int tmi, tn; decode(idx, tmi, tn);
    const int tm = xcd + 8 * tmi;
    const int m0 = tm * 256, n0 = tn * 128;
    char* eps = smem + 2 * STAGE + wv * 4608;
    if (MODE == 0) {
      const int nb = n0 + wn * 64;
      if (nb < 3648) {
        if (layer == 1) {
#pragma unroll
          for (int mt = 0; mt < 2; ++mt) {
            const float rs = rsqrtf(p.ssq[m0 + wm * 64 + mt * 32 + r] * (1.f / 1024.f) + 1e-6f);
#pragma unroll
            for (int nt = 0; nt < 2; ++nt)
#pragma unroll
              for (int i = 0; i < 16; ++i) acc[mt][nt][i] *= rs;
          }
        }
        float scale[2] = {1.f, 1.f};
        if (nb < 1024) {
#pragma unroll
          for (int mt = 0; mt < 2; ++mt) {
            float ss = 0.f;
#pragma unroll
            for (int nt = 0; nt < 2; ++nt)
#pragma unroll
              for (int i = 0; i < 16; ++i) ss += acc[mt][nt][i] * acc[mt][nt][i];
            ss += __shfl_xor(ss, 32);
            scale[mt] = rsqrtf(ss * (1.f / 64.f) + 1e-6f);
          }
        }
        const float* nw = (nb < 512 ? p.q_norm_w : p.k_norm_w) + layer * 64;
#pragma unroll
        for (int mt = 0; mt < 2; ++mt) {
          const int mb = m0 + wm * 64 + mt * 32;
          const int m = mb + r;
          const bool is_p = m < NTOK_P;
#pragma unroll
          for (int nt = 0; nt < 2; ++nt) {
#pragma unroll
            for (int g = 0; g < 4; ++g) {
              const int ncol = nb + nt * 32 + 8 * g + 4 * h;
              float v0 = acc[mt][nt][4 * g], v1 = acc[mt][nt][4 * g + 1], v2 = acc[mt][nt][4 * g + 2], v3 = acc[mt][nt][4 * g + 3];
              if (nb < 1024) {
                float4 w4 = *(const float4*)(nw + (ncol - nb));
                v0 *= scale[mt] * w4.x; v1 *= scale[mt] * w4.y; v2 *= scale[mt] * w4.z; v3 *= scale[mt] * w4.w;
              }
              *(float4*)(eps + r * 144 + (8 * g + 4 * h) * 4) = make_float4(v0, v1, v2, v3);
              if (nb >= OFF_C && nb < OFF_GC) {
                const bool last = is_p ? ((m & 2047) == 2047) : (((m - NTOK_P) & 31) == 31);
                if (last) {
                  float* dst = p.out + (is_p ? O_SHP + ((size_t)layer * 32 + (m >> 11)) * 832 : O_SHS + ((size_t)layer * 16 + ((m - NTOK_P) >> 5)) * 832) + (ncol - OFF_C);
                  *(float4*)dst = make_float4(v0, v1, v2, v3);
                }
              }
            }
            __builtin_amdgcn_wave_barrier();
#pragma unroll
            for (int it = 0; it < 2; ++it) {
              const int row = (lane >> 2) + 16 * it, ch = lane & 3;
              const float4 a = *(const float4*)(eps + row * 144 + ch * 32), c = *(const float4*)(eps + row * 144 + ch * 32 + 16);
              u32x4 o; o.x = pk2(a.x, a.y); o.y = pk2(a.z, a.w); o.z = pk2(c.x, c.y); o.w = pk2(c.z, c.w);
              nt_store16(p.P + (size_t)(mb + row) * D_IN + nb + nt * 32 + ch * 8, o);
            }
            if (nb >= 512 && nb < 1536) {
#pragma unroll
              for (int it = 0; it < 4; ++it) {
                const int row = it * 8 + (lane >> 3), ch = lane & 7;
                const float4 a = *(const float4*)(eps + row * 144 + ch * 16);
                const int mm = mb + row;
                const bool pp = mm < NTOK_P;
                float* dst;
                if (nb < 1024) dst = p.out + (pp ? O_KP + ((size_t)layer * 65536 + mm) * 512 : O_KS + ((size_t)layer * 512 + (mm - NTOK_P)) * 512) + (nb - 512);
                else dst = p.out + (pp ? O_VP + ((size_t)layer * 65536 + mm) * 512 : O_VS + ((size_t)layer * 512 + (mm - NTOK_P)) * 512) + (nb - 1024);
                nt_store16f(dst + nt * 32 + ch * 4, a);
              }
            }
            __builtin_amdgcn_wave_barrier();
          }
        }
      }
    } else if (MODE == 1) {
      const float* bg = p.b_glu + layer * 512;
#pragma unroll
      for (int mt = 0; mt < 2; ++mt) {
        const int m = m0 + wm * 64 + mt * 32 + r;
#pragma unroll
        for (int g = 0; g < 4; ++g) {
          const int col = tn * 64 + wn * 32 + 8 * g + 4 * h;
          float4 bv = *(const float4*)(bg + col), bgt = *(const float4*)(bg + 256 + col);
          u32x2 gb = *(const u32x2*)(p.P + (size_t)m * D_IN + OFF_GB + col);
          float o0 = (acc[mt][0][4 * g] + bv.x) * sigmoidf_(acc[mt][1][4 * g] + bgt.x) * siluf_(bflo(gb.x));
          float o1 = (acc[mt][0][4 * g + 1] + bv.y) * sigmoidf_(acc[mt][1][4 * g + 1] + bgt.y) * siluf_(bfhi(gb.x));
          float o2 = (acc[mt][0][4 * g + 2] + bv.z) * sigmoidf_(acc[mt][1][4 * g + 2] + bgt.z) * siluf_(bflo(gb.y));
          float o3 = (acc[mt][0][4 * g + 3] + bv.w) * sigmoidf_(acc[mt][1][4 * g + 3] + bgt.w) * siluf_(bfhi(gb.y));
          u32x2 o; o.x = pk2(o0, o1); o.y = pk2(o2, o3);
          *(u32x2*)(p.mix + (size_t)m * 1024 + 512 + col) = o;
        }
      }
    } else {
      const float* nw1 = p.norm_w + 1024;
#pragma unroll
      for (int mt = 0; mt < 2; ++mt) {
        const int mb = m0 + wm * 64 + mt * 32;
        float sq[4] = {0.f, 0.f, 0.f, 0.f};
#pragma unroll
        for (int nt = 0; nt < 2; ++nt) {
#pragma unroll
          for (int g = 0; g < 4; ++g)
            *(float4*)(eps + r * 144 + (8 * g + 4 * h) * 4) = make_float4(acc[mt][nt][4 * g], acc[mt][nt][4 * g + 1], acc[mt][nt][4 * g + 2], acc[mt][nt][4 * g + 3]);
          __builtin_amdgcn_wave_barrier();
#pragma unroll
          for (int it = 0; it < 4; ++it) {
            const int row = it * 8 + (lane >> 3), ch = lane & 7;
            const float4 a = *(const float4*)(eps + row * 144 + ch * 16);
            const int mm = mb + row, ncol = n0 + wn * 64 + nt * 32 + ch * 4;
            float4 xv = *(const float4*)(xrow(p, layer, mm) + ncol);
            xv.x += a.x; xv.y += a.y; xv.z += a.z; xv.w += a.w;
            nt_store16f(p.out + (size_t)mm * 1024 + ncol, xv);
            if (layer == 0) {
              sq[it] += xv.x * xv.x + xv.y * xv.y + xv.z * xv.z + xv.w * xv.w;
              const float4 w4 = *(const float4*)(nw1 + ncol);
              u32x2 o; o.x = pk2(xv.x * w4.x, xv.y * w4.y); o.y = pk2(xv.z * w4.z, xv.w * w4.w);
              *(u32x2*)(p.hbf + (size_t)mm * 1024 + ncol) = o;
            }
          }
          __builtin_amdgcn_wave_barrier();
        }
        if (layer == 0) {
#pragma unroll
          for (int it = 0; it < 4; ++it) {
            const float s = sum8(sq[it]);
            if ((lane & 7) == 0) atomicAdd(p.ssq + mb + it * 8 + (lane >> 3), s);
          }
        }
      }
    }
    zero_acc();
  }
}

constexpr int VS = 66;
DI void attn_item(const Params& p, int layer, int wi, bf16_t* vl) {
  const int lane = TID & 63, r = lane & 31, h = lane >> 5;
  const bool sample = wi >= 16384;
  int b, hd, qt, tok0, qabs0;
  if (!sample) { b = wi >> 9; hd = (wi >> 6) & 7; qt = wi & 63; tok0 = b * 2048; qabs0 = qt * 32; }
  else { int j = wi - 16384; b = j >> 3; hd = j & 7; qt = 0; tok0 = NTOK_P + b * 32; qabs0 = 4096; }
  const int tq0 = tok0 + qt * 32;
  bf16x8 qf[4];
  {
    const bf16_t* qp = p.P + (size_t)(tq0 + r) * D_IN + OFF_Q + hd * 64 + h * 8;
#pragma unroll
    for (int ks = 0; ks < 4; ++ks) qf[ks] = *(const bf16x8*)(qp + ks * 16);
  }
  f32x16 o[2];
#pragma unroll
  for (int d = 0; d < 2; ++d)
#pragma unroll
    for (int i = 0; i < 16; ++i) o[d][i] = 0.f;
  float run = 0.f;
  const int nblk = qabs0 / 32 + 1;
  const int pir = 16 * ((r >> 2) & 1) + 4 * (r >> 3) + (r & 3);
  const float* ck = p.cache_k + ((size_t)(layer * 16 + b) * 4096) * 512 + hd * 64;
  const float* cv = p.cache_v + ((size_t)(layer * 16 + b) * 4096) * 512 + hd * 64;

  bf16x8 kfn[4]; u32x4 vrn[4];
  auto load_p = [&](int kb_) {
    const int kp0_ = kb_ * 32;
    const int tk = sample ? (tok0 + (kp0_ + pir - 4096)) : (tok0 + kp0_ + pir);
    const bf16_t* kp = p.P + (size_t)tk * D_IN + OFF_K + hd * 64 + h * 8;
#pragma unroll
    for (int ks = 0; ks < 4; ++ks) kfn[ks] = *(const bf16x8*)(kp + ks * 16);
#pragma unroll
    for (int i = 0; i < 4; ++i) {
      const int key = i * 8 + (lane >> 3), dc = lane & 7;
      const int tv = sample ? (tok0 + (kp0_ + key - 4096)) : (tok0 + kp0_ + key);
      vrn[i] = *(const u32x4*)(p.P + (size_t)tv * D_IN + OFF_V + hd * 64 + dc * 8);
    }
  };
  load_p(nblk - 1);
  for (int kb = nblk - 1; kb >= 0; --kb) {
    const int kp0 = kb * 32;
    const bool fromP = (!sample) || (kb == 128);
    bf16x8 kf[4];
    if (fromP) {
#pragma unroll
      for (int ks = 0; ks < 4; ++ks) kf[ks] = kfn[ks];
#pragma unroll
      for (int i = 0; i < 4; ++i) {
        const int key = i * 8 + (lane >> 3), dc = lane & 7;
        unsigned* dst = (unsigned*)(vl + key * VS + dc * 8);
        dst[0] = vrn[i].x; dst[1] = vrn[i].y; dst[2] = vrn[i].z; dst[3] = vrn[i].w;
      }
      if (!sample && kb > 0) load_p(kb - 1);
    } else {
      const float* kp = ck + (size_t)(kp0 + pir) * 512 + h * 8;
#pragma unroll
      for (int ks = 0; ks < 4; ++ks) {
        float4 a = *(const float4*)(kp + ks * 16), c = *(const float4*)(kp + ks * 16 + 4);
        u32x4 t; t.x = pk2(a.x, a.y); t.y = pk2(a.z, a.w); t.z = pk2(c.x, c.y); t.w = pk2(c.z, c.w);
        kf[ks] = __builtin_bit_cast(bf16x8, t);
      }
#pragma unroll
      for (int i = 0; i < 4; ++i) {
        const int key = i * 8 + (lane >> 3), dc = lane & 7;
        const float* vp = cv + (size_t)(kp0 + key) * 512 + dc * 8;
        float4 a = *(const float4*)vp, c = *(const float4*)(vp + 4);
        unsigned* dst = (unsigned*)(vl + key * VS + dc * 8);
        dst[0] = pk2(a.x, a.y); dst[1] = pk2(a.z, a.w); dst[2] = pk2(c.x, c.y); dst[3] = pk2(c.z, c.w);
      }
    }
    f32x16 st;
#pragma unroll
    for (int i = 0; i < 16; ++i) st[i] = 0.f;
#pragma unroll
    for (int ks = 0; ks < 4; ++ks) st = MFMA(kf[ks], qf[ks], st);
    const bool diag = (kb == nblk - 1);
    float z[16], lk[16], lat[16];
#pragma unroll
    for (int i = 0; i < 16; ++i) {
      z[i] = st[i] * 0.125f;
      const bool msk = (!diag) || (16 * h + i < r);
      const float e = __expf(-fabsf(z[i]));
      const float sp = fmaxf(z[i], 0.f) + __logf(1.f + e);
      lk[i] = msk ? -sp : 0.f;
    }
    float suf = 0.f;
#pragma unroll
    for (int i = 15; i >= 0; --i) { lat[i] = suf; suf += lk[i]; }
    const float other = __shfl_xor(suf, 32);
    const float base = run + (h == 0 ? other : 0.f);
    float a[16];
#pragma unroll
    for (int i = 0; i < 16; ++i) {
      const bool msk = (!diag) || (16 * h + i < r);
      a[i] = msk ? __expf(z[i] + lk[i] + base + lat[i]) : 0.f;
    }
    run += suf + other;
    __builtin_amdgcn_wave_barrier();
#pragma unroll
    for (int s2 = 0; s2 < 2; ++s2) {
      u32x4 t; t.x = pk2(a[8 * s2], a[8 * s2 + 1]); t.y = pk2(a[8 * s2 + 2], a[8 * s2 + 3]); t.z = pk2(a[8 * s2 + 4], a[8 * s2 + 5]); t.w = pk2(a[8 * s2 + 6], a[8 * s2 + 7]);
      const bf16x8 pf = __builtin_bit_cast(bf16x8, t);
#pragma unroll
      for (int dt = 0; dt < 2; ++dt) {
        const bf16_t* vp = vl + (16 * h + 8 * s2) * VS + 32 * dt + r;
        bf16x8 vf;
#pragma unroll
        for (int j = 0; j < 8; ++j) vf[j] = (short)vp[j * VS];
        o[dt] = MFMA(vf, pf, o[dt]);
      }
    }
    __builtin_amdgcn_wave_barrier();
    if (__all(run < -104.f)) break;
  }
  const int tok = tq0 + r;
#pragma unroll
  for (int dt = 0; dt < 2; ++dt)
#pragma unroll
    for (int g = 0; g < 4; ++g) {
      const int d0 = 32 * dt + 8 * g + 4 * h;
      u32x2 ga = *(const u32x2*)(p.P + (size_t)tok * D_IN + OFF_GA + hd * 64 + d0);
      u32x2 ov;
      ov.x = pk2(o[dt][4 * g] * siluf_(bflo(ga.x)), o[dt][4 * g + 1] * siluf_(bfhi(ga.x)));
      ov.y = pk2(o[dt][4 * g + 2] * siluf_(bflo(ga.y)), o[dt][4 * g + 3] * siluf_(bfhi(ga.y)));
      *(u32x2*)(p.mix + (size_t)tok * 1024 + hd * 64 + d0) = ov;
    }
}

constexpr int S5_BU = 8192;
constexpr int S5_LDS = S5_BU + 8704 + 1024;
DI void s5_disc(const Params& p, int lg, int pi, float dt, float& ar, float& ai, float& fr, float& fi) {
  const float lr = fminf(p.lam_re[lg * 64 + pi], -1e-4f), li = p.lam_im[lg * 64 + pi];
  const float er = expf(lr * dt);
  ar = er * cosf(li * dt); ai = er * sinf(li * dt);
  const float den = lr * lr + li * li;
  fr = ((ar - 1.f) * lr + ai * li) / den; fi = (ai * lr - (ar - 1.f) * li) / den;
}
DI void s5_item(const Params& p, int layer, int item, char* lds) {
  float* BU = (float*)lds;
  char* Himg = lds + S5_BU;
  bf16_t* Ub = (bf16_t*)(lds + S5_BU + 8704);
  const int lane = TID & 63, r = lane & 31, h = lane >> 5;
  const int seq = item >> 4, g = item & 15;
  const bool sample = seq >= 32;
  const int b = sample ? seq - 32 : seq, L = sample ? 32 : 2048, tok0 = sample ? NTOK_P + b * 32 : b * 2048;
  const int lg = layer * 16 + g;
  const float dt = expf(p.log_dt[lg]);
  float ar, ai, fr_, fi_;
  s5_disc(p, lg, lane, dt, ar, ai, fr_, fi_);
  bf16x8 bbf[4];
#pragma unroll
  for (int half = 0; half < 2; ++half) {
    const int pi = 32 * half + r;
    float a_r, a_i, f_r, f_i;
    s5_disc(p, lg, pi, dt, a_r, a_i, f_r, f_i);
    const float* brp = p.b_re + ((size_t)lg * 64 + pi) * 16 + 8 * h;
    const float* bip = p.b_im + ((size_t)lg * 64 + pi) * 16 + 8 * h;
    float re[8], im[8];
#pragma unroll
    for (int j = 0; j < 8; ++j) { const float br = brp[j], bi = bip[j]; re[j] = f_r * br - f_i * bi; im[j] = f_r * bi + f_i * br; }
    u32x4 t0, t1;
    t0.x = pk2(re[0], re[1]); t0.y = pk2(re[2], re[3]); t0.z = pk2(re[4], re[5]); t0.w = pk2(re[6], re[7]);
    t1.x = pk2(im[0], im[1]); t1.y = pk2(im[2], im[3]); t1.z = pk2(im[4], im[5]); t1.w = pk2(im[6], im[7]);
    bbf[half] = __builtin_bit_cast(bf16x8, t0);
    bbf[2 + half] = __builtin_bit_cast(bf16x8, t1);
  }
  bf16x8 cf[8];
#pragma unroll
  for (int s = 0; s < 8; ++s) {
    u32x4 t; t.x = 0; t.y = 0; t.z = 0; t.w = 0;
    if (r < 16) {
      const int k0 = 16 * s + 8 * h;
      const float* src = (s < 4 ? p.c_re : p.c_im) + ((size_t)lg * 16 + r) * 64 + (k0 & 63);
      const float sg = s < 4 ? 1.f : -1.f;
      const float4 c0 = *(const float4*)src, c1 = *(const float4*)(src + 4);
      t.x = pk2(sg * c0.x, sg * c0.y); t.y = pk2(sg * c0.z, sg * c0.w); t.z = pk2(sg * c1.x, sg * c1.y); t.w = pk2(sg * c1.z, sg * c1.w);
    }
    cf[s] = __builtin_bit_cast(bf16x8, t);
  }
  const float dl = p.ssm_d[lg * 16 + (r & 15)];
  float hr = 0.f, hi = 0.f;
  if (sample) { hr = p.st_re[((size_t)(layer * 16 + b) * 16 + g) * 64 + lane]; hi = p.st_im[((size_t)(layer * 16 + b) * 16 + g) * 64 + lane]; }
  f32x16 zero;
#pragma unroll
  for (int i = 0; i < 16; ++i) zero[i] = 0.f;
  const bf16_t* upb = p.P + (size_t)(tok0 + r) * D_IN + OFF_U + g * 16 + 8 * h;
  bf16x8 uf = *(const bf16x8*)upb;
  for (int t0 = 0; t0 < L; t0 += 32) {
    const bf16x8 ucur = uf;
    if (t0 + 32 < L) uf = *(const bf16x8*)(upb + (size_t)(t0 + 32) * D_IN);
    *(bf16x8*)(Ub + r * 16 + 8 * h) = ucur;
    f32x16 d[4];
#pragma unroll
    for (int tile = 0; tile < 4; ++tile) d[tile] = MFMA(ucur, bbf[tile], zero);
#pragma unroll
    for (int hf = 0; hf < 2; ++hf) {
#pragma unroll
      for (int tile = 0; tile < 4; ++tile)
#pragma unroll
        for (int i = 0; i < 8; ++i) BU[((i & 3) + 8 * (i >> 2) + 4 * h) * 128 + 32 * tile + r] = d[tile][8 * hf + i];
      __builtin_amdgcn_wave_barrier();
#pragma unroll
      for (int tt = 0; tt < 16; ++tt) {
        const int t = 16 * hf + tt;
        const float bur = BU[tt * 128 + lane], bui = BU[tt * 128 + 64 + lane];
        const float nhr = ar * hr - ai * hi + bur, nhi = ar * hi + ai * hr + bui;
        hr = nhr; hi = nhi;
        *(bf16_t*)(Himg + t * 272 + lane * 2) = (bf16_t)f2bf(hr);
        *(bf16_t*)(Himg + t * 272 + 128 + lane * 2) = (bf16_t)f2bf(hi);
      }
      __builtin_amdgcn_wave_barrier();
    }
    f32x16 yacc = zero;
#pragma unroll
    for (int s = 0; s < 8; ++s) {
      const bf16x8 af = *(const bf16x8*)(Himg + r * 272 + s * 32 + h * 16);
      yacc = MFMA(af, cf[s], yacc);
    }
    if (r < 16) {
#pragma unroll
      for (int i = 0; i < 16; ++i) {
        const int t = (i & 3) + 8 * (i >> 2) + 4 * h;
        const float yv = yacc[i] + dl * bf2f(Ub[t * 16 + r]);
        const float gl = yv * __builtin_amdgcn_rcpf(1.f + __expf(-1.5957691216f * (yv + 0.044715f * yv * yv * yv)));
        p.yb[(size_t)(tok0 + t0 + t) * 256 + g * 16 + r] = (bf16_t)f2bf(gl);
      }
    }
    __builtin_amdgcn_wave_barrier();
  }
  float* ore = p.out + (sample ? O_SRES : O_SREP) + ((size_t)(layer * (sample ? 16 : 32) + b) * 16 + g) * 64 + lane;
  float* oim = p.out + (sample ? O_SIMS : O_SIMP) + ((size_t)(layer * (sample ? 16 : 32) + b) * 16 + g) * 64 + lane;
  *ore = hr; *oim = hi;
}

DI void rwkv_item(const Params& p, int layer, int item, char* smem) {
  constexpr int SETF = 6 * 2048;
  float* SET0 = (float*)smem;
  float* YB = SET0 + 2 * SETF;
  char* PW = (char*)(YB + 2 * 2048);
  const int tid = TID, lane = tid & 63, wv = tid >> 6;
  const int seq = item >> 2, hd = item & 3;
  const bool sample = seq >= 32;
  const int b = sample ? seq - 32 : seq, L = sample ? 32 : 2048, tok0 = sample ? NTOK_P + b * 32 : b * 2048;
  const int nch = L >> 5;
  if (wv < 4) {
    const int rp = tid >> 3, kq = tid & 7;
    f32x2 S0[4], S1[4];
    if (sample) {
      const float* sp = p.st_wkv + (((size_t)(layer * 16 + b) * 4 + hd) * 64 + rp) * 64 + kq * 8;
#pragma unroll
      for (int j = 0; j < 4; ++j) { S0[j].x = sp[2 * j]; S0[j].y = sp[2 * j + 1]; S1[j].x = sp[2048 + 2 * j]; S1[j].y = sp[2048 + 2 * j + 1]; }
    } else {
#pragma unroll
      for (int j = 0; j < 4; ++j) { S0[j].x = 0.f; S0[j].y = 0.f; S1[j].x = 0.f; S1[j].y = 0.f; }
    }
    lds_barrier();
    for (int c = 0; c < nch; ++c) {
      const float* R = SET0 + (c & 1) * SETF; const float* W = R + 2048; const float* KT = W + 2048; const float* KH = KT + 2048;
      const float* BB = KH + 2048; const float* V = BB + 2048;
      float* Y = YB + (c & 1) * 2048;
      float yk0[4], yk1[4];
      float4 nkh0, nkh1, nw0, nw1, nb0, nb1, nk0, nk1, nr0, nr1; float nv0, nv1;
      {
        const int o = kq * 8;
        nkh0 = *(const float4*)(KH + o); nkh1 = *(const float4*)(KH + o + 4); nw0 = *(const float4*)(W + o); nw1 = *(const float4*)(W + o + 4);
        nb0 = *(const float4*)(BB + o); nb1 = *(const float4*)(BB + o + 4); nk0 = *(const float4*)(KT + o); nk1 = *(const float4*)(KT + o + 4);
        nr0 = *(const float4*)(R + o); nr1 = *(const float4*)(R + o + 4); nv0 = V[rp]; nv1 = V[rp + 32];
      }
#pragma unroll
      for (int q = 0; q < 4; ++q) {
        yk0[q] = 0.f; yk1[q] = 0.f;
#pragma unroll
        for (int e = 0; e < 8; ++e) {
          const int tl = q * 8 + e;
          const float4 kh0 = nkh0, kh1 = nkh1, w0_ = nw0, w1_ = nw1, b0 = nb0, b1 = nb1, k0 = nk0, k1 = nk1, r0 = nr0, r1 = nr1;
          const float va = nv0, vb = nv1;
          if (tl < 31) {
            const int o = (tl + 1) * 64 + kq * 8;
            nkh0 = *(const float4*)(KH + o); nkh1 = *(const float4*)(KH + o + 4); nw0 = *(const float4*)(W + o); nw1 = *(const float4*)(W + o + 4);
            nb0 = *(const float4*)(BB + o); nb1 = *(const float4*)(BB + o + 4); nk0 = *(const float4*)(KT + o); nk1 = *(const float4*)(KT + o + 4);
            nr0 = *(const float4*)(R + o); nr1 = *(const float4*)(R + o + 4); nv0 = V[(tl + 1) * 64 + rp]; nv1 = V[(tl + 1) * 64 + rp + 32];
          }
          const f32x2 khv[4] = {{kh0.x, kh0.y}, {kh0.z, kh0.w}, {kh1.x, kh1.y}, {kh1.z, kh1.w}};
          const f32x2 wvv[4] = {{w0_.x, w0_.y}, {w0_.z, w0_.w}, {w1_.x, w1_.y}, {w1_.z, w1_.w}};
          const f32x2 bv[4] = {{b0.x, b0.y}, {b0.z, b0.w}, {b1.x, b1.y}, {b1.z, b1.w}};
          const f32x2 kv[4] = {{k0.x, k0.y}, {k0.z, k0.w}, {k1.x, k1.y}, {k1.z, k1.w}};
          const f32x2 rv[4] = {{r0.x, r0.y}, {r0.z, r0.w}, {r1.x, r1.y}, {r1.z, r1.w}};
          const f32x2 va2 = {va, va}, vb2 = {vb, vb};
          f32x2 ma[4], mb[4];
#pragma unroll
          for (int j = 0; j < 4; ++j) { ma[j] = fma2(S0[j], wvv[j], va2 * kv[j]); mb[j] = fma2(S1[j], wvv[j], vb2 * kv[j]); }
          f32x2 sa2 = fma2(S0[1], khv[1], S0[0] * khv[0]) + fma2(S0[3], khv[3], S0[2] * khv[2]);
          f32x2 sb2 = fma2(S1[1], khv[1], S1[0] * khv[0]) + fma2(S1[3], khv[3], S1[2] * khv[2]);
          const float sa = sum8(sa2.x + sa2.y), sb = sum8(sb2.x + sb2.y);
          const f32x2 nsa = {-sa, -sa}, nsb = {-sb, -sb};
#pragma unroll
          for (int j = 0; j < 4; ++j) { S0[j] = fma2(nsa, bv[j], ma[j]); S1[j] = fma2(nsb, bv[j], mb[j]); }
          f32x2 ya2 = fma2(S0[1], rv[1], S0[0] * rv[0]) + fma2(S0[3], rv[3], S0[2] * rv[2]);
          f32x2 yb2 = fma2(S1[1], rv[1], S1[0] * rv[0]) + fma2(S1[3], rv[3], S1[2] * rv[2]);
          const float ya = sum8(ya2.x + ya2.y), ybv = sum8(yb2.x + yb2.y);
          yk0[q] = (e == kq) ? ya : yk0[q];
          yk1[q] = (e == kq) ? ybv : yk1[q];
        }
      }
#pragma unroll
      for (int q = 0; q < 4; ++q) { Y[(q * 8 + kq) * 64 + rp] = yk0[q]; Y[(q * 8 + kq) * 64 + rp + 32] = yk1[q]; }
      lds_barrier();
    }
    float* so = p.out + (sample ? O_WKVS : O_WKVP) + (((size_t)(layer * (sample ? 16 : 32) + b) * 4 + hd) * 64 + rp) * 64 + kq * 8;
    *(float4*)so = make_float4(S0[0].x, S0[0].y, S0[1].x, S0[1].y);
    *(float4*)(so + 4) = make_float4(S0[2].x, S0[2].y, S0[3].x, S0[3].y);
    *(float4*)(so + 2048) = make_float4(S1[0].x, S1[0].y, S1[1].x, S1[1].y);
    *(float4*)(so + 2052) = make_float4(S1[2].x, S1[2].y, S1[3].x, S1[3].y);
  } else {
    const int pw = wv - 4, r_ = lane & 31, h_ = lane >> 5;
    const int cg_ = hd * 64 + lane;
    bf16_t* LORAb = (bf16_t*)(PW + pw * 5248);
    float* DSA = (float*)(PW + pw * 5248 + 1152);
    bf16x8 lb[2][2][2];
#pragma unroll
    for (int ll = 0; ll < 2; ++ll)
#pragma unroll
      for (int nn = 0; nn < 2; ++nn) {
        const float* srcw = (ll ? p.a2 : p.w2) + (size_t)layer * 32 * 256 + hd * 64 + 32 * nn + r_;
#pragma unroll
        for (int s = 0; s < 2; ++s) {
          float t[8];
#pragma unroll
          for (int j = 0; j < 8; ++j) t[j] = srcw[(size_t)(16 * s + 8 * h_ + j) * 256];
          u32x4 u; u.x = pk2(t[0], t[1]); u.y = pk2(t[2], t[3]); u.z = pk2(t[4], t[5]); u.w = pk2(t[6], t[7]);
          lb[ll][nn][s] = __builtin_bit_cast(bf16x8, u);
        }
      }
    const float w0c = p.w0[layer * 256 + cg_], a0c = p.a0[layer * 256 + cg_], kkc = p.k_k[layer * 256 + cg_], kac = p.k_a[layer * 256 + cg_];
    const float ubc = p.u_bonus[layer * 256 + cg_], lnw = p.ln_w[layer * 256 + cg_], lnb = p.ln_b[layer * 256 + cg_];
    const float* mu = p.mu + layer * 832;
    const float mu_r = mu[cg_], mu_k = mu[256 + cg_], mu_v = mu[512 + cg_], mu_l = mu[768 + lane];
    const float* shp = p.st_shift + (size_t)(layer * 16 + b) * 832;
    auto pre = [&](int c, float (&xvk)[8], float (&bonk)[8], float (&gtk)[8]) {
      float* R = SET0 + (c & 1) * SETF; float* W = R + 2048; float* KT = W + 2048; float* KH = KT + 2048; float* BB = KH + 2048; float* V = BB + 2048;
      const bf16_t* base = p.P + (size_t)(tok0 + c * 32 + 8 * pw) * D_IN + OFF_C;
      bf16_t cr[8], ck[8], cv[8], cl[8], cgt[8];
#pragma unroll
      for (int i = 0; i < 8; ++i) {
        const bf16_t* cp = base + (size_t)i * D_IN;
        cr[i] = cp[cg_]; ck[i] = cp[256 + cg_]; cv[i] = cp[512 + cg_]; cl[i] = cp[768 + lane]; cgt[i] = cp[OFF_GC - OFF_C + cg_];
      }
      float pr, pk, pv, pl;
      if (c * 32 + 8 * pw == 0) {
        if (sample) { pr = shp[cg_]; pk = shp[256 + cg_]; pv = shp[512 + cg_]; pl = shp[768 + lane]; }
        else { pr = 0.f; pk = 0.f; pv = 0.f; pl = 0.f; }
      } else {
        const bf16_t* pp = base - D_IN;
        pr = bf2f(pp[cg_]); pk = bf2f(pp[256 + cg_]); pv = bf2f(pp[512 + cg_]); pl = bf2f(pp[768 + lane]);
      }
      float xr_[8], xk_[8];
#pragma unroll
      for (int i = 0; i < 8; ++i) {
        const float c_r = bf2f(cr[i]), c_k = bf2f(ck[i]), c_v = bf2f(cv[i]), c_l = bf2f(cl[i]);
        xr_[i] = c_r + mu_r * (pr - c_r); xk_[i] = c_k + mu_k * (pk - c_k); xvk[i] = c_v + mu_v * (pv - c_v);
        const float xl = c_l + mu_l * (pl - c_l);
        pr = c_r; pk = c_k; pv = c_v; pl = c_l;
        gtk[i] = bf2f(cgt[i]);
        LORAb[i * 72 + lane] = (bf16_t)f2bf(lane < 32 ? fast_tanh(xl) : xl);
      }
      __builtin_amdgcn_wave_barrier();
#pragma unroll
      for (int ll = 0; ll < 2; ++ll) {
        const bf16x8 af0 = *(const bf16x8*)((const char*)LORAb + (r_ & 7) * 144 + ll * 64 + h_ * 16);
        const bf16x8 af1 = *(const bf16x8*)((const char*)LORAb + (r_ & 7) * 144 + ll * 64 + 32 + h_ * 16);
#pragma unroll
        for (int nn = 0; nn < 2; ++nn) {
          f32x16 dacc;
#pragma unroll
          for (int i = 0; i < 16; ++i) dacc[i] = 0.f;
          dacc = MFMA(af0, lb[ll][nn][0], dacc);
          dacc = MFMA(af1, lb[ll][nn][1], dacc);
#pragma unroll
          for (int i = 0; i < 4; ++i) DSA[ll * 512 + (i + 4 * h_) * 64 + 32 * nn + r_] = dacc[i];
        }
      }
      __builtin_amdgcn_wave_barrier();
#pragma unroll
      for (int i = 0; i < 8; ++i) {
        const int tl = 8 * pw + i;
        const float dsum = w0c + DSA[i * 64 + lane], asum = a0c + DSA[512 + i * 64 + lane];
        const float dec = __expf(-0.6065306597f * sigmoidf_(dsum));
        const float a = sigmoidf_(asum);
        const float kk = xk_[i] * kkc;
        const float ss = wave_sum(kk * kk);
        const float kh = kk * __builtin_amdgcn_rsqf(ss + 1e-12f);
        const float kt = xk_[i] * (1.f + (a - 1.f) * kac);
        bonk[i] = wave_sum(xr_[i] * kt * ubc);
        R[tl * 64 + lane] = xr_[i]; W[tl * 64 + lane] = dec; KT[tl * 64 + lane] = kt; KH[tl * 64 + lane] = kh; BB[tl * 64 + lane] = a * kh; V[tl * 64 + lane] = xvk[i];
      }
      __builtin_amdgcn_wave_barrier();
    };
    auto post = [&](int c, const float (&xvk)[8], const float (&bonk)[8], const float (&gtk)[8]) {
      const float* Y = YB + (c & 1) * 2048;
#pragma unroll
      for (int i = 0; i < 8; ++i) {
        const int tl = 8 * pw + i;
        const float y = Y[tl * 64 + lane];
        const float mean = wave_sum(y) * (1.f / 64.f);
        const float msq = wave_sum(y * y) * (1.f / 64.f);
        const float var = fmaxf(msq - mean * mean, 0.f);
        float yn = (y - mean) * __builtin_amdgcn_rsqf(var + 64e-5f) * lnw + lnb;
        yn += bonk[i] * xvk[i];
        p.mix[(size_t)(tok0 + c * 32 + tl) * 1024 + 768 + cg_] = (bf16_t)f2bf(yn * siluf_(gtk[i]));
      }
    };
    float xvA[8], bonA[8], gtA[8], xvB[8], bonB[8], gtB[8];
#pragma unroll
    for (int i = 0; i < 8; ++i) { xvB[i] = 0.f; bonB[i] = 0.f; gtB[i] = 0.f; }
    pre(0, xvA, bonA, gtA);
    lds_barrier();
    for (int c = 0; c < nch; c += 2) {
      if (c >= 1) post(c - 1, xvB, bonB, gtB);
      if (c + 1 < nch) pre(c + 1, xvB, bonB, gtB);
      lds_barrier();
      if (c + 1 < nch) {
        post(c, xvA, bonA, gtA);
        if (c + 2 < nch) pre(c + 2, xvA, bonA, gtA);
        lds_barrier();
      }
    }
    if ((nch - 1) & 1) post(nch - 1, xvB, bonB, gtB); else post(nch - 1, xvA, bonA, gtA);
  }
  lds_barrier();
}

constexpr int ATT_LDS0 = 6 * S5_LDS;
DI void phase_mixers(const Params& p, int layer, char* smem, int cofs) {
  const int G = GDIM, bid = BID, half = G / 2;
  const int tid = TID, wv = tid >> 6, lane = tid & 63;
  if (bid < half) {
    for (int item = bid; item < 128; item += half) rwkv_item(p, layer, item, smem);
  } else {
    const int j = bid - half, nb2 = G - half;
    for (int item = 128 + j; item < 192; item += nb2) rwkv_item(p, layer, item, smem);
    if (wv < 6) { for (int it = j * 6 + wv; it < 768; it += nb2 * 6) s5_item(p, layer, it, smem + wv * S5_LDS); }
  }
  unsigned* ctr = p.counters + layer + cofs;
  bf16_t* vl = (bf16_t*)(smem + ATT_LDS0) + wv * (32 * VS);
  while (true) {
    int it = 0;
    if (lane == 0) it = (int)atomicAdd(ctr, 1u);
    it = __builtin_amdgcn_readfirstlane(it);
    if (it >= 16512) break;
    attn_item(p, layer, it, vl);
  }
}

__global__ void __launch_bounds__(NT) mega(Params p) {
  __shared__ __attribute__((aligned(16))) char smem[SMEM_BYTES];
  cg::grid_group grid = cg::this_grid();
  phase_weights(p, smem);
  phase_norm(p, 0);
  grid.sync();
  for (int layer = 0; layer < 2; ++layer) {
    gemm_phase<0>(p, layer, smem);
    grid.sync();
#if PROBE_GEMM0
    gemm_phase<0>(p, layer, smem);
    grid.sync();
#endif
    phase_mixers(p, layer, smem, 0);
    grid.sync();
#if PROBE_MIX
    phase_mixers(p, layer, smem, 2);
    grid.sync();
#endif
    gemm_phase<1>(p, layer, smem);
    grid.sync();
    gemm_phase<2>(p, layer, smem);
    if (layer == 0) grid.sync();
  }
}

#if MULTI_LAUNCH
template <int PH>
__global__ void __launch_bounds__(NT) phase_kernel(Params p, int layer) {
  __shared__ __attribute__((aligned(16))) char smem[SMEM_BYTES];
  if (PH == 0) { phase_weights(p, smem); }
  else if (PH == 1) phase_norm(p, layer);
  else if (PH == 2) gemm_phase<0>(p, layer, smem);
  else if (PH == 3) phase_mixers(p, layer, smem, 0);
  else if (PH == 4) gemm_phase<1>(p, layer, smem);
  else gemm_phase<2>(p, layer, smem);
}
#endif

extern "C" void kernel_launch(void* const* d_in, const int* in_sizes, int n_in, void* d_out, int out_size, void* d_ws, size_t ws_size, hipStream_t stream) {
  Params p{};
  const float** f = (const float**)&p;
  for (int i = 0; i < 33; ++i) f[i] = (const float*)d_in[i];
  p.out = (float*)d_out;
  char* ws = (char*)d_ws;
  size_t off = 0;
  auto take = [&](size_t bytes) { char* q = ws + off; off += (bytes + 255) & ~(size_t)255; return q; };
  p.WinT = (bf16_t*)take((size_t)2 * 3648 * 1024 * 2);
  p.WoutT = (bf16_t*)take((size_t)2 * 1024 * 1024 * 2);
  p.WgluT = (bf16_t*)take((size_t)2 * 512 * 256 * 2);
  p.hbf = (bf16_t*)take((size_t)NTOK * 1024 * 2);
  p.P = (bf16_t*)take((size_t)NTOK * D_IN * 2);
  p.mix = (bf16_t*)take((size_t)NTOK * 1024 * 2);
  p.yb = (bf16_t*)take((size_t)NTOK * 256 * 2);
  p.counters = (unsigned*)take(256);
  p.ssq = (float*)take((size_t)NTOK * 4);
  if (off > ws_size || (size_t)out_size != O_END || n_in != 33) fprintf(stderr, "kernel_launch: unexpected sizes ws=%zu need=%zu out=%d n_in=%d\n", ws_size, off, out_size, n_in);
#if MULTI_LAUNCH
  const int G = 256;
  phase_kernel<0><<<G, NT, 0, stream>>>(p, 0);
  for (int layer = 0; layer < 2; ++layer) {
    phase_kernel<1><<<G, NT, 0, stream>>>(p, layer);
    phase_kernel<2><<<G, NT, 0, stream>>>(p, layer);
    phase_kernel<3><<<G, NT, 0, stream>>>(p, layer);
    phase_kernel<4><<<G, NT, 0, stream>>>(p, layer);
    phase_kernel<5><<<G, NT, 0, stream>>>(p, layer);
  }
#else
  static int grid_blocks = 0;
  if (!grid_blocks) {
    int dev = 0, cus = 0, per_cu = 0;
    hipGetDevice(&dev);
    hipDeviceGetAttribute(&cus, hipDeviceAttributeMultiprocessorCount, dev);
    hipOccupancyMaxActiveBlocksPerMultiprocessor(&per_cu, mega, NT, 0);
    if (per_cu < 1) per_cu = 1;
    grid_blocks = cus * per_cu;
  }
  void* args[] = {&p};
  hipError_t e = hipLaunchCooperativeKernel((void*)mega, dim3(grid_blocks), dim3(NT), args, 0, stream);
  if (e != hipSuccess) fprintf(stderr, "cooperative launch failed: %s (grid %d)\n", hipGetErrorString(e), grid_blocks);
#endif
}
```

```cpp
#include <hip/hip_runtime.h>
#include <hip/hip_cooperative_groups.h>
#include <cstdio>
namespace cg = cooperative_groups;

#define PROBE_GEMM0 0
#define PROBE_MIX 0
#ifndef MULTI_LAUNCH
#define MULTI_LAUNCH 0
#endif

#define DI __device__ __forceinline__
typedef unsigned short bf16_t;
typedef short bf16x8 __attribute__((ext_vector_type(8)));
typedef float f32x16 __attribute__((ext_vector_type(16)));
typedef unsigned u32x4 __attribute__((ext_vector_type(4)));
typedef unsigned u32x2 __attribute__((ext_vector_type(2)));
#define MFMA(a, b, c) __builtin_amdgcn_mfma_f32_32x32x16_bf16((a), (b), (c), 0, 0, 0)

constexpr int NT = 512;
constexpr int NTOK_P = 65536, NTOK = 66048, D_IN = 3648;
constexpr int OFF_Q = 0, OFF_K = 512, OFF_V = 1024, OFF_GA = 1536, OFF_U = 2048, OFF_GB = 2304, OFF_C = 2560, OFF_GC = 3392;
constexpr size_t O_Y = 0, O_KP = 67633152, O_VP = 134742016, O_SREP = 201850880, O_SIMP = 201916416, O_WKVP = 201981952,
                 O_SHP = 203030528, O_KS = 203083776, O_VS = 203608064, O_SRES = 204132352, O_SIMS = 204165120,
                 O_WKVS = 204197888, O_SHS = 204722176, O_END = 204748800;
constexpr int SMEM_BYTES = 2 * 55296 + 8 * 4608;
constexpr int LDS_ROW = 144;
constexpr int STAGE = (256 + 128) * LDS_ROW;

struct Params {
  const float *x_prompt, *x_sample, *cache_k, *cache_v, *st_re, *st_im, *st_wkv, *st_shift;
  const float *norm_w, *w_in, *q_norm_w, *k_norm_w, *lam_re, *lam_im, *log_dt, *b_re, *b_im, *c_re, *c_im, *ssm_d, *w_glu, *b_glu;
  const float *mu, *w0, *w2, *a0, *a2, *k_k, *k_a, *u_bonus, *ln_w, *ln_b, *w_out;
  float* out;
  bf16_t *WinT, *WoutT, *WgluT, *hbf, *P, *mix, *yb;
  unsigned* counters;
  float* ssq;
};

DI int opq_v(int x) { asm volatile("" : "+v"(x)); return x; }
DI int opq_s(int x) { asm volatile("" : "+s"(x)); return x; }
#define TID opq_v((int)threadIdx.x)
#define BID opq_s((int)blockIdx.x)
#define GDIM opq_s((int)gridDim.x)
typedef float f32x4v __attribute__((ext_vector_type(4)));
DI void nt_store16(void* p, u32x4 v) { __builtin_nontemporal_store(v, (u32x4*)p); }
DI void nt_store16f(void* p, float4 v) { f32x4v t = {v.x, v.y, v.z, v.w}; __builtin_nontemporal_store(t, (f32x4v*)p); }
typedef __bf16 bf16x2_t __attribute__((ext_vector_type(2)));
typedef float f32x2c __attribute__((ext_vector_type(2)));
DI unsigned pk2(float a, float b) { f32x2c v = {a, b}; bf16x2_t r = __builtin_convertvector(v, bf16x2_t); return __builtin_bit_cast(unsigned, r); }
DI unsigned f2bf(float x) { return pk2(x, 0.f) & 0xffffu; }
DI float bf2f(unsigned v) { return __uint_as_float(v << 16); }
DI float bflo(unsigned w) { return __uint_as_float(w << 16); }
DI float bfhi(unsigned w) { return __uint_as_float(w & 0xffff0000u); }
DI float sigmoidf_(float x) { return __builtin_amdgcn_rcpf(1.f + __expf(-x)); }
DI float siluf_(float x) { return x * __builtin_amdgcn_rcpf(1.f + __expf(-x)); }
typedef float f32x2 __attribute__((ext_vector_type(2)));
DI f32x2 fma2(f32x2 a, f32x2 b, f32x2 c) { return __builtin_elementwise_fma(a, b, c); }
template <int CTRL> DI float dpp_mov(float x) { return __int_as_float(__builtin_amdgcn_update_dpp(0, __float_as_int(x), CTRL, 0xF, 0xF, true)); }
DI float sum8(float x) { x += dpp_mov<0xB1>(x); x += dpp_mov<0x4E>(x); x += dpp_mov<0x141>(x); return x; }
DI float fast_tanh(float x) { return 1.f - 2.f * __builtin_amdgcn_rcpf(1.f + __expf(2.f * x)); }
DI void lds_barrier() { asm volatile("s_waitcnt lgkmcnt(0)\n\ts_barrier" ::: "memory"); }
DI float wave_sum(float v) {
  v += dpp_mov<0xB1>(v); v += dpp_mov<0x4E>(v); v += dpp_mov<0x141>(v); v += dpp_mov<0x140>(v);
  v += __int_as_float(__builtin_amdgcn_update_dpp(0, __float_as_int(v), 0x142, 0xA, 0xF, false));
  v += __int_as_float(__builtin_amdgcn_update_dpp(0, __float_as_int(v), 0x143, 0xC, 0xF, false));
  return __int_as_float(__builtin_amdgcn_readlane(__float_as_int(v), 63));
}
DI const float* xrow(const Params& p, int layer, int row) {
  if (layer == 0) return row < NTOK_P ? p.x_prompt + (size_t)row * 1024 : p.x_sample + (size_t)(row - NTOK_P) * 1024;
  return p.out + (size_t)row * 1024;
}

DI void transpose_tile(const float* __restrict__ src, int K, int N, bf16_t* __restrict__ dst, int k0, int n0, float* tile) {
  const int tid = TID;
#pragma unroll
  for (int i = 0; i < 8; ++i) { int idx = tid + NT * i; int kk = idx >> 6, nn = idx & 63; tile[kk * 65 + nn] = src[(size_t)(k0 + kk) * N + n0 + nn]; }
  __syncthreads();
#pragma unroll
  for (int i = 0; i < 8; ++i) { int idx = tid + NT * i; int nn = idx >> 6, kk = idx & 63; dst[(size_t)(n0 + nn) * K + k0 + kk] = (bf16_t)f2bf(tile[kk * 65 + nn]); }
  __syncthreads();
}
DI void phase_weights(const Params& p, char* smem) {
  float* tile = (float*)smem;
  const int bid = BID, gdim = GDIM;
  for (int t = bid; t < 2400; t += gdim) {
    int layer = t / 1200, j = t % 1200;
    if (j < 912) { int kt = j / 57, nt = j % 57; transpose_tile(p.w_in + (size_t)layer * 1024 * 3648, 1024, 3648, p.WinT + (size_t)layer * 3648 * 1024, kt * 64, nt * 64, tile); }
    else if (j < 1168) { j -= 912; int kt = j / 16, nt = j % 16; transpose_tile(p.w_out + (size_t)layer * 1024 * 1024, 1024, 1024, p.WoutT + (size_t)layer * 1024 * 1024, kt * 64, nt * 64, tile); }
    else { j -= 1168; int kt = j / 8, nt = j % 8; transpose_tile(p.w_glu + (size_t)layer * 256 * 512, 256, 512, p.WgluT + (size_t)layer * 512 * 256, kt * 64, nt * 64, tile); }
  }
  { const int tid = TID; if (bid == 0 && tid < 64) p.counters[tid] = 0;
    for (int i = bid * NT + tid; i < NTOK; i += gdim * NT) p.ssq[i] = 0.f; }
}

DI void phase_norm(const Params& p, int layer) {
  const int tid = TID, lane = tid & 63, w = tid >> 6;
  const int bid = BID, gdim = GDIM;
  const float* nw = p.norm_w + layer * 1024;
  const int stride = gdim * 8;
  for (int row0 = bid * 8 + w; row0 < NTOK; row0 += 2 * stride) {
    const int row1 = row0 + stride;
    const bool has1 = row1 < NTOK;
    const float* x0 = xrow(p, layer, row0);
    const float* x1 = xrow(p, layer, has1 ? row1 : row0);
    float4 v0[4], v1[4]; float s0 = 0.f, s1 = 0.f;
#pragma unroll
    for (int i = 0; i < 4; ++i) { v0[i] = *(const float4*)(x0 + i * 256 + lane * 4); v1[i] = *(const float4*)(x1 + i * 256 + lane * 4); }
#pragma unroll
    for (int i = 0; i < 4; ++i) {
      s0 += v0[i].x * v0[i].x + v0[i].y * v0[i].y + v0[i].z * v0[i].z + v0[i].w * v0[i].w;
      s1 += v1[i].x * v1[i].x + v1[i].y * v1[i].y + v1[i].z * v1[i].z + v1[i].w * v1[i].w;
    }
    s0 = wave_sum(s0); s1 = wave_sum(s1);
    const float c0 = rsqrtf(s0 * (1.f / 1024.f) + 1e-6f), c1 = rsqrtf(s1 * (1.f / 1024.f) + 1e-6f);
#pragma unroll
    for (int i = 0; i < 4; ++i) {
      float4 wv = *(const float4*)(nw + i * 256 + lane * 4);
      u32x2 o; o.x = pk2(v0[i].x * c0 * wv.x, v0[i].y * c0 * wv.y); o.y = pk2(v0[i].z * c0 * wv.z, v0[i].w * c0 * wv.w);
      *(u32x2*)(p.hbf + (size_t)row0 * 1024 + i * 256 + lane * 4) = o;
      if (has1) {
        u32x2 o1; o1.x = pk2(v1[i].x * c1 * wv.x, v1[i].y * c1 * wv.y); o1.y = pk2(v1[i].z * c1 * wv.z, v1[i].w * c1 * wv.w);
        *(u32x2*)(p.hbf + (size_t)row1 * 1024 + i * 256 + lane * 4) = o1;
      }
    }
  }
}

template <int MODE>
DI void gemm_phase(const Params& p, int layer, char* smem) {
  constexpr int K = (MODE == 1) ? 256 : 1024;
  constexpr int NTN = (MODE == 0) ? 29 : (MODE == 1 ? 4 : 8);
  constexpr int KT = K / 64;
  const bf16_t* __restrict__ A = MODE == 0 ? p.hbf : (MODE == 1 ? p.yb : p.mix);
  const bf16_t* __restrict__ Bt = MODE == 0 ? p.WinT + (size_t)layer * 3648 * 1024 : (MODE == 1 ? p.WgluT + (size_t)layer * 512 * 256 : p.WoutT + (size_t)layer * 1024 * 1024);
  const int tid = TID, lane = tid & 63, wv = tid >> 6, r = lane & 31, h = lane >> 5;
  const int wm = wv >> 1, wn = wv & 1;
  const int bid = BID, gdim = GDIM;
  const int xcd = bid & 7, jb = bid >> 3, nbx = (gdim - xcd + 7) >> 3;

  const int total_x = ((258 - xcd + 7) >> 3) * NTN;
  const int nmine = jb < total_x ? (total_x - jb + nbx - 1) / nbx : 0;
  if (nmine == 0) return;
  const int lrow = tid >> 3, kc = tid & 7;
  const int ntm_x = (258 - xcd + 7) >> 3;
  auto decode = [&](int idx, int& tmi_o, int& tn_o) {
    constexpr int QW = 4 * NTN;
    const int nfull = ntm_x >> 2, remw = ntm_x & 3;
    const int quad = idx / QW;
    if (quad < nfull) { const int rem = idx - quad * QW; tn_o = rem >> 2; tmi_o = quad * 4 + (rem & 3); }
    else { const int rem = idx - nfull * QW; tn_o = rem / remw; tmi_o = nfull * 4 + rem % remw; }
  };
  auto set_ptrs = [&](int idx, const bf16_t* (&ap)[4], const bf16_t* (&bp)[2]) {
    int tmi_, tn_; decode(idx, tmi_, tn_);
    const int m0_ = (xcd + 8 * tmi_) * 256, n0_ = tn_ * 128;
#pragma unroll
    for (int i = 0; i < 4; ++i) ap[i] = A + (size_t)(m0_ + lrow + 64 * i) * K + kc * 8;
#pragma unroll
    for (int i = 0; i < 2; ++i) {
      int row = lrow + 64 * i, brow;
      if (MODE == 0) { brow = n0_ + row; brow = brow < 3648 ? brow : 3647; }
      else if (MODE == 2) brow = n0_ + row;
      else { int wn_ = row >> 6, nt_ = (row >> 5) & 1, c_ = row & 31; brow = nt_ * 256 + tn_ * 64 + wn_ * 32 + c_; }
      bp[i] = Bt + (size_t)brow * K + kc * 8;
    }
  };
  f32x16 acc[2][2];
  auto zero_acc = [&]() {
#pragma unroll
    for (int a = 0; a < 2; ++a)
#pragma unroll
      for (int b = 0; b < 2; ++b)
#pragma unroll
        for (int i = 0; i < 16; ++i) acc[a][b][i] = 0.f;
  };
  auto compute = [&](const char* buf, char* nbuf, const u32x4 (&pa)[4], const u32x4 (&pb)[2]) {
    const char* As = buf; const char* Bs = buf + 256 * LDS_ROW;
    char* An = nbuf; char* Bn = nbuf + 256 * LDS_ROW;
    __builtin_amdgcn_iglp_opt(0);
#pragma unroll
    for (int s = 0; s < 4; ++s) {
      bf16x8 af[2], bfr[2];
#pragma unroll
      for (int mt = 0; mt < 2; ++mt) af[mt] = *(const bf16x8*)(As + (wm * 64 + mt * 32 + r) * LDS_ROW + s * 32 + h * 16);
#pragma unroll
      for (int nt = 0; nt < 2; ++nt) bfr[nt] = *(const bf16x8*)(Bs + (wn * 64 + nt * 32 + r) * LDS_ROW + s * 32 + h * 16);
#pragma unroll
      for (int mt = 0; mt < 2; ++mt)
#pragma unroll
        for (int nt = 0; nt < 2; ++nt) acc[mt][nt] = MFMA(bfr[nt], af[mt], acc[mt][nt]);
      if (s < 2) {
        *(u32x4*)(An + (lrow + 64 * (2 * s)) * LDS_ROW + kc * 16) = pa[2 * s];
        *(u32x4*)(An + (lrow + 64 * (2 * s + 1)) * LDS_ROW + kc * 16) = pa[2 * s + 1];
      } else {
        *(u32x4*)(Bn + (lrow + 64 * (s - 2)) * LDS_ROW + kc * 16) = pb[s - 2];
      }
    }
  };
  u32x4 sa[4][4], sb[4][2];
  const bf16_t* cap[4]; const bf16_t* cbp[2]; const bf16_t* nap[4]; const bf16_t* nbp[2];
  set_ptrs(jb, cap, cbp);
#pragma unroll
  for (int j = 0; j < 4; ++j) {
#pragma unroll
    for (int i = 0; i < 4; ++i) sa[j][i] = *(const u32x4*)(cap[i] + j * 64);
#pragma unroll
    for (int i = 0; i < 2; ++i) sb[j][i] = *(const u32x4*)(cbp[i] + j * 64);
  }
  {
    char* As = smem; char* Bs = smem + 256 * LDS_ROW;
#pragma unroll
    for (int i = 0; i < 4; ++i) *(u32x4*)(As + (lrow + 64 * i) * LDS_ROW + kc * 16) = sa[0][i];
#pragma unroll
    for (int i = 0; i < 2; ++i) *(u32x4*)(Bs + (lrow + 64 * i) * LDS_ROW + kc * 16) = sb[0][i];
  }
  lds_barrier();
  zero_acc();
  int c_idx = jb;
  for (int ti = 0; ti < nmine; ++ti) {
    set_ptrs(ti + 1 < nmine ? c_idx + nbx : c_idx, nap, nbp);
    for (int q = 0; q < KT / 4; ++q) {
      const bool lastq = (q == KT / 4 - 1);
      const int koff = lastq ? 0 : (4 * (q + 1)) * 64;
      const bf16_t* lap[4]; const bf16_t* lbp[2];
#pragma unroll
      for (int i = 0; i < 4; ++i) lap[i] = (lastq ? nap[i] : cap[i]) + koff;
#pragma unroll
      for (int i = 0; i < 2; ++i) lbp[i] = (lastq ? nbp[i] : cbp[i]) + koff;
#pragma unroll
      for (int j = 0; j < 4; ++j) {
#pragma unroll
        for (int i = 0; i < 4; ++i) sa[j][i] = *(const u32x4*)(lap[i] + j * 64);
#pragma unroll
        for (int i = 0; i < 2; ++i) sb[j][i] = *(const u32x4*)(lbp[i] + j * 64);
        compute(smem + (j & 1) * STAGE, smem + ((j + 1) & 1) * STAGE, sa[(j + 1) & 3], sb[(j + 1) & 3]);
        lds_barrier();
      }
    }
#pragma unroll
    for (int i = 0; i < 4; ++i) cap[i] = nap[i];
#pragma unroll
    for (int i = 0; i < 2; ++i) cbp[i] = nbp[i];
    const int idx = c_idx; c_idx += nbx;
    int tmi, tn; decode(idx, tmi, tn);
    const int tm = xcd + 8 * tmi;
    const int m0 = tm * 256, n0 = tn * 128;
    char* eps = smem + 2 * STAGE + wv * 4608;
    if (MODE == 0) {
      const int nb = n0 + wn * 64;
      if (nb < 3648) {
        if (layer == 1) {
#pragma unroll
          for (int mt = 0; mt < 2; ++mt) {
            const float rs = rsqrtf(p.ssq[m0 + wm * 64 + mt * 32 + r] * (1.f / 1024.f) + 1e-6f);
#pragma unroll
            for (int nt = 0; nt < 2; ++nt)
#pragma unroll
              for (int i = 0; i < 16; ++i) acc[mt][nt][i] *= rs;
          }
        }
        float scale[2] = {1.f, 1.f};
        if (nb < 1024) {
#pragma unroll
          for (int mt = 0; mt < 2; ++mt) {
            float ss = 0.f;
#pragma unroll
            for (int nt = 0; nt < 2; ++nt)
#pragma unroll
              for (int i = 0; i < 16; ++i) ss += acc[mt][nt][i] * acc[mt][nt][i];
            ss += __shfl_xor(ss, 32);
            scale[mt] = rsqrtf(ss * (1.f / 64.f) + 1e-6f);
          }
        }
        const float* nw = (nb < 512 ? p.q_norm_w : p.k_norm_w) + layer * 64;
#pragma unroll
        for (int mt = 0; mt < 2; ++mt) {
          const int mb = m0 + wm * 64 + mt * 32;
          const int m = mb + r;
          const bool is_p = m < NTOK_P;
#pragma unroll
          for (int nt = 0; nt < 2; ++nt) {
#pragma unroll
            for (int g = 0; g < 4; ++g) {
              const int ncol = nb + nt * 32 + 8 * g + 4 * h;
              float v0 = acc[mt][nt][4 * g], v1 = acc[mt][nt][4 * g + 1], v2 = acc[mt][nt][4 * g + 2], v3 = acc[mt][nt][4 * g + 3];
              if (nb < 1024) {
                float4 w4 = *(const float4*)(nw + (ncol - nb));
                v0 *= scale[mt] * w4.x; v1 *= scale[mt] * w4.y; v2 *= scale[mt] * w4.z; v3 *= scale[mt] * w4.w;
              }
              *(float4*)(eps + r * 144 + (8 * g + 4 * h) * 4) = make_float4(v0, v1, v2, v3);
              if (nb >= OFF_C && nb < OFF_GC) {
                const bool last = is_p ? ((m & 2047) == 2047) : (((m - NTOK_P) & 31) == 31);
                if (last) {
                  float* dst = p.out + (is_p ? O_SHP + ((size_t)layer * 32 + (m >> 11)) * 832 : O_SHS + ((size_t)layer * 16 + ((m - NTOK_P) >> 5)) * 832) + (ncol - OFF_C);
                  *(float4*)dst = make_float4(v0, v1, v2, v3);
                }
              }
            }
            __builtin_amdgcn_wave_barrier();
#pragma unroll
            for (int it = 0; it < 2; ++it) {
              const int row = (lane >> 2) + 16 * it, ch = lane & 3;
              const float4 a = *(const float4*)(eps + row * 144 + ch * 32), c = *(const float4*)(eps + row * 144 + ch * 32 + 16);
              u32x4 o; o.x = pk2(a.x, a.y); o.y = pk2(a.z, a.w); o.z = pk2(c.x, c.y); o.w = pk2(c.z, c.w);
              nt_store16(p.P + (size_t)(mb + row) * D_IN + nb + nt * 32 + ch * 8, o);
            }
            if (nb >= 512 && nb < 1536) {
#pragma unroll
              for (int it = 0; it < 4; ++it) {
                const int row = it * 8 + (lane >> 3), ch = lane & 7;
                const float4 a = *(const float4*)(eps + row * 144 + ch * 16);
                const int mm = mb + row;
                const bool pp = mm < NTOK_P;
                float* dst;
                if (nb < 1024) dst = p.out + (pp ? O_KP + ((size_t)layer * 65536 + mm) * 512 : O_KS + ((size_t)layer * 512 + (mm - NTOK_P)) * 512) + (nb - 512);
                else dst = p.out + (pp ? O_VP + ((size_t)layer * 65536 + mm) * 512 : O_VS + ((size_t)layer * 512 + (mm - NTOK_P)) * 512) + (nb - 1024);
                nt_store16f(dst + nt * 32 + ch * 4, a);
              }
            }
            __builtin_amdgcn_wave_barrier();
          }
        }
      }
    } else if (MODE == 1) {
      const float* bg = p.b_glu + layer * 512;
#pragma unroll
      for (int mt = 0; mt < 2; ++mt) {
        const int m = m0 + wm * 64 + mt * 32 + r;
#pragma unroll
        for (int g = 0; g < 4; ++g) {
          const int col = tn * 64 + wn * 32 + 8 * g + 4 * h;
          float4 bv = *(const float4*)(bg + col), bgt = *(const float4*)(bg + 256 + col);
          u32x2 gb = *(const u32x2*)(p.P + (size_t)m * D_IN + OFF_GB + col);
          float o0 = (acc[mt][0][4 * g] + bv.x) * sigmoidf_(acc[mt][1][4 * g] + bgt.x) * siluf_(bflo(gb.x));
          float o1 = (acc[mt][0][4 * g + 1] + bv.y) * sigmoidf_(acc[mt][1][4 * g + 1] + bgt.y) * siluf_(bfhi(gb.x));
          float o2 = (acc[mt][0][4 * g + 2] + bv.z) * sigmoidf_(acc[mt][1][4 * g + 2] + bgt.z) * siluf_(bflo(gb.y));
          float o3 = (acc[mt][0][4 * g + 3] + bv.w) * sigmoidf_(acc[mt][1][4 * g + 3] + bgt.w) * siluf_(bfhi(gb.y));
          u32x2 o; o.x = pk2(o0, o1); o.y = pk2(o2, o3);
          *(u32x2*)(p.mix + (size_t)m * 1024 + 512 + col) = o;
        }
      }
    } else {
      const float* nw1 = p.norm_w + 1024;
#pragma unroll
      for (int mt = 0; mt < 2; ++mt) {
        const int mb = m0 + wm * 64 + mt * 32;
        float sq[4] = {0.f, 0.f, 0.f, 0.f};
#pragma unroll
        for (int nt = 0; nt < 2; ++nt) {
#pragma unroll
          for (int g = 0; g < 4; ++g)
            *(float4*)(eps + r * 144 + (8 * g + 4 * h) * 4) = make_float4(acc[mt][nt][4 * g], acc[mt][nt][4 * g + 1], acc[mt][nt][4 * g + 2], acc[mt][nt][4 * g + 3]);
          __builtin_amdgcn_wave_barrier();
#pragma unroll
          for (int it = 0; it < 4; ++it) {
            const int row = it * 8 + (lane >> 3), ch = lane & 7;
            const float4 a = *(const float4*)(eps + row * 144 + ch * 16);
            const int mm = mb + row, ncol = n0 + wn * 64 + nt * 32 + ch * 4;
            float4 xv = *(const float4*)(xrow(p, layer, mm) + ncol);
            xv.x += a.x; xv.y += a.y; xv.z += a.z; xv.w += a.w;
            nt_store16f(p.out + (size_t)mm * 1024 + ncol, xv);
            if (layer == 0) {
              sq[it] += xv.x * xv.x + xv.y * xv.y + xv.z * xv.z + xv.w * xv.w;
              const float4 w4 = *(const float4*)(nw1 + ncol);
              u32x2 o; o.x = pk2(xv.x * w4.x, xv.y * w4.y); o.y = pk2(xv.z * w4.z, xv.w * w4.w);
              *(u32x2*)(p.hbf + (size_t)mm * 1024 + ncol) = o;
            }
          }
          __builtin_amdgcn_wave_barrier();
        }
        if (layer == 0) {
#pragma unroll
          for (int it = 0; it < 4; ++it) {
            const float s = sum8(sq[it]);
            if ((lane & 7) == 0) atomicAdd(p.ssq + mb + it * 8 + (lane >> 3), s);
          }
        }
      }
    }
    zero_acc();
  }
}

constexpr int VS = 66;
DI void attn_item(const Params& p, int layer, int wi, bf16_t* vl) {
  const int lane = TID & 63, r = lane & 31, h = lane >> 5;
  const bool sample = wi >= 16384;
  int b, hd, qt, tok0, qabs0;
  if (!sample) { b = wi >> 9; hd = (wi >> 6) & 7; qt = wi & 63; tok0 = b * 2048; qabs0 = qt * 32; }
  else { int j = wi - 16384; b = j >> 3; hd = j & 7; qt = 0; tok0 = NTOK_P + b * 32; qabs0 = 4096; }
  const int tq0 = tok0 + qt * 32;
  bf16x8 qf[4];
  {
    const bf16_t* qp = p.P + (size_t)(tq0 + r) * D_IN + OFF_Q + hd * 64 + h * 8;
#pragma unroll
    for (int ks = 0; ks < 4; ++ks) qf[ks] = *(const bf16x8*)(qp + ks * 16);
  }
  f32x16 o[2];
#pragma unroll
  for (int d = 0; d < 2; ++d)
#pragma unroll
    for (int i = 0; i < 16; ++i) o[d][i] = 0.f;
  float run = 0.f;
  const int nblk = qabs0 / 32 + 1;
  const int pir = 16 * ((r >> 2) & 1) + 4 * (r >> 3) + (r & 3);
  const float* ck = p.cache_k + ((size_t)(layer * 16 + b) * 4096) * 512 + hd * 64;
  const float* cv = p.cache_v + ((size_t)(layer * 16 + b) * 4096) * 512 + hd * 64;

  bf16x8 kfn[4]; u32x4 vrn[4];
  auto load_p = [&](int kb_) {
    const int kp0_ = kb_ * 32;
    const int tk = sample ? (tok0 + (kp0_ + pir - 4096)) : (tok0 + kp0_ + pir);
    const bf16_t* kp = p.P + (size_t)tk * D_IN + OFF_K + hd * 64 + h * 8;
#pragma unroll
    for (int ks = 0; ks < 4; ++ks) kfn[ks] = *(const bf16x8*)(kp + ks * 16);
#pragma unroll
    for (int i = 0; i < 4; ++i) {
      const int key = i * 8 + (lane >> 3), dc = lane & 7;
      const int tv = sample ? (tok0 + (kp0_ + key - 4096)) : (tok0 + kp0_ + key);
      vrn[i] = *(const u32x4*)(p.P + (size_t)tv * D_IN + OFF_V + hd * 64 + dc * 8);
    }
  };
  load_p(nblk - 1);
  for (int kb = nblk - 1; kb >= 0; --kb) {
    const int kp0 = kb * 32;
    const bool fromP = (!sample) || (kb == 128);
    bf16x8 kf[4];
    if (fromP) {
#pragma unroll
      for (int ks = 0; ks < 4; ++ks) kf[ks] = kfn[ks];
#pragma unroll
      for (int i = 0; i < 4; ++i) {
        const int key = i * 8 + (lane >> 3), dc = lane & 7;
        unsigned* dst = (unsigned*)(vl + key * VS + dc * 8);
        dst[0] = vrn[i].x; dst[1] = vrn[i].y; dst[2] = vrn[i].z; dst[3] = vrn[i].w;
      }
      if (!sample && kb > 0) load_p(kb - 1);
    } else {
      const float* kp = ck + (size_t)(kp0 + pir) * 512 + h * 8;
#pragma unroll
      for (int ks = 0; ks < 4; ++ks) {
        float4 a = *(const float4*)(kp + ks * 16), c = *(const float4*)(kp + ks * 16 + 4);
        u32x4 t; t.x = pk2(a.x, a.y); t.y = pk2(a.z, a.w); t.z = pk2(c.x, c.y); t.w = pk2(c.z, c.w);
        kf[ks] = __builtin_bit_cast(bf16x8, t);
      }
#pragma unroll
      for (int i = 0; i < 4; ++i) {
        const int key = i * 8 + (lane >> 3), dc = lane & 7;
        const float* vp = cv + (size_t)(kp0 + key) * 512 + dc * 8;
        float4 a = *(const float4*)vp, c = *(const float4*)(vp + 4);
        unsigned* dst = (unsigned*)(vl + key * VS + dc * 8);
        dst[0] = pk2(a.x, a.y); dst[1] = pk2(a.z, a.w); dst[2] = pk2(c.x, c.y); dst[3] = pk2(c.z, c.w);
      }
    }
    f32x16 st;
#pragma unroll
    for (int i = 0; i < 16; ++i) st[i] = 0.f;
#pragma unroll
    for (int ks = 0; ks < 4; ++ks) st = MFMA(kf[ks], qf[ks], st);
    const bool diag = (kb == nblk - 1);
    float z[16], lk[16], lat[16];
#pragma unroll
    for (int i = 0; i < 16; ++i) {
      z[i] = st[i] * 0.125f;
      const bool msk = (!diag) || (16 * h + i < r);
      const float e = __expf(-fabsf(z[i]));
      const float sp = fmaxf(z[i], 0.f) + __logf(1.f + e);
      lk[i] = msk ? -sp : 0.f;
    }
    float suf = 0.f;
#pragma unroll
    for (int i = 15; i >= 0; --i) { lat[i] = suf; suf += lk[i]; }
    const float other = __shfl_xor(suf, 32);
    const float base = run + (h == 0 ? other : 0.f);
    float a[16];
#pragma unroll
    for (int i = 0; i < 16; ++i) {
      const bool msk = (!diag) || (16 * h + i < r);
      a[i] = msk ? __expf(z[i] + lk[i] + base + lat[i]) : 0.f;
    }
    run += suf + other;
    __builtin_amdgcn_wave_barrier();
#pragma unroll
    for (int s2 = 0; s2 < 2; ++s2) {
      u32x4 t; t.x = pk2(a[8 * s2], a[8 * s2 + 1]); t.y = pk2(a[8 * s2 + 2], a[8 * s2 + 3]); t.z = pk2(a[8 * s2 + 4], a[8 * s2 + 5]); t.w = pk2(a[8 * s2 + 6], a[8 * s2 + 7]);
      const bf16x8 pf = __builtin_bit_cast(bf16x8, t);
#pragma unroll
      for (int dt = 0; dt < 2; ++dt) {
        const bf16_t* vp = vl + (16 * h + 8 * s2) * VS + 32 * dt + r;
        bf16x8 vf;
#pragma unroll
        for (int j = 0; j < 8; ++j) vf[j] = (short)vp[j * VS];
        o[dt] = MFMA(vf, pf, o[dt]);
      }
    }
    __builtin_amdgcn_wave_barrier();
    if (__all(run < -104.f)) break;
  }
  const int tok = tq0 + r;
#pragma unroll
  for (int dt = 0; dt < 2; ++dt)
#pragma unroll
    for (int g = 0; g < 4; ++g) {
      const int d0 = 32 * dt + 8 * g + 4 * h;
      u32x2 ga = *(const u32x2*)(p.P + (size_t)tok * D_IN + OFF_GA + hd * 64 + d0);
      u32x2 ov;
      ov.x = pk2(o[dt][4 * g] * siluf_(bflo(ga.x)), o[dt][4 * g + 1] * siluf_(bfhi(ga.x)));
      ov.y = pk2(o[dt][4 * g + 2] * siluf_(bflo(ga.y)), o[dt][4 * g + 3] * siluf_(bfhi(ga.y)));
      *(u32x2*)(p.mix + (size_t)tok * 1024 + hd * 64 + d0) = ov;
    }
}

constexpr int S5_BU = 8192;
constexpr int S5_LDS = S5_BU + 8704 + 1024;
DI void s5_disc(const Params& p, int lg, int pi, float dt, float& ar, float& ai, float& fr, float& fi) {
  const float lr = fminf(p.lam_re[lg * 64 + pi], -1e-4f), li = p.lam_im[lg * 64 + pi];
  const float er = expf(lr * dt);
  ar = er * cosf(li * dt); ai = er * sinf(li * dt);
  const float den = lr * lr + li * li;
  fr = ((ar - 1.f) * lr + ai * li) / den; fi = (ai * lr - (ar - 1.f) * li) / den;
}
DI void s5_item(const Params& p, int layer, int item, char* lds) {
  float* BU = (float*)lds;
  char* Himg = lds + S5_BU;
  bf16_t* Ub = (bf16_t*)(lds + S5_BU + 8704);
  const int lane = TID & 63, r = lane & 31, h = lane >> 5;
  const int seq = item >> 4, g = item & 15;
  const bool sample = seq >= 32;
  const int b = sample ? seq - 32 : seq, L = sample ? 32 : 2048, tok0 = sample ? NTOK_P + b * 32 : b * 2048;
  const int lg = layer * 16 + g;
  const float dt = expf(p.log_dt[lg]);
  float ar, ai, fr_, fi_;
  s5_disc(p, lg, lane, dt, ar, ai, fr_, fi_);
  bf16x8 bbf[4];
#pragma unroll
  for (int half = 0; half < 2; ++half) {
    const int pi = 32 * half + r;
    float a_r, a_i, f_r, f_i;
    s5_disc(p, lg, pi, dt, a_r, a_i, f_r, f_i);
    const float* brp = p.b_re + ((size_t)lg * 64 + pi) * 16 + 8 * h;
    const float* bip = p.b_im + ((size_t)lg * 64 + pi) * 16 + 8 * h;
    float re[8], im[8];
#pragma unroll
    for (int j = 0; j < 8; ++j) { const float br = brp[j], bi = bip[j]; re[j] = f_r * br - f_i * bi; im[j] = f_r * bi + f_i * br; }
    u32x4 t0, t1;
    t0.x = pk2(re[0], re[1]); t0.y = pk2(re[2], re[3]); t0.z = pk2(re[4], re[5]); t0.w = pk2(re[6], re[7]);
    t1.x = pk2(im[0], im[1]); t1.y = pk2(im[2], im[3]); t1.z = pk2(im[4], im[5]); t1.w = pk2(im[6], im[7]);
    bbf[half] = __builtin_bit_cast(bf16x8, t0);
    bbf[2 + half] = __builtin_bit_cast(bf16x8, t1);
  }
  bf16x8 cf[8];
#pragma unroll
  for (int s = 0; s < 8; ++s) {
    u32x4 t; t.x = 0; t.y = 0; t.z = 0; t.w = 0;
    if (r < 16) {
      const int k0 = 16 * s + 8 * h;
      const float* src = (s < 4 ? p.c_re : p.c_im) + ((size_t)lg * 16 + r) * 64 + (k0 & 63);
      const float sg = s < 4 ? 1.f : -1.f;
      const float4 c0 = *(const float4*)src, c1 = *(const float4*)(src + 4);
      t.x = pk2(sg * c0.x, sg * c0.y); t.y = pk2(sg * c0.z, sg * c0.w); t.z = pk2(sg * c1.x, sg * c1.y); t.w = pk2(sg * c1.z, sg * c1.w);
    }
    cf[s] = __builtin_bit_cast(bf16x8, t);
  }
  const float dl = p.ssm_d[lg * 16 + (r & 15)];
  float hr = 0.f, hi = 0.f;
  if (sample) { hr = p.st_re[((size_t)(layer * 16 + b) * 16 + g) * 64 + lane]; hi = p.st_im[((size_t)(layer * 16 + b) * 16 + g) * 64 + lane]; }
  f32x16 zero;
#pragma unroll
  for (int i = 0; i < 16; ++i) zero[i] = 0.f;
  const bf16_t* upb = p.P + (size_t)(tok0 + r) * D_IN + OFF_U + g * 16 + 8 * h;
  bf16x8 uf = *(const bf16x8*)upb;
  for (int t0 = 0; t0 < L; t0 += 32) {
    const bf16x8 ucur = uf;
    if (t0 + 32 < L) uf = *(const bf16x8*)(upb + (size_t)(t0 + 32) * D_IN);
    *(bf16x8*)(Ub + r * 16 + 8 * h) = ucur;
    f32x16 d[4];
#pragma unroll
    for (int tile = 0; tile < 4; ++tile) d[tile] = MFMA(ucur, bbf[tile], zero);
#pragma unroll
    for (int hf = 0; hf < 2; ++hf) {
#pragma unroll
      for (int tile = 0; tile < 4; ++tile)
#pragma unroll
        for (int i = 0; i < 8; ++i) BU[((i & 3) + 8 * (i >> 2) + 4 * h) * 128 + 32 * tile + r] = d[tile][8 * hf + i];
      __builtin_amdgcn_wave_barrier();
#pragma unroll
      for (int tt = 0; tt < 16; ++tt) {
        const int t = 16 * hf + tt;
        const float bur = BU[tt * 128 + lane], bui = BU[tt * 128 + 64 + lane];
        const float nhr = ar * hr - ai * hi + bur, nhi = ar * hi + ai * hr + bui;
        hr = nhr; hi = nhi;
        *(bf16_t*)(Himg + t * 272 + lane * 2) = (bf16_t)f2bf(hr);
        *(bf16_t*)(Himg + t * 272 + 128 + lane * 2) = (bf16_t)f2bf(hi);
      }
      __builtin_amdgcn_wave_barrier();
    }
    f32x16 yacc = zero;
#pragma unroll
    for (int s = 0; s < 8; ++s) {
      const bf16x8 af = *(const bf16x8*)(Himg + r * 272 + s * 32 + h * 16);
      yacc = MFMA(af, cf[s], yacc);
    }
    if (r < 16) {
#pragma unroll
      for (int i = 0; i < 16; ++i) {
        const int t = (i & 3) + 8 * (i >> 2) + 4 * h;
        const float yv = yacc[i] + dl * bf2f(Ub[t * 16 + r]);
        const float gl = yv * __builtin_amdgcn_rcpf(1.f + __expf(-1.5957691216f * (yv + 0.044715f * yv * yv * yv)));
        p.yb[(size_t)(tok0 + t0 + t) * 256 + g * 16 + r] = (bf16_t)f2bf(gl);
      }
    }
    __builtin_amdgcn_wave_barrier();
  }
  float* ore = p.out + (sample ? O_SRES : O_SREP) + ((size_t)(layer * (sample ? 16 : 32) + b) * 16 + g) * 64 + lane;
  float* oim = p.out + (sample ? O_SIMS : O_SIMP) + ((size_t)(layer * (sample ? 16 : 32) + b) * 16 + g) * 64 + lane;
  *ore = hr; *oim = hi;
}

DI void rwkv_item(const Params& p, int layer, int item, char* smem) {
  constexpr int SETF = 6 * 2048;
  float* SET0 = (float*)smem;
  float* YB = SET0 + 2 * SETF;
  char* PW = (char*)(YB + 2 * 2048);
  const int tid = TID, lane = tid & 63, wv = tid >> 6;
  const int seq = item >> 2, hd = item & 3;
  const bool sample = seq >= 32;
  const int b = sample ? seq - 32 : seq, L = sample ? 32 : 2048, tok0 = sample ? NTOK_P + b * 32 : b * 2048;
  const int nch = L >> 5;
  if (wv < 4) {
    const int rp = tid >> 3, kq = tid & 7;
    f32x2 S0[4], S1[4];
    if (sample) {
      const float* sp = p.st_wkv + (((size_t)(layer * 16 + b) * 4 + hd) * 64 + rp) * 64 + kq * 8;
#pragma unroll
      for (int j = 0; j < 4; ++j) { S0[j].x = sp[2 * j]; S0[j].y = sp[2 * j + 1]; S1[j].x = sp[2048 + 2 * j]; S1[j].y = sp[2048 + 2 * j + 1]; }
    } else {
#pragma unroll
      for (int j = 0; j < 4; ++j) { S0[j].x = 0.f; S0[j].y = 0.f; S1[j].x = 0.f; S1[j].y = 0.f; }
    }
    lds_barrier();
    for (int c = 0; c < nch; ++c) {
      const float* R = SET0 + (c & 1) * SETF; const float* W = R + 2048; const float* KT = W + 2048; const float* KH = KT + 2048;
      const float* BB = KH + 2048; const float* V = BB + 2048;
      float* Y = YB + (c & 1) * 2048;
      float yk0[4], yk1[4];
      float4 nkh0, nkh1, nw0, nw1, nb0, nb1, nk0, nk1, nr0, nr1; float nv0, nv1;
      {
        const int o = kq * 8;
        nkh0 = *(const float4*)(KH + o); nkh1 = *(const float4*)(KH + o + 4); nw0 = *(const float4*)(W + o); nw1 = *(const float4*)(W + o + 4);
        nb0 = *(const float4*)(BB + o); nb1 = *(const float4*)(BB + o + 4); nk0 = *(const float4*)(KT + o); nk1 = *(const float4*)(KT + o + 4);
        nr0 = *(const float4*)(R + o); nr1 = *(const float4*)(R + o + 4); nv0 = V[rp]; nv1 = V[rp + 32];
      }
#pragma unroll
      for (int q = 0; q < 4; ++q) {
        yk0[q] = 0.f; yk1[q] = 0.f;
#pragma unroll
        for (int e = 0; e < 8; ++e) {
          const int tl = q * 8 + e;
          const float4 kh0 = nkh0, kh1 = nkh1, w0_ = nw0, w1_ = nw1, b0 = nb0, b1 = nb1, k0 = nk0, k1 = nk1, r0 = nr0, r1 = nr1;
          const float va = nv0, vb = nv1;
          if (tl < 31) {
            const int o = (tl + 1) * 64 + kq * 8;
            nkh0 = *(const float4*)(KH + o); nkh1 = *(const float4*)(KH + o + 4); nw0 = *(const float4*)(W + o); nw1 = *(const float4*)(W + o + 4);
            nb0 = *(const float4*)(BB + o); nb1 = *(const float4*)(BB + o + 4); nk0 = *(const float4*)(KT + o); nk1 = *(const float4*)(KT + o + 4);
            nr0 = *(const float4*)(R + o); nr1 = *(const float4*)(R + o + 4); nv0 = V[(tl + 1) * 64 + rp]; nv1 = V[(tl + 1) * 64 + rp + 32];
          }
          const f32x2 khv[4] = {{kh0.x, kh0.y}, {kh0.z, kh0.w}, {kh1.x, kh1.y}, {kh1.z, kh1.w}};
          const f32x2 wvv[4] = {{w0_.x, w0_.y}, {w0_.z, w0_.w}, {w1_.x, w1_.y}, {w1_.z, w1_.w}};
          const f32x2 bv[4] = {{b0.x, b0.y}, {b0.z, b0.w}, {b1.x, b1.y}, {b1.z, b1.w}};
          const f32x2 kv[4] = {{k0.x, k0.y}, {k0.z, k0.w}, {k1.x, k1.y}, {k1.z, k1.w}};
          const f32x2 rv[4] = {{r0.x, r0.y}, {r0.z, r0.w}, {r1.x, r1.y}, {r1.z, r1.w}};
          const f32x2 va2 = {va, va}, vb2 = {vb, vb};
          f32x2 ma[4], mb[4];
#pragma unroll
          for (int j = 0; j < 4; ++j) { ma[j] = fma2(S0[j], wvv[j], va2 * kv[j]); mb[j] = fma2(S1[j], wvv[j], vb2 * kv[j]); }
          f32x2 sa2 = fma2(S0[1], khv[1], S0[0] * khv[0]) + fma2(S0[3], khv[3], S0[2] * khv[2]);
          f32x2 sb2 = fma2(S1[1], khv[1], S1[0] * khv[0]) + fma2(S1[3], khv[3], S1[2] * khv[2]);
          const float sa = sum8(sa2.x + sa2.y), sb = sum8(sb2.x + sb2.y);
          const f32x2 nsa = {-sa, -sa}, nsb = {-sb, -sb};
#pragma unroll
          for (int j = 0; j < 4; ++j) { S0[j] = fma2(nsa, bv[j], ma[j]); S1[j] = fma2(nsb, bv[j], mb[j]); }
          f32x2 ya2 = fma2(S0[1], rv[1], S0[0] * rv[0]) + fma2(S0[3], rv[3], S0[2] * rv[2]);
          f32x2 yb2 = fma2(S1[1], rv[1], S1[0] * rv[0]) + fma2(S1[3], rv[3], S1[2] * rv[2]);
          const float ya = sum8(ya2.x + ya2.y), ybv = sum8(yb2.x + yb2.y);
          yk0[q] = (e == kq) ? ya : yk0[q];
          yk1[q] = (e == kq) ? ybv : yk1[q];
        }
      }
#pragma unroll
      for (int q = 0; q < 4; ++q) { Y[(q * 8 + kq) * 64 + rp] = yk0[q]; Y[(q * 8 + kq) * 64 + rp + 32] = yk1[q]; }
      lds_barrier();
    }
    float* so = p.out + (sample ? O_WKVS : O_WKVP) + (((size_t)(layer * (sample ? 16 : 32) + b) * 4 + hd) * 64 + rp) * 64 + kq * 8;
    *(float4*)so = make_float4(S0[0].x, S0[0].y, S0[1].x, S0[1].y);
    *(float4*)(so + 4) = make_float4(S0[2].x, S0[2].y, S0[3].x, S0[3].y);
    *(float4*)(so + 2048) = make_float4(S1[0].x, S1[0].y, S1[1].x, S1[1].y);
    *(float4*)(so + 2052) = make_float4(S1[2].x, S1[2].y, S1[3].x, S1[3].y);
  } else {
    const int pw = wv - 4, r_ = lane & 31, h_ = lane >> 5;
    const int cg_ = hd * 64 + lane;
    bf16_t* LORAb = (bf16_t*)(PW + pw * 5248);
    float* DSA = (float*)(PW + pw * 5248 + 1152);
    bf16x8 lb[2][2][2];
#pragma unroll
    for (int ll = 0; ll < 2; ++ll)
#pragma unroll
      for (int nn = 0; nn < 2; ++nn) {
        const float* srcw = (ll ? p.a2 : p.w2) + (size_t)layer * 32 * 256 + hd * 64 + 32 * nn + r_;
#pragma unroll
        for (int s = 0; s < 2; ++s) {
          float t[8];
#pragma unroll
          for (int j = 0; j < 8; ++j) t[j] = srcw[(size_t)(16 * s + 8 * h_ + j) * 256];
          u32x4 u; u.x = pk2(t[0], t[1]); u.y = pk2(t[2], t[3]); u.z = pk2(t[4], t[5]); u.w = pk2(t[6], t[7]);
          lb[ll][nn][s] = __builtin_bit_cast(bf16x8, u);
        }
      }
    const float w0c = p.w0[layer * 256 + cg_], a0c = p.a0[layer * 256 + cg_], kkc = p.k_k[layer * 256 + cg_], kac = p.k_a[layer * 256 + cg_];
    const float ubc = p.u_bonus[layer * 256 + cg_], lnw = p.ln_w[layer * 256 + cg_], lnb = p.ln_b[layer * 256 + cg_];
    const float* mu = p.mu + layer * 832;
    const float mu_r = mu[cg_], mu_k = mu[256 + cg_], mu_v = mu[512 + cg_], mu_l = mu[768 + lane];
    const float* shp = p.st_shift + (size_t)(layer * 16 + b) * 832;
    auto pre = [&](int c, float (&xvk)[8], float (&bonk)[8], float (&gtk)[8]) {
      float* R = SET0 + (c & 1) * SETF; float* W = R + 2048; float* KT = W + 2048; float* KH = KT + 2048; float* BB = KH + 2048; float* V = BB + 2048;
      const bf16_t* base = p.P + (size_t)(tok0 + c * 32 + 8 * pw) * D_IN + OFF_C;
      bf16_t cr[8], ck[8], cv[8], cl[8], cgt[8];
#pragma unroll
      for (int i = 0; i < 8; ++i) {
        const bf16_t* cp = base + (size_t)i * D_IN;
        cr[i] = cp[cg_]; ck[i] = cp[256 + cg_]; cv[i] = cp[512 + cg_]; cl[i] = cp[768 + lane]; cgt[i] = cp[OFF_GC - OFF_C + cg_];
      }
      float pr, pk, pv, pl;
      if (c * 32 + 8 * pw == 0) {
        if (sample) { pr = shp[cg_]; pk = shp[256 + cg_]; pv = shp[512 + cg_]; pl = shp[768 + lane]; }
        else { pr = 0.f; pk = 0.f; pv = 0.f; pl = 0.f; }
      } else {
        const bf16_t* pp = base - D_IN;
        pr = bf2f(pp[cg_]); pk = bf2f(pp[256 + cg_]); pv = bf2f(pp[512 + cg_]); pl = bf2f(pp[768 + lane]);
      }
      float xr_[8], xk_[8];
#pragma unroll
      for (int i = 0; i < 8; ++i) {
        const float c_r = bf2f(cr[i]), c_k = bf2f(ck[i]), c_v = bf2f(cv[i]), c_l = bf2f(cl[i]);
        xr_[i] = c_r + mu_r * (pr - c_r); xk_[i] = c_k + mu_k * (pk - c_k); xvk[i] = c_v + mu_v * (pv - c_v);
        const float xl = c_l + mu_l * (pl - c_l);
        pr = c_r; pk = c_k; pv = c_v; pl = c_l;
        gtk[i] = bf2f(cgt[i]);
        LORAb[i * 72 + lane] = (bf16_t)f2bf(lane < 32 ? fast_tanh(xl) : xl);
      }
      __builtin_amdgcn_wave_barrier();
#pragma unroll
      for (int ll = 0; ll < 2; ++ll) {
        const bf16x8 af0 = *(const bf16x8*)((const char*)LORAb + (r_ & 7) * 144 + ll * 64 + h_ * 16);
        const bf16x8 af1 = *(const bf16x8*)((const char*)LORAb + (r_ & 7) * 144 + ll * 64 + 32 + h_ * 16);
#pragma unroll
        for (int nn = 0; nn < 2; ++nn) {
          f32x16 dacc;
#pragma unroll
          for (int i = 0; i < 16; ++i) dacc[i] = 0.f;
          dacc = MFMA(af0, lb[ll][nn][0], dacc);
          dacc = MFMA(af1, lb[ll][nn][1], dacc);
#pragma unroll
          for (int i = 0; i < 4; ++i) DSA[ll * 512 + (i + 4 * h_) * 64 + 32 * nn + r_] = dacc[i];
        }
      }
      __builtin_amdgcn_wave_barrier();
#pragma unroll
      for (int i = 0; i < 8; ++i) {
        const int tl = 8 * pw + i;
        const float dsum = w0c + DSA[i * 64 + lane], asum = a0c + DSA[512 + i * 64 + lane];
        const float dec = __expf(-0.6065306597f * sigmoidf_(dsum));
        const float a = sigmoidf_(asum);
        const float kk = xk_[i] * kkc;
        const float ss = wave_sum(kk * kk);
        const float kh = kk * __builtin_amdgcn_rsqf(ss + 1e-12f);
        const float kt = xk_[i] * (1.f + (a - 1.f) * kac);
        bonk[i] = wave_sum(xr_[i] * kt * ubc);
        R[tl * 64 + lane] = xr_[i]; W[tl * 64 + lane] = dec; KT[tl * 64 + lane] = kt; KH[tl * 64 + lane] = kh; BB[tl * 64 + lane] = a * kh; V[tl * 64 + lane] = xvk[i];
      }
      __builtin_amdgcn_wave_barrier();
    };
    auto post = [&](int c, const float (&xvk)[8], const float (&bonk)[8], const float (&gtk)[8]) {
      const float* Y = YB + (c & 1) * 2048;
#pragma unroll
      for (int i = 0; i < 8; ++i) {
        const int tl = 8 * pw + i;
        const float y = Y[tl * 64 + lane];
        const float mean = wave_sum(y) * (1.f / 64.f);
        const float msq = wave_sum(y * y) * (1.f / 64.f);
        const float var = fmaxf(msq - mean * mean, 0.f);
        float yn = (y - mean) * __builtin_amdgcn_rsqf(var + 64e-5f) * lnw + lnb;
        yn += bonk[i] * xvk[i];
        p.mix[(size_t)(tok0 + c * 32 + tl) * 1024 + 768 + cg_] = (bf16_t)f2bf(yn * siluf_(gtk[i]));
      }
    };
    float xvA[8], bonA[8], gtA[8], xvB[8], bonB[8], gtB[8];
#pragma unroll
    for (int i = 0; i < 8; ++i) { xvB[i] = 0.f; bonB[i] = 0.f; gtB[i] = 0.f; }
    pre(0, xvA, bonA, gtA);
    lds_barrier();
    for (int c = 0; c < nch; c += 2) {
      if (c >= 1) post(c - 1, xvB, bonB, gtB);
      if (c + 1 < nch) pre(c + 1, xvB, bonB, gtB);
      lds_barrier();
      if (c + 1 < nch) {
        post(c, xvA, bonA, gtA);
        if (c + 2 < nch) pre(c + 2, xvA, bonA, gtA);
        lds_barrier();
      }
    }
    if ((nch - 1) & 1) post(nch - 1, xvB, bonB, gtB); else post(nch - 1, xvA, bonA, gtA);
  }
  lds_barrier();
}

constexpr int ATT_LDS0 = 6 * S5_LDS;
DI void phase_mixers(const Params& p, int layer, char* smem, int cofs) {
  const int G = GDIM, bid = BID, half = G / 2;
  const int tid = TID, wv = tid >> 6, lane = tid & 63;
  if (bid < half) {
    for (int item = bid; item < 128; item += half) rwkv_item(p, layer, item, smem);
  } else {
    const int j = bid - half, nb2 = G - half;
    for (int item = 128 + j; item < 192; item += nb2) rwkv_item(p, layer, item, smem);
    if (wv < 6) { for (int it = j * 6 + wv; it < 768; it += nb2 * 6) s5_item(p, layer, it, smem + wv * S5_LDS); }
  }
  unsigned* ctr = p.counters + layer + cofs;
  bf16_t* vl = (bf16_t*)(smem + ATT_LDS0) + wv * (32 * VS);
  while (true) {
    int it = 0;
    if (lane == 0) it = (int)atomicAdd(ctr, 1u);
    it = __builtin_amdgcn_readfirstlane(it);
    if (it >= 16512) break;
    attn_item(p, layer, it, vl);
  }
}

__global__ void __launch_bounds__(NT) mega(Params p) {
  __shared__ __attribute__((aligned(16))) char smem[SMEM_BYTES];
  cg::grid_group grid = cg::this_grid();
  phase_weights(p, smem);
  phase_norm(p, 0);
  grid.sync();
  for (int layer = 0; layer < 2; ++layer) {
    gemm_phase<0>(p, layer, smem);
    grid.sync();
#if PROBE_GEMM0
    gemm_phase<0>(p, layer, smem);
    grid.sync();
#endif
    phase_mixers(p, layer, smem, 0);
    grid.sync();
#if PROBE_MIX
    phase_mixers(p, layer, smem, 2);
    grid.sync();
#endif
    gemm_phase<1>(p, layer, smem);
    grid.sync();
    gemm_phase<2>(p, layer, smem);
    if (layer == 0) grid.sync();
  }
}

#if MULTI_LAUNCH
template <int PH>
__global__ void __launch_bounds__(NT) phase_kernel(Params p, int layer) {
  __shared__ __attribute__((aligned(16))) char smem[SMEM_BYTES];
  if (PH == 0) { phase_weights(p, smem); }
  else if (PH == 1) phase_norm(p, layer);
  else if (PH == 2) gemm_phase<0>(p, layer, smem);
  else if (PH == 3) phase_mixers(p, layer, smem, 0);
  else if (PH == 4) gemm_phase<1>(p, layer, smem);
  else gemm_phase<2>(p, layer, smem);
}
#endif

extern "C" void kernel_launch(void* const* d_in, const int* in_sizes, int n_in, void* d_out, int out_size, void* d_ws, size_t ws_size, hipStream_t stream) {
  Params p{};
  const float** f = (const float**)&p;
  for (int i = 0; i < 33; ++i) f[i] = (const float*)d_in[i];
  p.out = (float*)d_out;
  char* ws = (char*)d_ws;
  size_t off = 0;
  auto take = [&](size_t bytes) { char* q = ws + off; off += (bytes + 255) & ~(size_t)255; return q; };
  p.WinT = (bf16_t*)take((size_t)2 * 3648 * 1024 * 2);
  p.WoutT = (bf16_t*)take((size_t)2 * 1024 * 1024 * 2);
  p.WgluT = (bf16_t*)take((size_t)2 * 512 * 256 * 2);
  p.hbf = (bf16_t*)take((size_t)NTOK * 1024 * 2);
  p.P = (bf16_t*)take((size_t)NTOK * D_IN * 2);
  p.mix = (bf16_t*)take((size_t)NTOK * 1024 * 2);
  p.yb = (bf16_t*)take((size_t)NTOK * 256 * 2);
  p.counters = (unsigned*)take(256);
  p.ssq = (float*)take((size_t)NTOK * 4);
  if (off > ws_size || (size_t)out_size != O_END || n_in != 33) fprintf(stderr, "kernel_launch: unexpected sizes ws=%zu need=%zu out=%d n_in=%d\n", ws_size, off, out_size, n_in);
#if MULTI_LAUNCH
  const int G = 256;
  phase_kernel<0><<<G, NT, 0, stream>>>(p, 0);
  for (int layer = 0; layer < 2; ++layer) {
    phase_kernel<1><<<G, NT, 0, stream>>>(p, layer);
    phase_kernel<2><<<G, NT, 0, stream>>>(p, layer);
    phase_kernel<3><<<G, NT, 0, stream>>>(p, layer);
    phase_kernel<4><<<G, NT, 0, stream>>>(p, layer);
    phase_kernel<5><<<G, NT, 0, stream>>>(p, layer);
  }
#else
  static int grid_blocks = 0;
  if (!grid_blocks) {
    int dev = 0, cus = 0, per_cu = 0;
    hipGetDevice(&dev);
    hipDeviceGetAttribute(&cus, hipDeviceAttributeMultiprocessorCount, dev);
    hipOccupancyMaxActiveBlocksPerMultiprocessor(&per_cu, mega, NT, 0);
    if (per_cu < 1) per_cu = 1;
    grid_blocks = cus * per_cu;
  }
  void* args[] = {&p};
  hipError_t e = hipLaunchCooperativeKernel((void*)mega, dim3(grid_blocks), dim3(NT), args, 0, stream);
  if (e != hipSuccess) fprintf(stderr, "cooperative launch failed: %s (grid %d)\n", hipGetErrorString(e), grid_blocks);
#endif
}
```

```cpp
#include <hip/hip_runtime.h>
#include <hip/hip_cooperative_groups.h>
#include <cstdio>
namespace cg = cooperative_groups;

#define PROBE_GEMM0 0
#define PROBE_MIX 0
#ifndef MULTI_LAUNCH
#define MULTI_LAUNCH 0
#endif

#define DI __device__ __forceinline__
typedef unsigned short bf16_t;
typedef short bf16x8 __attribute__((ext_vector_type(8)));
typedef float f32x16 __attribute__((ext_vector_type(16)));
typedef unsigned u32x4 __attribute__((ext_vector_type(4)));
typedef unsigned u32x2 __attribute__((ext_vector_type(2)));
#define MFMA(a, b, c) __builtin_amdgcn_mfma_f32_32x32x16_bf16((a), (b), (c), 0, 0, 0)

constexpr int NT = 512;
constexpr int NTOK_P = 65536, NTOK = 66048, D_IN = 3648;
constexpr int OFF_Q = 0, OFF_K = 512, OFF_V = 1024, OFF_GA = 1536, OFF_U = 2048, OFF_GB = 2304, OFF_C = 2560, OFF_GC = 3392;
constexpr size_t O_Y = 0, O_KP = 67633152, O_VP = 134742016, O_SREP = 201850880, O_SIMP = 201916416, O_WKVP = 201981952,
                 O_SHP = 203030528, O_KS = 203083776, O_VS = 203608064, O_SRES = 204132352, O_SIMS = 204165120,
                 O_WKVS = 204197888, O_SHS = 204722176, O_END = 204748800;
constexpr int SMEM_BYTES = 2 * 55296 + 8 * 4608;
constexpr int LDS_ROW = 144;
constexpr int STAGE = (256 + 128) * LDS_ROW;

struct Params {
  const float *x_prompt, *x_sample, *cache_k, *cache_v, *st_re, *st_im, *st_wkv, *st_shift;
  const float *norm_w, *w_in, *q_norm_w, *k_norm_w, *lam_re, *lam_im, *log_dt, *b_re, *b_im, *c_re, *c_im, *ssm_d, *w_glu, *b_glu;
  const float *mu, *w0, *w2, *a0, *a2, *k_k, *k_a, *u_bonus, *ln_w, *ln_b, *w_out;
  float* out;
  bf16_t *WinT, *WoutT, *WgluT, *hbf, *P, *mix, *yb;
  unsigned* counters;
  float* ssq;
};

DI int opq_v(int x) { asm volatile("" : "+v"(x)); return x; }
DI int opq_s(int x) { asm volatile("" : "+s"(x)); return x; }
#define TID opq_v((int)threadIdx.x)
#define BID opq_s((int)blockIdx.x)
#define GDIM opq_s((int)gridDim.x)
typedef float f32x4v __attribute__((ext_vector_type(4)));
DI void nt_store16(void* p, u32x4 v) { __builtin_nontemporal_store(v, (u32x4*)p); }
DI void nt_store16f(void* p, float4 v) { f32x4v t = {v.x, v.y, v.z, v.w}; __builtin_nontemporal_store(t, (f32x4v*)p); }
typedef __bf16 bf16x2_t __attribute__((ext_vector_type(2)));
typedef float f32x2c __attribute__((ext_vector_type(2)));
DI unsigned pk2(float a, float b) { f32x2c v = {a, b}; bf16x2_t r = __builtin_convertvector(v, bf16x2_t); return __builtin_bit_cast(unsigned, r); }
DI unsigned f2bf(float x) { return pk2(x, 0.f) & 0xffffu; }
DI float bf2f(unsigned v) { return __uint_as_float(v << 16); }
DI float bflo(unsigned w) { return __uint_as_float(w << 16); }
DI float bfhi(unsigned w) { return __uint_as_float(w & 0xffff0000u); }
DI float sigmoidf_(float x) { return __builtin_amdgcn_rcpf(1.f + __expf(-x)); }
DI float siluf_(float x) { return x * __builtin_amdgcn_rcpf(1.f + __expf(-x)); }
typedef float f32x2 __attribute__((ext_vector_type(2)));
DI f32x2 fma2(f32x2 a, f32x2 b, f32x2 c) { return __builtin_elementwise_fma(a, b, c); }
template <int CTRL> DI float dpp_mov(float x) { return __int_as_float(__builtin_amdgcn_update_dpp(0, __float_as_int(x), CTRL, 0xF, 0xF, true)); }
DI float sum8(float x) { x += dpp_mov<0xB1>(x); x += dpp_mov<0x4E>(x); x += dpp_mov<0x141>(x); return x; }
DI float fast_tanh(float x) { return 1.f - 2.f * __builtin_amdgcn_rcpf(1.f + __expf(2.f * x)); }
DI void lds_barrier() { asm volatile("s_waitcnt lgkmcnt(0)\n\ts_barrier" ::: "memory"); }
DI float wave_sum(float v) {
  v += dpp_mov<0xB1>(v); v += dpp_mov<0x4E>(v); v += dpp_mov<0x141>(v); v += dpp_mov<0x140>(v);
  v += __int_as_float(__builtin_amdgcn_update_dpp(0, __float_as_int(v), 0x142, 0xA, 0xF, false));
  v += __int_as_float(__builtin_amdgcn_update_dpp(0, __float_as_int(v), 0x143, 0xC, 0xF, false));
  return __int_as_float(__builtin_amdgcn_readlane(__float_as_int(v), 63));
}
DI const float* xrow(const Params& p, int layer, int row) {
  if (layer == 0) return row < NTOK_P ? p.x_prompt + (size_t)row * 1024 : p.x_sample + (size_t)(row - NTOK_P) * 1024;
  return p.out + (size_t)row * 1024;
}

DI void transpose_tile(const float* __restrict__ src, int K, int N, bf16_t* __restrict__ dst, int k0, int n0, float* tile, int lane) {
#pragma unroll
  for (int i = 0; i < 16; ++i) {
    const int kk = i * 4 + (lane >> 4), c = (lane & 15) * 4;
    const float4 v = *(const float4*)(src + (size_t)(k0 + kk) * N + n0 + c);
    float* t = tile + kk * 65 + c;
    t[0] = v.x; t[1] = v.y; t[2] = v.z; t[3] = v.w;
  }
  __builtin_amdgcn_wave_barrier();
#pragma unroll
  for (int i = 0; i < 32; ++i) {
    const int nn = i * 2 + (lane >> 5), kk = (lane & 31) * 2;
    *(unsigned*)(dst + (size_t)(n0 + nn) * K + k0 + kk) = pk2(tile[kk * 65 + nn], tile[(kk + 1) * 65 + nn]);
  }
  __builtin_amdgcn_wave_barrier();
}
DI void phase_weights(const Params& p, char* smem) {
  const int bid = BID, gdim = GDIM;
  const int tid = TID, lane = tid & 63, wv = tid >> 6;
  float* tile = (float*)smem + wv * (64 * 65);
  for (int t = bid * 8 + wv; t < 2400; t += gdim * 8) {
    int layer = t / 1200, j = t % 1200;
    if (j < 912) { int kt = j / 57, nt = j % 57; transpose_tile(p.w_in + (size_t)layer * 1024 * 3648, 1024, 3648, p.WinT + (size_t)layer * 3648 * 1024, kt * 64, nt * 64, tile, lane); }
    else if (j < 1168) { j -= 912; int kt = j / 16, nt = j % 16; transpose_tile(p.w_out + (size_t)layer * 1024 * 1024, 1024, 1024, p.WoutT + (size_t)layer * 1024 * 1024, kt * 64, nt * 64, tile, lane); }
    else { j -= 1168; int kt = j / 8, nt = j % 8; transpose_tile(p.w_glu + (size_t)layer * 256 * 512, 256, 512, p.WgluT + (size_t)layer * 512 * 256, kt * 64, nt * 64, tile, lane); }
  }
  { if (bid == 0 && tid < 64) p.counters[tid] = 0;
    for (int i = bid * NT + tid; i < NTOK; i += gdim * NT) p.ssq[i] = 0.f; }
}

DI void phase_norm(const Params& p, int layer) {
  const int tid = TID, lane = tid & 63, w = tid >> 6;
  const int bid = BID, gdim = GDIM;
  const float* nw = p.norm_w + layer * 1024;
  const int stride = gdim * 8;
  for (int row0 = bid * 8 + w; row0 < NTOK; row0 += 2 * stride) {
    const int row1 = row0 + stride;
    const bool has1 = row1 < NTOK;
    const float* x0 = xrow(p, layer, row0);
    const float* x1 = xrow(p, layer, has1 ? row1 : row0);
    float4 v0[4], v1[4]; float s0 = 0.f, s1 = 0.f;
#pragma unroll
    for (int i = 0; i < 4; ++i) { v0[i] = *(const float4*)(x0 + i * 256 + lane * 4); v1[i] = *(const float4*)(x1 + i * 256 + lane * 4); }
#pragma unroll
    for (int i = 0; i < 4; ++i) {
      s0 += v0[i].x * v0[i].x + v0[i].y * v0[i].y + v0[i].z * v0[i].z + v0[i].w * v0[i].w;
      s1 += v1[i].x * v1[i].x + v1[i].y * v1[i].y + v1[i].z * v1[i].z + v1[i].w * v1[i].w;
    }
    s0 = wave_sum(s0); s1 = wave_sum(s1);
    const float c0 = rsqrtf(s0 * (1.f / 1024.f) + 1e-6f), c1 = rsqrtf(s1 * (1.f / 1024.f) + 1e-6f);
#pragma unroll
    for (int i = 0; i < 4; ++i) {
      float4 wv = *(const float4*)(nw + i * 256 + lane * 4);
      u32x2 o; o.x = pk2(v0[i].x * c0 * wv.x, v0[i].y * c0 * wv.y); o.y = pk2(v0[i].z * c0 * wv.z, v0[i].w * c0 * wv.w);
      *(u32x2*)(p.hbf + (size_t)row0 * 1024 + i * 256 + lane * 4) = o;
      if (has1) {
        u32x2 o1; o1.x = pk2(v1[i].x * c1 * wv.x, v1[i].y * c1 * wv.y); o1.y = pk2(v1[i].z * c1 * wv.z, v1[i].w * c1 * wv.w);
        *(u32x2*)(p.hbf + (size_t)row1 * 1024 + i * 256 + lane * 4) = o1;
      }
    }
  }
}

template <int MODE>
DI void gemm_phase(const Params& p, int layer, char* smem) {
  constexpr int K = (MODE == 1) ? 256 : 1024;
  constexpr int NTN = (MODE == 0) ? 29 : (MODE == 1 ? 4 : 8);
  constexpr int KT = K / 64;
  const bf16_t* __restrict__ A = MODE == 0 ? p.hbf : (MODE == 1 ? p.yb : p.mix);
  const bf16_t* __restrict__ Bt = MODE == 0 ? p.WinT + (size_t)layer * 3648 * 1024 : (MODE == 1 ? p.WgluT + (size_t)layer * 512 * 256 : p.WoutT + (size_t)layer * 1024 * 1024);
  const int tid = TID, lane = tid & 63, wv = tid >> 6, r = lane & 31, h = lane >> 5;
  const int wm = wv >> 1, wn = wv & 1;
  const int bid = BID, gdim = GDIM;
  const int xcd = bid & 7, jb = bid >> 3, nbx = (gdim - xcd + 7) >> 3;

  const int total_x = ((258 - xcd + 7) >> 3) * NTN;
  const int nmine = jb < total_x ? (total_x - jb + nbx - 1) / nbx : 0;
  if (nmine == 0) return;
  const int lrow = tid >> 3, kc = tid & 7;
  const int ntm_x = (258 - xcd + 7) >> 3;
  auto decode = [&](int idx, int& tmi_o, int& tn_o) {
    constexpr int QW = 4 * NTN;
    const int nfull = ntm_x >> 2, remw = ntm_x & 3;
    const int quad = idx / QW;
    if (quad < nfull) { const int rem = idx - quad * QW; tn_o = rem >> 2; tmi_o = quad * 4 + (rem & 3); }
    else { const int rem = idx - nfull * QW; tn_o = rem / remw; tmi_o = nfull * 4 + rem % remw; }
  };
  auto set_ptrs = [&](int idx, const bf16_t* (&ap)[4], const bf16_t* (&bp)[2]) {
    int tmi_, tn_; decode(idx, tmi_, tn_);
    const int m0_ = (xcd + 8 * tmi_) * 256, n0_ = tn_ * 128;
#pragma unroll
    for (int i = 0; i < 4; ++i) ap[i] = A + (size_t)(m0_ + lrow + 64 * i) * K + kc * 8;
#pragma unroll
    for (int i = 0; i < 2; ++i) {
      int row = lrow + 64 * i, brow;
      if (MODE == 0) { brow = n0_ + row; brow = brow < 3648 ? brow : 3647; }
      else if (MODE == 2) brow = n0_ + row;
      else { int wn_ = row >> 6, nt_ = (row >> 5) & 1, c_ = row & 31; brow = nt_ * 256 + tn_ * 64 + wn_ * 32 + c_; }
      bp[i] = Bt + (size_t)brow * K + kc * 8;
    }
  };
  f32x16 acc[2][2];
  auto zero_acc = [&]() {
#pragma unroll
    for (int a = 0; a < 2; ++a)
#pragma unroll
      for (int b = 0; b < 2; ++b)
#pragma unroll
        for (int i = 0; i < 16; ++i) acc[a][b][i] = 0.f;
  };
  auto compute = [&](const char* buf, char* nbuf, const u32x4 (&pa)[4], const u32x4 (&pb)[2]) {
    const char* As = buf; const char* Bs = buf + 256 * LDS_ROW;
    char* An = nbuf; char* Bn = nbuf + 256 * LDS_ROW;
    __builtin_amdgcn_iglp_opt(0);
#pragma unroll
    for (int s = 0; s < 4; ++s) {
      bf16x8 af[2], bfr[2];
#pragma unroll
      for (int mt = 0; mt < 2; ++mt) af[mt] = *(const bf16x8*)(As + (wm * 64 + mt * 32 + r) * LDS_ROW + s * 32 + h * 16);
#pragma unroll
      for (int nt = 0; nt < 2; ++nt) bfr[nt] = *(const bf16x8*)(Bs + (wn * 64 + nt * 32 + r) * LDS_ROW + s * 32 + h * 16);
#pragma unroll
      for (int mt = 0; mt < 2; ++mt)
#pragma unroll
        for (int nt = 0; nt < 2; ++nt) acc[mt][nt] = MFMA(bfr[nt], af[mt], acc[mt][nt]);
      if (s < 2) {
        *(u32x4*)(An + (lrow + 64 * (2 * s)) * LDS_ROW + kc * 16) = pa[2 * s];
        *(u32x4*)(An + (lrow + 64 * (2 * s + 1)) * LDS_ROW + kc * 16) = pa[2 * s + 1];
      } else {
        *(u32x4*)(Bn + (lrow + 64 * (s - 2)) * LDS_ROW + kc * 16) = pb[s - 2];
      }
    }
  };
  u32x4 sa[4][4], sb[4][2];
  const bf16_t* cap[4]; const bf16_t* cbp[2]; const bf16_t* nap[4]; const bf16_t* nbp[2];
  set_ptrs(jb, cap, cbp);
#pragma unroll
  for (int j = 0; j < 4; ++j) {
#pragma unroll
    for (int i = 0; i < 4; ++i) sa[j][i] = *(const u32x4*)(cap[i] + j * 64);
#pragma unroll
    for (int i = 0; i < 2; ++i) sb[j][i] = *(const u32x4*)(cbp[i] + j * 64);
  }
  {
    char* As = smem; char* Bs = smem + 256 * LDS_ROW;
#pragma unroll
    for (int i = 0; i < 4; ++i) *(u32x4*)(As + (lrow + 64 * i) * LDS_ROW + kc * 16) = sa[0][i];
#pragma unroll
    for (int i = 0; i < 2; ++i) *(u32x4*)(Bs + (lrow + 64 * i) * LDS_ROW + kc * 16) = sb[0][i];
  }
  lds_barrier();
  zero_acc();
  int c_idx = jb;
  for (int ti = 0; ti < nmine; ++ti) {
    set_ptrs(ti + 1 < nmine ? c_idx + nbx : c_idx, nap, nbp);
    for (int q = 0; q < KT / 4; ++q) {
      const bool lastq = (q == KT / 4 - 1);
      const int koff = lastq ? 0 : (4 * (q + 1)) * 64;
      const bf16_t* lap[4]; const bf16_t* lbp[2];
#pragma unroll
      for (int i = 0; i < 4; ++i) lap[i] = (lastq ? nap[i] : cap[i]) + koff;
#pragma unroll
      for (int i = 0; i < 2; ++i) lbp[i] = (lastq ? nbp[i] : cbp[i]) + koff;
#pragma unroll
      for (int j = 0; j < 4; ++j) {
#pragma unroll
        for (int i = 0; i < 4; ++i) sa[j][i] = *(const u32x4*)(lap[i] + j * 64);
#pragma unroll
        for (int i = 0; i < 2; ++i) sb[j][i] = *(const u32x4*)(lbp[i] + j * 64);
        compute(smem + (j & 1) * STAGE, smem + ((j + 1) & 1) * STAGE, sa[(j + 1) & 3], sb[(j + 1) & 3]);
        lds_barrier();
      }
    }
#pragma unroll
    for (int i = 0; i < 4; ++i) cap[i] = nap[i];
#pragma unroll
    for (int i = 0; i < 2; ++i) cbp[i] = nbp[i];
    const int idx = c_idx; c_idx += nbx;
    int tmi, tn; decode(idx, tmi, tn);
    const int tm = xcd + 8 * tmi;
    const int m0 = tm * 256, n0 = tn * 128;
    char* eps = smem + 2 * STAGE + wv * 4608;
    if (MODE == 0) {
      const int nb = n0 + wn * 64;
      if (nb < 3648) {
        if (layer == 1) {
#pragma unroll
          for (int mt = 0; mt < 2; ++mt) {
            const float rs = rsqrtf(p.ssq[m0 + wm * 64 + mt * 32 + r] * (1.f / 1024.f) + 1e-6f);
#pragma unroll
            for (int nt = 0; nt < 2; ++nt)
#pragma unroll
              for (int i = 0; i < 16; ++i) acc[mt][nt][i] *= rs;
          }
        }
        float scale[2] = {1.f, 1.f};
        if (nb < 1024) {
#pragma unroll
          for (int mt = 0; mt < 2; ++mt) {
            float ss = 0.f;
#pragma unroll
            for (int nt = 0; nt < 2; ++nt)
#pragma unroll
              for (int i = 0; i < 16; ++i) ss += acc[mt][nt][i] * acc[mt][nt][i];
            ss += __shfl_xor(ss, 32);
            scale[mt] = rsqrtf(ss * (1.f / 64.f) + 1e-6f);
          }
        }
        const float* nw = (nb < 512 ? p.q_norm_w : p.k_norm_w) + layer * 64;
#pragma unroll
        for (int mt = 0; mt < 2; ++mt) {
          const int mb = m0 + wm * 64 + mt * 32;
          const int m = mb + r;
          const bool is_p = m < NTOK_P;
#pragma unroll
          for (int nt = 0; nt < 2; ++nt) {
#pragma unroll
            for (int g = 0; g < 4; ++g) {
              const int ncol = nb + nt * 32 + 8 * g + 4 * h;
              float v0 = acc[mt][nt][4 * g], v1 = acc[mt][nt][4 * g + 1], v2 = acc[mt][nt][4 * g + 2], v3 = acc[mt][nt][4 * g + 3];
              if (nb < 1024) {
                float4 w4 = *(const float4*)(nw + (ncol - nb));
                v0 *= scale[mt] * w4.x; v1 *= scale[mt] * w4.y; v2 *= scale[mt] * w4.z; v3 *= scale[mt] * w4.w;
              }
              *(float4*)(eps + r * 144 + (8 * g + 4 * h) * 4) = make_float4(v0, v1, v2, v3);
              if (nb >= OFF_C && nb < OFF_GC) {
                const bool last = is_p ? ((m & 2047) == 2047) : (((m - NTOK_P) & 31) == 31);
                if (last) {
                  float* dst = p.out + (is_p ? O_SHP + ((size_t)layer * 32 + (m >> 11)) * 832 : O_SHS + ((size_t)layer * 16 + ((m - NTOK_P) >> 5)) * 832) + (ncol - OFF_C);
                  *(float4*)dst = make_float4(v0, v1, v2, v3);
                }
              }
            }
            __builtin_amdgcn_wave_barrier();
#pragma unroll
            for (int it = 0; it < 2; ++it) {
              const int row = (lane >> 2) + 16 * it, ch = lane & 3;
              const float4 a = *(const float4*)(eps + row * 144 + ch * 32), c = *(const float4*)(eps + row * 144 + ch * 32 + 16);
              u32x4 o; o.x = pk2(a.x, a.y); o.y = pk2(a.z, a.w); o.z = pk2(c.x, c.y); o.w = pk2(c.z, c.w);
              nt_store16(p.P + (size_t)(mb + row) * D_IN + nb + nt * 32 + ch * 8, o);
            }
            if (nb >= 512 && nb < 1536) {
#pragma unroll
              for (int it = 0; it < 4; ++it) {
                const int row = it * 8 + (lane >> 3), ch = lane & 7;
                const float4 a = *(const float4*)(eps + row * 144 + ch * 16);
                const int mm = mb + row;
                const bool pp = mm < NTOK_P;
                float* dst;
                if (nb < 1024) dst = p.out + (pp ? O_KP + ((size_t)layer * 65536 + mm) * 512 : O_KS + ((size_t)layer * 512 + (mm - NTOK_P)) * 512) + (nb - 512);
                else dst = p.out + (pp ? O_VP + ((size_t)layer * 65536 + mm) * 512 : O_VS + ((size_t)layer * 512 + (mm - NTOK_P)) * 512) + (nb - 1024);
                nt_store16f(dst + nt * 32 + ch * 4, a);
              }
            }
            __builtin_amdgcn_wave_barrier();
          }
        }
      }
    } else if (MODE == 1) {
      const float* bg = p.b_glu + layer * 512;
#pragma unroll
      for (int mt = 0; mt < 2; ++mt) {
        const int m = m0 + wm * 64 + mt * 32 + r;
#pragma unroll
        for (int g = 0; g < 4; ++g) {
          const int col = tn * 64 + wn * 32 + 8 * g + 4 * h;
          float4 bv = *(const float4*)(bg + col), bgt = *(const float4*)(bg + 256 + col);
          u32x2 gb = *(const u32x2*)(p.P + (size_t)m * D_IN + OFF_GB + col);
          float o0 = (acc[mt][0][4 * g] + bv.x) * sigmoidf_(acc[mt][1][4 * g] + bgt.x) * siluf_(bflo(gb.x));
          float o1 = (acc[mt][0][4 * g + 1] + bv.y) * sigmoidf_(acc[mt][1][4 * g + 1] + bgt.y) * siluf_(bfhi(gb.x));
          float o2 = (acc[mt][0][4 * g + 2] + bv.z) * sigmoidf_(acc[mt][1][4 * g + 2] + bgt.z) * siluf_(bflo(gb.y));
          float o3 = (acc[mt][0][4 * g + 3] + bv.w) * sigmoidf_(acc[mt][1][4 * g + 3] + bgt.w) * siluf_(bfhi(gb.y));
          u32x2 o; o.x = pk2(o0, o1); o.y = pk2(o2, o3);
          *(u32x2*)(p.mix + (size_t)m * 1024 + 512 + col) = o;
        }
      }
    } else {
      const float* nw1 = p.norm_w + 1024;
#pragma unroll
      for (int mt = 0; mt < 2; ++mt) {
        const int mb = m0 + wm * 64 + mt * 32;
        float sq[4] = {0.f, 0.f, 0.f, 0.f};
#pragma unroll
        for (int nt = 0; nt < 2; ++nt) {
#pragma unroll
          for (int g = 0; g < 4; ++g)
            *(float4*)(eps + r * 144 + (8 * g + 4 * h) * 4) = make_float4(acc[mt][nt][4 * g], acc[mt][nt][4 * g + 1], acc[mt][nt][4 * g + 2], acc[mt][nt][4 * g + 3]);
          __builtin_amdgcn_wave_barrier();
#pragma unroll
          for (int it = 0; it < 4; ++it) {
            const int row = it * 8 + (lane >> 3), ch = lane & 7;
            const float4 a = *(const float4*)(eps + row * 144 + ch * 16);
            const int mm = mb + row, ncol = n0 + wn * 64 + nt * 32 + ch * 4;
            float4 xv = *(const float4*)(xrow(p, layer, mm) + ncol);
            xv.x += a.x; xv.y += a.y; xv.z += a.z; xv.w += a.w;
            nt_store16f(p.out + (size_t)mm * 1024 + ncol, xv);
            if (layer == 0) {
              sq[it] += xv.x * xv.x + xv.y * xv.y + xv.z * xv.z + xv.w * xv.w;
              const float4 w4 = *(const float4*)(nw1 + ncol);
              u32x2 o; o.x = pk2(xv.x * w4.x, xv.y * w4.y); o.y = pk2(xv.z * w4.z, xv.w * w4.w);
              *(u32x2*)(p.hbf + (size_t)mm * 1024 + ncol) = o;
            }
          }
          __builtin_amdgcn_wave_barrier();
        }
        if (layer == 0) {
#pragma unroll
          for (int it = 0; it < 4; ++it) {
            const float s = sum8(sq[it]);
            if ((lane & 7) == 0) atomicAdd(p.ssq + mb + it * 8 + (lane >> 3), s);
          }
        }
      }
    }
    zero_acc();
  }
}

constexpr int VS = 66;
DI void attn_item(const Params& p, int layer, int wi, bf16_t* vl) {
  const int lane = TID & 63, r = lane & 31, h = lane >> 5;
  const bool sample = wi >= 16384;
  int b, hd, qt, tok0, qabs0;
  if (!sample) { b = wi >> 9; hd = (wi >> 6) & 7; qt = wi & 63; tok0 = b * 2048; qabs0 = qt * 32; }
  else { int j = wi - 16384; b = j >> 3; hd = j & 7; qt = 0; tok0 = NTOK_P + b * 32; qabs0 = 4096; }
  const int tq0 = tok0 + qt * 32;
  bf16x8 qf[4];
  {
    const bf16_t* qp = p.P + (size_t)(tq0 + r) * D_IN + OFF_Q + hd * 64 + h * 8;
#pragma unroll
    for (int ks = 0; ks < 4; ++ks) qf[ks] = *(const bf16x8*)(qp + ks * 16);
  }
  u32x2 gap[2][4];
#pragma unroll
  for (int dt = 0; dt < 2; ++dt)
#pragma unroll
    for (int g = 0; g < 4; ++g) gap[dt][g] = *(const u32x2*)(p.P + (size_t)(tq0 + r) * D_IN + OFF_GA + hd * 64 + 32 * dt + 8 * g + 4 * h);
  f32x16 o[2];
#pragma unroll
  for (int d = 0; d < 2; ++d)
#pragma unroll
    for (int i = 0; i < 16; ++i) o[d][i] = 0.f;
  float run = 0.f;
  const int nblk = qabs0 / 32 + 1;
  const int pir = 16 * ((r >> 2) & 1) + 4 * (r >> 3) + (r & 3);
  const float* ck = p.cache_k + ((size_t)(layer * 16 + b) * 4096) * 512 + hd * 64;
  const float* cv = p.cache_v + ((size_t)(layer * 16 + b) * 4096) * 512 + hd * 64;

  bf16x8 kfn[4]; u32x4 vrn[4];
  auto load_p = [&](int kb_) {
    const int kp0_ = kb_ * 32;
    const int tk = sample ? (tok0 + (kp0_ + pir - 4096)) : (tok0 + kp0_ + pir);
    const bf16_t* kp = p.P + (size_t)tk * D_IN + OFF_K + hd * 64 + h * 8;
#pragma unroll
    for (int ks = 0; ks < 4; ++ks) kfn[ks] = *(const bf16x8*)(kp + ks * 16);
#pragma unroll
    for (int i = 0; i < 4; ++i) {
      const int key = i * 8 + (lane >> 3), dc = lane & 7;
      const int tv = sample ? (tok0 + (kp0_ + key - 4096)) : (tok0 + kp0_ + key);
      vrn[i] = *(const u32x4*)(p.P + (size_t)tv * D_IN + OFF_V + hd * 64 + dc * 8);
    }
  };
  load_p(nblk - 1);
  for (int kb = nblk - 1; kb >= 0; --kb) {
    const int kp0 = kb * 32;
    const bool fromP = (!sample) || (kb == 128);
    bf16x8 kf[4];
    if (fromP) {
#pragma unroll
      for (int ks = 0; ks < 4; ++ks) kf[ks] = kfn[ks];
#pragma unroll
      for (int i = 0; i < 4; ++i) {
        const int key = i * 8 + (lane >> 3), dc = lane & 7;
        unsigned* dst = (unsigned*)(vl + key * VS + dc * 8);
        dst[0] = vrn[i].x; dst[1] = vrn[i].y; dst[2] = vrn[i].z; dst[3] = vrn[i].w;
      }
      if (!sample && kb > 0) load_p(kb - 1);
    } else {
      const float* kp = ck + (size_t)(kp0 + pir) * 512 + h * 8;
#pragma unroll
      for (int ks = 0; ks < 4; ++ks) {
        float4 a = *(const float4*)(kp + ks * 16), c = *(const float4*)(kp + ks * 16 + 4);
        u32x4 t; t.x = pk2(a.x, a.y); t.y = pk2(a.z, a.w); t.z = pk2(c.x, c.y); t.w = pk2(c.z, c.w);
        kf[ks] = __builtin_bit_cast(bf16x8, t);
      }
#pragma unroll
      for (int i = 0; i < 4; ++i) {
        const int key = i * 8 + (lane >> 3), dc = lane & 7;
        const float* vp = cv + (size_t)(kp0 + key) * 512 + dc * 8;
        float4 a = *(const float4*)vp, c = *(const float4*)(vp + 4);
        unsigned* dst = (unsigned*)(vl + key * VS + dc * 8);
        dst[0] = pk2(a.x, a.y); dst[1] = pk2(a.z, a.w); dst[2] = pk2(c.x, c.y); dst[3] = pk2(c.z, c.w);
      }
    }
    f32x16 st;
#pragma unroll
    for (int i = 0; i < 16; ++i) st[i] = 0.f;
#pragma unroll
    for (int ks = 0; ks < 4; ++ks) st = MFMA(kf[ks], qf[ks], st);
    const bool diag = (kb == nblk - 1);
    float z[16], lk[16], lat[16];
#pragma unroll
    for (int i = 0; i < 16; ++i) {
      z[i] = st[i] * 0.125f;
      const bool msk = (!diag) || (16 * h + i < r);
      const float e = __expf(-fabsf(z[i]));
      const float sp = fmaxf(z[i], 0.f) + __logf(1.f + e);
      lk[i] = msk ? -sp : 0.f;
    }
    float suf = 0.f;
#pragma unroll
    for (int i = 15; i >= 0; --i) { lat[i] = suf; suf += lk[i]; }
    const float other = __shfl_xor(suf, 32);
    const float base = run + (h == 0 ? other : 0.f);
    float a[16];
#pragma unroll
    for (int i = 0; i < 16; ++i) {
      const bool msk = (!diag) || (16 * h + i < r);
      a[i] = msk ? __expf(z[i] + lk[i] + base + lat[i]) : 0.f;
    }
    run += suf + other;
    __builtin_amdgcn_wave_barrier();
#pragma unroll
    for (int s2 = 0; s2 < 2; ++s2) {
      u32x4 t; t.x = pk2(a[8 * s2], a[8 * s2 + 1]); t.y = pk2(a[8 * s2 + 2], a[8 * s2 + 3]); t.z = pk2(a[8 * s2 + 4], a[8 * s2 + 5]); t.w = pk2(a[8 * s2 + 6], a[8 * s2 + 7]);
      const bf16x8 pf = __builtin_bit_cast(bf16x8, t);
#pragma unroll
      for (int dt = 0; dt < 2; ++dt) {
        const bf16_t* vp = vl + (16 * h + 8 * s2) * VS + 32 * dt + r;
        bf16x8 vf;
#pragma unroll
        for (int j = 0; j < 8; ++j) vf[j] = (short)vp[j * VS];
        o[dt] = MFMA(vf, pf, o[dt]);
      }
    }
    __builtin_amdgcn_wave_barrier();
    if (__all(run < -104.f)) break;
  }
  const int tok = tq0 + r;
#pragma unroll
  for (int dt = 0; dt < 2; ++dt)
#pragma unroll
    for (int g = 0; g < 4; ++g) {
      const int d0 = 32 * dt + 8 * g + 4 * h;
      const u32x2 ga = gap[dt][g];
      u32x2 ov;
      ov.x = pk2(o[dt][4 * g] * siluf_(bflo(ga.x)), o[dt][4 * g + 1] * siluf_(bfhi(ga.x)));
      ov.y = pk2(o[dt][4 * g + 2] * siluf_(bflo(ga.y)), o[dt][4 * g + 3] * siluf_(bfhi(ga.y)));
      *(u32x2*)(p.mix + (size_t)tok * 1024 + hd * 64 + d0) = ov;
    }
}

constexpr int S5_BU = 8192;
constexpr int S5_LDS = S5_BU + 8704 + 1024;
DI void s5_disc(const Params& p, int lg, int pi, float dt, float& ar, float& ai, float& fr, float& fi) {
  const float lr = fminf(p.lam_re[lg * 64 + pi], -1e-4f), li = p.lam_im[lg * 64 + pi];
  const float er = expf(lr * dt);
  ar = er * cosf(li * dt); ai = er * sinf(li * dt);
  const float den = lr * lr + li * li;
  fr = ((ar - 1.f) * lr + ai * li) / den; fi = (ai * lr - (ar - 1.f) * li) / den;
}
DI void s5_item(const Params& p, int layer, int item, char* lds) {
  float* BU = (float*)lds;
  char* Himg = lds + S5_BU;
  bf16_t* Ub = (bf16_t*)(lds + S5_BU + 8704);
  const int lane = TID & 63, r = lane & 31, h = lane >> 5;
  const int seq = item >> 4, g = item & 15;
  const bool sample = seq >= 32;
  const int b = sample ? seq - 32 : seq, L = sample ? 32 : 2048, tok0 = sample ? NTOK_P + b * 32 : b * 2048;
  const int lg = layer * 16 + g;
  const float dt = expf(p.log_dt[lg]);
  float ar, ai, fr_, fi_;
  s5_disc(p, lg, lane, dt, ar, ai, fr_, fi_);
  bf16x8 bbf[4];
#pragma unroll
  for (int half = 0; half < 2; ++half) {
    const int pi = 32 * half + r;
    float a_r, a_i, f_r, f_i;
    s5_disc(p, lg, pi, dt, a_r, a_i, f_r, f_i);
    const float* brp = p.b_re + ((size_t)lg * 64 + pi) * 16 + 8 * h;
    const float* bip = p.b_im + ((size_t)lg * 64 + pi) * 16 + 8 * h;
    float re[8], im[8];
#pragma unroll
    for (int j = 0; j < 8; ++j) { const float br = brp[j], bi = bip[j]; re[j] = f_r * br - f_i * bi; im[j] = f_r * bi + f_i * br; }
    u32x4 t0, t1;
    t0.x = pk2(re[0], re[1]); t0.y = pk2(re[2], re[3]); t0.z = pk2(re[4], re[5]); t0.w = pk2(re[6], re[7]);
    t1.x = pk2(im[0], im[1]); t1.y = pk2(im[2], im[3]); t1.z = pk2(im[4], im[5]); t1.w = pk2(im[6], im[7]);
    bbf[half] = __builtin_bit_cast(bf16x8, t0);
    bbf[2 + half] = __builtin_bit_cast(bf16x8, t1);
  }
  bf16x8 cf[8];
#pragma unroll
  for (int s = 0; s < 8; ++s) {
    u32x4 t; t.x = 0; t.y = 0; t.z = 0; t.w = 0;
    if (r < 16) {
      const int k0 = 16 * s + 8 * h;
      const float* src = (s < 4 ? p.c_re : p.c_im) + ((size_t)lg * 16 + r) * 64 + (k0 & 63);
      const float sg = s < 4 ? 1.f : -1.f;
      const float4 c0 = *(const float4*)src, c1 = *(const float4*)(src + 4);
      t.x = pk2(sg * c0.x, sg * c0.y); t.y = pk2(sg * c0.z, sg * c0.w); t.z = pk2(sg * c1.x, sg * c1.y); t.w = pk2(sg * c1.z, sg * c1.w);
    }
    cf[s] = __builtin_bit_cast(bf16x8, t);
  }
  const float dl = p.ssm_d[lg * 16 + (r & 15)];
  float hr = 0.f, hi = 0.f;
  if (sample) { hr = p.st_re[((size_t)(layer * 16 + b) * 16 + g) * 64 + lane]; hi = p.st_im[((size_t)(layer * 16 + b) * 16 + g) * 64 + lane]; }
  f32x16 zero;
#pragma unroll
  for (int i = 0; i < 16; ++i) zero[i] = 0.f;
  const bf16_t* upb = p.P + (size_t)(tok0 + r) * D_IN + OFF_U + g * 16 + 8 * h;
  bf16x8 uf = *(const bf16x8*)upb;
  for (int t0 = 0; t0 < L; t0 += 32) {
    const bf16x8 ucur = uf;
    if (t0 + 32 < L) uf = *(const bf16x8*)(upb + (size_t)(t0 + 32) * D_IN);
    *(bf16x8*)(Ub + r * 16 + 8 * h) = ucur;
    f32x16 d[4];
#pragma unroll
    for (int tile = 0; tile < 4; ++tile) d[tile] = MFMA(ucur, bbf[tile], zero);
#pragma unroll
    for (int hf = 0; hf < 2; ++hf) {
#pragma unroll
      for (int tile = 0; tile < 4; ++tile)
#pragma unroll
        for (int i = 0; i < 8; ++i) BU[((i & 3) + 8 * (i >> 2) + 4 * h) * 128 + 32 * tile + r] = d[tile][8 * hf + i];
      __builtin_amdgcn_wave_barrier();
#pragma unroll
      for (int tt = 0; tt < 16; ++tt) {
        const int t = 16 * hf + tt;
        const float bur = BU[tt * 128 + lane], bui = BU[tt * 128 + 64 + lane];
        const float nhr = ar * hr - ai * hi + bur, nhi = ar * hi + ai * hr + bui;
        hr = nhr; hi = nhi;
        *(bf16_t*)(Himg + t * 272 + lane * 2) = (bf16_t)f2bf(hr);
        *(bf16_t*)(Himg + t * 272 + 128 + lane * 2) = (bf16_t)f2bf(hi);
      }
      __builtin_amdgcn_wave_barrier();
    }
    f32x16 yacc = zero;
#pragma unroll
    for (int s = 0; s < 8; ++s) {
      const bf16x8 af = *(const bf16x8*)(Himg + r * 272 + s * 32 + h * 16);
      yacc = MFMA(af, cf[s], yacc);
    }
    if (r < 16) {
#pragma unroll
      for (int i = 0; i < 16; ++i) {
        const int t = (i & 3) + 8 * (i >> 2) + 4 * h;
        const float yv = yacc[i] + dl * bf2f(Ub[t * 16 + r]);
        const float gl = yv * __builtin_amdgcn_rcpf(1.f + __expf(-1.5957691216f * (yv + 0.044715f * yv * yv * yv)));
        p.yb[(size_t)(tok0 + t0 + t) * 256 + g * 16 + r] = (bf16_t)f2bf(gl);
      }
    }
    __builtin_amdgcn_wave_barrier();
  }
  float* ore = p.out + (sample ? O_SRES : O_SREP) + ((size_t)(layer * (sample ? 16 : 32) + b) * 16 + g) * 64 + lane;
  float* oim = p.out + (sample ? O_SIMS : O_SIMP) + ((size_t)(layer * (sample ? 16 : 32) + b) * 16 + g) * 64 + lane;
  *ore = hr; *oim = hi;
}

DI void rwkv_item(const Params& p, int layer, int item, char* smem) {
  constexpr int SETF = 6 * 2048;
  float* SET0 = (float*)smem;
  float* YB = SET0 + 2 * SETF;
  char* PW = (char*)(YB + 2 * 2048);
  const int tid = TID, lane = tid & 63, wv = tid >> 6;
  const int seq = item >> 2, hd = item & 3;
  const bool sample = seq >= 32;
  const int b = sample ? seq - 32 : seq, L = sample ? 32 : 2048, tok0 = sample ? NTOK_P + b * 32 : b * 2048;
  const int nch = L >> 5;
  if (wv < 4) {
    const int rp = tid >> 3, kq = tid & 7;
    f32x2 S0[4], S1[4];
    if (sample) {
      const float* sp = p.st_wkv + (((size_t)(layer * 16 + b) * 4 + hd) * 64 + rp) * 64 + kq * 8;
#pragma unroll
      for (int j = 0; j < 4; ++j) { S0[j].x = sp[2 * j]; S0[j].y = sp[2 * j + 1]; S1[j].x = sp[2048 + 2 * j]; S1[j].y = sp[2048 + 2 * j + 1]; }
    } else {
#pragma unroll
      for (int j = 0; j < 4; ++j) { S0[j].x = 0.f; S0[j].y = 0.f; S1[j].x = 0.f; S1[j].y = 0.f; }
    }
    lds_barrier();
    for (int c = 0; c < nch; ++c) {
      const float* R = SET0 + (c & 1) * SETF; const float* W = R + 2048; const float* KT = W + 2048; const float* KH = KT + 2048;
      const float* BB = KH + 2048; const float* V = BB + 2048;
      float* Y = YB + (c & 1) * 2048;
      float yk0[4], yk1[4];
      float4 nkh0, nkh1, nw0, nw1, nb0, nb1, nk0, nk1, nr0, nr1; float nv0, nv1;
      {
        const int o = kq * 8;
        nkh0 = *(const float4*)(KH + o); nkh1 = *(const float4*)(KH + o + 4); nw0 = *(const float4*)(W + o); nw1 = *(const float4*)(W + o + 4);
        nb0 = *(const float4*)(BB + o); nb1 = *(const float4*)(BB + o + 4); nk0 = *(const float4*)(KT + o); nk1 = *(const float4*)(KT + o + 4);
        nr0 = *(const float4*)(R + o); nr1 = *(const float4*)(R + o + 4); nv0 = V[rp]; nv1 = V[rp + 32];
      }
#pragma unroll
      for (int q = 0; q < 4; ++q) {
        yk0[q] = 0.f; yk1[q] = 0.f;
#pragma unroll
        for (int e = 0; e < 8; ++e) {
          const int tl = q * 8 + e;
          const float4 kh0 = nkh0, kh1 = nkh1, w0_ = nw0, w1_ = nw1, b0 = nb0, b1 = nb1, k0 = nk0, k1 = nk1, r0 = nr0, r1 = nr1;
          const float va = nv0, vb = nv1;
          if (tl < 31) {
            const int o = (tl + 1) * 64 + kq * 8;
            nkh0 = *(const float4*)(KH + o); nkh1 = *(const float4*)(KH + o + 4); nw0 = *(const float4*)(W + o); nw1 = *(const float4*)(W + o + 4);
            nb0 = *(const float4*)(BB + o); nb1 = *(const float4*)(BB + o + 4); nk0 = *(const float4*)(KT + o); nk1 = *(const float4*)(KT + o + 4);
            nr0 = *(const float4*)(R + o); nr1 = *(const float4*)(R + o + 4); nv0 = V[(tl + 1) * 64 + rp]; nv1 = V[(tl + 1) * 64 + rp + 32];
          }
          const f32x2 khv[4] = {{kh0.x, kh0.y}, {kh0.z, kh0.w}, {kh1.x, kh1.y}, {kh1.z, kh1.w}};
          const f32x2 wvv[4] = {{w0_.x, w0_.y}, {w0_.z, w0_.w}, {w1_.x, w1_.y}, {w1_.z, w1_.w}};
          const f32x2 bv[4] = {{b0.x, b0.y}, {b0.z, b0.w}, {b1.x, b1.y}, {b1.z, b1.w}};
          const f32x2 kv[4] = {{k0.x, k0.y}, {k0.z, k0.w}, {k1.x, k1.y}, {k1.z, k1.w}};
          const f32x2 rv[4] = {{r0.x, r0.y}, {r0.z, r0.w}, {r1.x, r1.y}, {r1.z, r1.w}};
          const f32x2 va2 = {va, va}, vb2 = {vb, vb};
          f32x2 ma[4], mb[4];
#pragma unroll
          for (int j = 0; j < 4; ++j) { ma[j] = fma2(S0[j], wvv[j], va2 * kv[j]); mb[j] = fma2(S1[j], wvv[j], vb2 * kv[j]); }
          f32x2 sa2 = fma2(S0[1], khv[1], S0[0] * khv[0]) + fma2(S0[3], khv[3], S0[2] * khv[2]);
          f32x2 sb2 = fma2(S1[1], khv[1], S1[0] * khv[0]) + fma2(S1[3], khv[3], S1[2] * khv[2]);
          const float sa = sum8(sa2.x + sa2.y), sb = sum8(sb2.x + sb2.y);
          const f32x2 nsa = {-sa, -sa}, nsb = {-sb, -sb};
#pragma unroll
          for (int j = 0; j < 4; ++j) { S0[j] = fma2(nsa, bv[j], ma[j]); S1[j] = fma2(nsb, bv[j], mb[j]); }
          f32x2 ya2 = fma2(S0[1], rv[1], S0[0] * rv[0]) + fma2(S0[3], rv[3], S0[2] * rv[2]);
          f32x2 yb2 = fma2(S1[1], rv[1], S1[0] * rv[0]) + fma2(S1[3], rv[3], S1[2] * rv[2]);
          const float ya = sum8(ya2.x + ya2.y), ybv = sum8(yb2.x + yb2.y);
          yk0[q] = (e == kq) ? ya : yk0[q];
          yk1[q] = (e == kq) ? ybv : yk1[q];
        }
      }
#pragma unroll
      for (int q = 0; q < 4; ++q) { Y[(q * 8 + kq) * 64 + rp] = yk0[q]; Y[(q * 8 + kq) * 64 + rp + 32] = yk1[q]; }
      lds_barrier();
    }
    float* so = p.out + (sample ? O_WKVS : O_WKVP) + (((size_t)(layer * (sample ? 16 : 32) + b) * 4 + hd) * 64 + rp) * 64 + kq * 8;
    *(float4*)so = make_float4(S0[0].x, S0[0].y, S0[1].x, S0[1].y);
    *(float4*)(so + 4) = make_float4(S0[2].x, S0[2].y, S0[3].x, S0[3].y);
    *(float4*)(so + 2048) = make_float4(S1[0].x, S1[0].y, S1[1].x, S1[1].y);
    *(float4*)(so + 2052) = make_float4(S1[2].x, S1[2].y, S1[3].x, S1[3].y);
  } else {
    const int pw = wv - 4, r_ = lane & 31, h_ = lane >> 5;
    const int cg_ = hd * 64 + lane;
    bf16_t* LORAb = (bf16_t*)(PW + pw * 5248);
    float* DSA = (float*)(PW + pw * 5248 + 1152);
    bf16x8 lb[2][2][2];
#pragma unroll
    for (int ll = 0; ll < 2; ++ll)
#pragma unroll
      for (int nn = 0; nn < 2; ++nn) {
        const float* srcw = (ll ? p.a2 : p.w2) + (size_t)layer * 32 * 256 + hd * 64 + 32 * nn + r_;
#pragma unroll
        for (int s = 0; s < 2; ++s) {
          float t[8];
#pragma unroll
          for (int j = 0; j < 8; ++j) t[j] = srcw[(size_t)(16 * s + 8 * h_ + j) * 256];
          u32x4 u; u.x = pk2(t[0], t[1]); u.y = pk2(t[2], t[3]); u.z = pk2(t[4], t[5]); u.w = pk2(t[6], t[7]);
          lb[ll][nn][s] = __builtin_bit_cast(bf16x8, u);
        }
      }
    const float w0c = p.w0[layer * 256 + cg_], a0c = p.a0[layer * 256 + cg_], kkc = p.k_k[layer * 256 + cg_], kac = p.k_a[layer * 256 + cg_];
    const float ubc = p.u_bonus[layer * 256 + cg_], lnw = p.ln_w[layer * 256 + cg_], lnb = p.ln_b[layer * 256 + cg_];
    const float* mu = p.mu + layer * 832;
    const float mu_r = mu[cg_], mu_k = mu[256 + cg_], mu_v = mu[512 + cg_], mu_l = mu[768 + lane];
    const float* shp = p.st_shift + (size_t)(layer * 16 + b) * 832;
    auto pre = [&](int c, float (&xvk)[8], float (&bonk)[8], float (&gtk)[8]) {
      float* R = SET0 + (c & 1) * SETF; float* W = R + 2048; float* KT = W + 2048; float* KH = KT + 2048; float* BB = KH + 2048; float* V = BB + 2048;
      const bf16_t* base = p.P + (size_t)(tok0 + c * 32 + 8 * pw) * D_IN + OFF_C;
      bf16_t cr[8], ck[8], cv[8], cl[8], cgt[8];
#pragma unroll
      for (int i = 0; i < 8; ++i) {
        const bf16_t* cp = base + (size_t)i * D_IN;
        cr[i] = cp[cg_]; ck[i] = cp[256 + cg_]; cv[i] = cp[512 + cg_]; cl[i] = cp[768 + lane]; cgt[i] = cp[OFF_GC - OFF_C + cg_];
      }
      float pr, pk, pv, pl;
      if (c * 32 + 8 * pw == 0) {
        if (sample) { pr = shp[cg_]; pk = shp[256 + cg_]; pv = shp[512 + cg_]; pl = shp[768 + lane]; }
        else { pr = 0.f; pk = 0.f; pv = 0.f; pl = 0.f; }
      } else {
        const bf16_t* pp = base - D_IN;
        pr = bf2f(pp[cg_]); pk = bf2f(pp[256 + cg_]); pv = bf2f(pp[512 + cg_]); pl = bf2f(pp[768 + lane]);
      }
      float xr_[8], xk_[8];
#pragma unroll
      for (int i = 0; i < 8; ++i) {
        const float c_r = bf2f(cr[i]), c_k = bf2f(ck[i]), c_v = bf2f(cv[i]), c_l = bf2f(cl[i]);
        xr_[i] = c_r + mu_r * (pr - c_r); xk_[i] = c_k + mu_k * (pk - c_k); xvk[i] = c_v + mu_v * (pv - c_v);
        const float xl = c_l + mu_l * (pl - c_l);
        pr = c_r; pk = c_k; pv = c_v; pl = c_l;
        gtk[i] = bf2f(cgt[i]);
        LORAb[i * 72 + lane] = (bf16_t)f2bf(lane < 32 ? fast_tanh(xl) : xl);
      }
      __builtin_amdgcn_wave_barrier();
#pragma unroll
      for (int ll = 0; ll < 2; ++ll) {
        const bf16x8 af0 = *(const bf16x8*)((const char*)LORAb + (r_ & 7) * 144 + ll * 64 + h_ * 16);
        const bf16x8 af1 = *(const bf16x8*)((const char*)LORAb + (r_ & 7) * 144 + ll * 64 + 32 + h_ * 16);
#pragma unroll
        for (int nn = 0; nn < 2; ++nn) {
          f32x16 dacc;
#pragma unroll
          for (int i = 0; i < 16; ++i) dacc[i] = 0.f;
          dacc = MFMA(af0, lb[ll][nn][0], dacc);
          dacc = MFMA(af1, lb[ll][nn][1], dacc);
#pragma unroll
          for (int i = 0; i < 4; ++i) DSA[ll * 512 + (i + 4 * h_) * 64 + 32 * nn + r_] = dacc[i];
        }
      }
      __builtin_amdgcn_wave_barrier();
#pragma unroll
      for (int i = 0; i < 8; ++i) {
        const int tl = 8 * pw + i;
        const float dsum = w0c + DSA[i * 64 + lane], asum = a0c + DSA[512 + i * 64 + lane];
        const float dec = __expf(-0.6065306597f * sigmoidf_(dsum));
        const float a = sigmoidf_(asum);
        const float kk = xk_[i] * kkc;
        const float ss = wave_sum(kk * kk);
        const float kh = kk * __builtin_amdgcn_rsqf(ss + 1e-12f);
        const float kt = xk_[i] * (1.f + (a - 1.f) * kac);
        bonk[i] = wave_sum(xr_[i] * kt * ubc);
        R[tl * 64 + lane] = xr_[i]; W[tl * 64 + lane] = dec; KT[tl * 64 + lane] = kt; KH[tl * 64 + lane] = kh; BB[tl * 64 + lane] = a * kh; V[tl * 64 + lane] = xvk[i];
      }
      __builtin_amdgcn_wave_barrier();
    };
    auto post = [&](int c, const float (&xvk)[8], const float (&bonk)[8], const float (&gtk)[8]) {
      const float* Y = YB + (c & 1) * 2048;
#pragma unroll
      for (int i = 0; i < 8; ++i) {
        const int tl = 8 * pw + i;
        const float y = Y[tl * 64 + lane];
        const float mean = wave_sum(y) * (1.f / 64.f);
        const float msq = wave_sum(y * y) * (1.f / 64.f);
        const float var = fmaxf(msq - mean * mean, 0.f);
        float yn = (y - mean) * __builtin_amdgcn_rsqf(var + 64e-5f) * lnw + lnb;
        yn += bonk[i] * xvk[i];
        p.mix[(size_t)(tok0 + c * 32 + tl) * 1024 + 768 + cg_] = (bf16_t)f2bf(yn * siluf_(gtk[i]));
      }
    };
    float xvA[8], bonA[8], gtA[8], xvB[8], bonB[8], gtB[8];
#pragma unroll
    for (int i = 0; i < 8; ++i) { xvB[i] = 0.f; bonB[i] = 0.f; gtB[i] = 0.f; }
    pre(0, xvA, bonA, gtA);
    lds_barrier();
    for (int c = 0; c < nch; c += 2) {
      if (c >= 1) post(c - 1, xvB, bonB, gtB);
      if (c + 1 < nch) pre(c + 1, xvB, bonB, gtB);
      lds_barrier();
      if (c + 1 < nch) {
        post(c, xvA, bonA, gtA);
        if (c + 2 < nch) pre(c + 2, xvA, bonA, gtA);
        lds_barrier();
      }
    }
    if ((nch - 1) & 1) post(nch - 1, xvB, bonB, gtB); else post(nch - 1, xvA, bonA, gtA);
  }
  lds_barrier();
}

constexpr int ATT_LDS0 = 6 * S5_LDS;
DI void phase_mixers(const Params& p, int layer, char* smem, int cofs) {
  const int G = GDIM, bid = BID, half = G / 2;
  const int tid = TID, wv = tid >> 6, lane = tid & 63;
  if (bid < half) {
    for (int item = bid; item < 128; item += half) rwkv_item(p, layer, item, smem);
  } else {
    const int j = bid - half, nb2 = G - half;
    for (int item = 128 + j; item < 192; item += nb2) rwkv_item(p, layer, item, smem);
    if (wv < 6) { for (int it = j * 6 + wv; it < 768; it += nb2 * 6) s5_item(p, layer, it, smem + wv * S5_LDS); }
  }
  unsigned* ctr = p.counters + layer + cofs;
  bf16_t* vl = (bf16_t*)(smem + ATT_LDS0) + wv * (32 * VS);
  while (true) {
    int it = 0;
    if (lane == 0) it = (int)atomicAdd(ctr, 1u);
    it = __builtin_amdgcn_readfirstlane(it);
    if (it >= 16512) break;
    attn_item(p, layer, it, vl);
  }
}

__global__ void __launch_bounds__(NT) mega(Params p) {
  __shared__ __attribute__((aligned(16))) char smem[SMEM_BYTES];
  cg::grid_group grid = cg::this_grid();
  phase_weights(p, smem);
  phase_norm(p, 0);
  grid.sync();
  for (int layer = 0; layer < 2; ++layer) {
    gemm_phase<0>(p, layer, smem);
    grid.sync();
#if PROBE_GEMM0
    gemm_phase<0>(p, layer, smem);
    grid.sync();
#endif
    phase_mixers(p, layer, smem, 0);
    grid.sync();
#if PROBE_MIX
    phase_mixers(p, layer, smem, 2);
    grid.sync();
#endif
    gemm_phase<1>(p, layer, smem);
    grid.sync();
    gemm_phase<2>(p, layer, smem);
    if (layer == 0) grid.sync();
  }
}

#if MULTI_LAUNCH
template <int PH>
__global__ void __launch_bounds__(NT) phase_kernel(Params p, int layer) {
  __shared__ __attribute__((aligned(16))) char smem[SMEM_BYTES];
  if (PH == 0) { phase_weights(p, smem); }
  else if (PH == 1) phase_norm(p, layer);
  else if (PH == 2) gemm_phase<0>(p, layer, smem);
  else if (PH == 3) phase_mixers(p, layer, smem, 0);
  else if (PH == 4) gemm_phase<1>(p, layer, smem);
  else gemm_phase<2>(p, layer, smem);
}
#endif

extern "C" void kernel_launch(void* const* d_in, const int* in_sizes, int n_in, void* d_out, int out_size, void* d_ws, size_t ws_size, hipStream_t stream) {
  Params p{};
  const float** f = (const float**)&p;
  for (int i = 0; i < 33; ++i) f[i] = (const float*)d_in[i];
  p.out = (float*)d_out;
  char* ws = (char*)d_ws;
  size_t off = 0;
  auto take = [&](size_t bytes) { char* q = ws + off; off += (bytes + 255) & ~(size_t)255; return q; };
  p.WinT = (bf16_t*)take((size_t)2 * 3648 * 1024 * 2);
  p.WoutT = (bf16_t*)take((size_t)2 * 1024 * 1024 * 2);
  p.WgluT = (bf16_t*)take((size_t)2 * 512 * 256 * 2);
  p.hbf = (bf16_t*)take((size_t)NTOK * 1024 * 2);
  p.P = (bf16_t*)take((size_t)NTOK * D_IN * 2);
  p.mix = (bf16_t*)take((size_t)NTOK * 1024 * 2);
  p.yb = (bf16_t*)take((size_t)NTOK * 256 * 2);
  p.counters = (unsigned*)take(256);
  p.ssq = (float*)take((size_t)NTOK * 4);
  if (off > ws_size || (size_t)out_size != O_END || n_in != 33) fprintf(stderr, "kernel_launch: unexpected sizes ws=%zu need=%zu out=%d n_in=%d\n", ws_size, off, out_size, n_in);
#if MULTI_LAUNCH
  const int G = 256;
  phase_kernel<0><<<G, NT, 0, stream>>>(p, 0);
  for (int layer = 0; layer < 2; ++layer) {
    phase_kernel<1><<<G, NT, 0, stream>>>(p, layer);
    phase_kernel<2><<<G, NT, 0, stream>>>(p, layer);
    phase_kernel<3><<<G, NT, 0, stream>>>(p, layer);
    phase_kernel<4><<<G, NT, 0, stream>>>(p, layer);
    phase_kernel<5><<<G, NT, 0, stream>>>(p, layer);
  }
#else
  static int grid_blocks = 0;
  if (!grid_blocks) {
    int dev = 0, cus = 0, per_cu = 0;
    hipGetDevice(&dev);
    hipDeviceGetAttribute(&cus, hipDeviceAttributeMultiprocessorCount, dev);
    hipOccupancyMaxActiveBlocksPerMultiprocessor(&per_cu, mega, NT, 0);
    if (per_cu < 1) per_cu = 1;
    grid_blocks = cus * per_cu;
  }
  void* args[] = {&p};
  hipError_t e = hipLaunchCooperativeKernel((void*)mega, dim3(grid_blocks), dim3(NT), args, 0, stream);
  if (e != hipSuccess) fprintf(stderr, "cooperative launch failed: %s (grid %d)\n", hipGetErrorString(e), grid_blocks);
#endif
}
```
